# Optimizing an MI355X kernel written in HIP

```python
import math
import jax, jax.numpy as jnp
from jax import lax
import numpy as np

D_MODEL = 2048
BATCH = 8
SEQ = 2048
DEPTH = 2

BLOCK = 128
EPS = 1e-6
A_HEADS = 8
A_HEAD_DIM = 128
A_WIDTH = A_HEADS * A_HEAD_DIM
POOL_WINDOWS = (2, 4, 8, 16)
B_GROUP_DIM = 256
B_WIDTH = len(POOL_WINDOWS) * B_GROUP_DIM
C_PATTERNS = ((128, 1), (512, 4), (2048, 16))
C_GROUPS = len(C_PATTERNS)
C_HEADS_PER_GROUP = 4
C_HEAD_DIM = 128
C_HEADS = C_GROUPS * C_HEADS_PER_GROUP
C_QKV_WIDTH = C_HEADS * C_HEAD_DIM
C_OUT_WIDTH = C_HEADS_PER_GROUP * C_HEAD_DIM
N_BRANCHES = 3
IN_WIDTH = 2 * A_WIDTH + B_WIDTH + 3 * C_QKV_WIDTH + N_BRANCHES * D_MODEL
REL_BUCKETS = 32
REL_MAX_DISTANCE = 2048
PEER_HEADS = 8
PEER_KEYS = 128
PEER_N_EXPERTS = PEER_KEYS * PEER_KEYS
PEER_KEY_DIM = 256
PEER_TOPK = 16
PEER_TOKEN_BLOCK = 128

kernel_name = "hybrid_gmlp_pool_dilated_peer"


def rmsnorm(x, g):
    xf = x.astype(jnp.float32)
    y = xf * lax.rsqrt(jnp.mean(xf * xf, axis=-1, keepdims=True) + EPS)
    return (y * g.astype(jnp.float32)).astype(x.dtype)


def rel_bucket(n):
    max_exact = REL_BUCKETS // 2
    n = np.asarray(n)
    nl = np.maximum(n, max_exact).astype(np.float64)
    large = max_exact + (np.log(nl / max_exact) / math.log(REL_MAX_DISTANCE / max_exact)
                         * (REL_BUCKETS - max_exact)).astype(np.int32)
    large = np.minimum(large, REL_BUCKETS - 1)
    return np.where(n < max_exact, n, large).astype(np.int32)


def chunked_spatial_gating(u, v, a_norm_g, w_s, b_s):
    B, S, _ = u.shape
    u = jax.nn.gelu(u, approximate=False)
    v = rmsnorm(jax.nn.gelu(v, approximate=False), a_norm_g)
    vc = v.reshape(B, S // BLOCK, BLOCK, A_HEADS, A_HEAD_DIM)
    w_causal = jnp.where(jnp.tril(jnp.ones((BLOCK, BLOCK), dtype=bool))[None], w_s, 0)
    s = jnp.einsum('hts,bcshd->bcthd', w_causal, vc) + b_s.T[None, None, :, :, None]
    return u * s.reshape(B, S, A_WIDTH).astype(u.dtype)


def multiscale_pool(p, w_pool, pool_scale):
    B, S, _ = p.shape
    pf = p.astype(jnp.float32)
    cs = jnp.concatenate([jnp.zeros((B, 1, B_WIDTH), jnp.float32), jnp.cumsum(pf, axis=1)], axis=1)
    end = jnp.arange(1, S + 1)
    diffs = []
    for g, w in enumerate(POOL_WINDOWS):
        lo, hi = g * B_GROUP_DIM, (g + 1) * B_GROUP_DIM
        start = jnp.maximum(end - w, 0)
        csg = cs[:, :, lo:hi]
        window_sum = csg[:, 1:] - jnp.take(csg, start, axis=1)
        mean = window_sum / (end - start).astype(jnp.float32)[None, :, None]
        diffs.append(mean - pf[:, :, lo:hi])
    d = jnp.stack(diffs, axis=2).astype(p.dtype)
    y = jnp.einsum('bsgc,gce->bsge', d, w_pool)
    return y.reshape(B, S, B_WIDTH) * pool_scale


def dilated_group_attention(q, k, v, bias_hj, dilation, n_off):
    B, S, H, Dh = q.shape
    L = S // dilation
    nb = -(-L // BLOCK)
    Lp = nb * BLOCK

    def to_sub(t):
        t = t.reshape(B, L, dilation, H, Dh).transpose(0, 2, 1, 3, 4).reshape(B * dilation, L, H, Dh)
        t = jnp.pad(t, ((0, 0), (0, Lp - L), (0, 0), (0, 0)))
        return t.reshape(B * dilation, nb, BLOCK, H, Dh)

    def with_prev(t):
        prev = jnp.pad(t, ((0, 0), (1, 0), (0, 0), (0, 0), (0, 0)))[:, :-1]
        return jnp.concatenate([prev, t], axis=2)

    qb = to_sub(q)
    kk = with_prev(to_sub(k))
    vv = with_prev(to_sub(v)).astype(jnp.float32)
    logits = jnp.einsum('bnqhd,bnkhd->bnhqk', qb, kk, preferred_element_type=jnp.float32) * (Dh ** -0.5)
    qi = np.arange(BLOCK)[:, None]
    ki = np.arange(2 * BLOCK)[None, :]
    off = BLOCK + qi - ki
    off_ok = (off >= 0) & (off <= n_off)
    key_ok = (np.arange(nb)[:, None] * BLOCK - BLOCK + np.arange(2 * BLOCK)[None, :]) >= 0
    mask = off_ok[None] & key_ok[:, None, :]
    bias = bias_hj[:, np.clip(off, 0, n_off)].astype(jnp.float32)
    logits = jnp.where(mask[None, :, None], logits + bias[None, None], jnp.float32(-1e30))
    m = jnp.max(logits, axis=-1, keepdims=True)
    e = jnp.exp(logits - m)
    s = jnp.sum(e, axis=-1, keepdims=True)
    lse = (m + jnp.log(s))[..., 0].transpose(0, 1, 3, 2)
    o = jnp.einsum('bnhqk,bnkhd->bnqhd', e, vv) / s[..., 0].transpose(0, 1, 3, 2)[..., None]

    def from_sub(t):
        t = t.reshape(B * dilation, Lp, *t.shape[3:])[:, :L]
        t = t.reshape(B, dilation, L, *t.shape[2:])
        return jnp.swapaxes(t, 1, 2).reshape(B, S, *t.shape[3:])

    return from_sub(o), from_sub(lse)


def dilated_mixture_attention(q, k, v, rel_table):
    outs, lses = [], []
    for g, (window, dilation) in enumerate(C_PATTERNS):
        n_off = window // dilation
        buckets = rel_bucket(np.arange(n_off + 1) * dilation)
        bias_hj = rel_table[buckets][:, g * C_HEADS_PER_GROUP:(g + 1) * C_HEADS_PER_GROUP].T
        o, lse = dilated_group_attention(q[:, :, g], k[:, :, g], v[:, :, g], bias_hj, dilation, n_off)
        outs.append(o)
        lses.append(lse)
    o = jnp.stack(outs, axis=2)
    w = jax.nn.softmax(jnp.stack(lses, axis=2), axis=2)
    return jnp.sum(w[..., None] * o, axis=2)


def peer_ffn(x, w_q, sub_keys_1, sub_keys_2, expert_u, expert_v):
    B, S, D = x.shape
    T = B * S
    xt = x.reshape(T, D)
    q = (xt @ w_q).astype(jnp.float32).reshape(T, PEER_HEADS, 2, PEER_KEY_DIM // 2)
    s1 = jnp.einsum('thc,kc->thk', q[:, :, 0], sub_keys_1.astype(jnp.float32))
    s2 = jnp.einsum('thc,kc->thk', q[:, :, 1], sub_keys_2.astype(jnp.float32))
    v1, i1 = lax.top_k(s1, PEER_TOPK)
    v2, i2 = lax.top_k(s2, PEER_TOPK)
    cand = (v1[..., :, None] + v2[..., None, :]).reshape(T, PEER_HEADS, PEER_TOPK * PEER_TOPK)
    vs, pos = lax.top_k(cand, PEER_TOPK)
    e1 = jnp.take_along_axis(i1, pos // PEER_TOPK, axis=-1)
    e2 = jnp.take_along_axis(i2, pos % PEER_TOPK, axis=-1)
    experts = (e1 * PEER_KEYS + e2).reshape(T, PEER_HEADS * PEER_TOPK)
    gates = jax.nn.softmax(vs, axis=-1).reshape(T, PEER_HEADS * PEER_TOPK)
    nblk = T // PEER_TOKEN_BLOCK

    def token_block(args):
        xb, eb, gb = args
        a = jnp.einsum('td,tkd->tk', xb, expert_u[eb], preferred_element_type=jnp.float32)
        h = (jax.nn.gelu(a, approximate=False) * gb).astype(xb.dtype)
        return jnp.einsum('tk,tkd->td', h, expert_v[eb])

    y = lax.map(token_block, (xt.reshape(nblk, PEER_TOKEN_BLOCK, D),
                              experts.reshape(nblk, PEER_TOKEN_BLOCK, -1),
                              gates.reshape(nblk, PEER_TOKEN_BLOCK, -1)))
    return y.reshape(B, S, D).astype(x.dtype)


def hybrid_layer(x, rel_table, norm_mix_g, w_in, a_norm_g, a_w_s, a_b_s, b_w_pool, b_scale,
                 w_br_a, w_br_b, w_br_c, w_out, norm_ffn_g, peer_w_q, peer_k1, peer_k2, peer_u, peer_v):
    B, S, D = x.shape
    h = rmsnorm(x, norm_mix_g)
    p = h @ w_in
    cuts = np.cumsum([A_WIDTH, A_WIDTH, B_WIDTH, C_QKV_WIDTH, C_QKV_WIDTH, C_QKV_WIDTH]).tolist()
    a_u, a_v, b_in, c_q, c_k, c_v, gate_logits = jnp.split(p, cuts, axis=-1)
    y_a = chunked_spatial_gating(a_u, a_v, a_norm_g, a_w_s, a_b_s)
    y_b = multiscale_pool(b_in, b_w_pool, b_scale)
    shp = (B, S, C_GROUPS, C_HEADS_PER_GROUP, C_HEAD_DIM)
    y_c = dilated_mixture_attention(c_q.reshape(shp), c_k.reshape(shp), c_v.reshape(shp), rel_table)
    y_c = y_c.reshape(B, S, C_OUT_WIDTH).astype(x.dtype)
    gates = jax.nn.sigmoid(gate_logits.astype(jnp.float32)).astype(x.dtype).reshape(B, S, N_BRANCHES, D)
    merged = (gates[:, :, 0] * (y_a @ w_br_a) + gates[:, :, 1] * (y_b @ w_br_b)
              + gates[:, :, 2] * (y_c @ w_br_c))
    x = x + merged @ w_out
    x = x + peer_ffn(rmsnorm(x, norm_ffn_g), peer_w_q, peer_k1, peer_k2, peer_u, peer_v)
    return x


def setup_inputs(seed: int = 0) -> dict:
    key = jax.random.key(seed)
    ks = jax.random.split(key, 24)
    nrm = lambda k, shape, scale: jax.random.normal(k, shape, jnp.float32) * scale
    gain = lambda k, shape: 1.0 + 0.01 * jax.random.normal(k, shape, jnp.float32)
    D = D_MODEL
    return {
        "x": nrm(ks[0], (BATCH, SEQ, D), 1.0),
        "rel_bias_table": nrm(ks[1], (REL_BUCKETS, C_HEADS), 0.5),
        "norm_mix_g": gain(ks[2], (DEPTH, D)),
        "w_in": nrm(ks[3], (DEPTH, D, IN_WIDTH), D ** -0.5),
        "a_norm_g": gain(ks[4], (DEPTH, A_WIDTH)),
        "a_w_s": nrm(ks[5], (DEPTH, A_HEADS, BLOCK, BLOCK), BLOCK ** -0.5),
        "a_b_s": gain(ks[6], (DEPTH, A_HEADS, BLOCK)),
        "b_w_pool": nrm(ks[7], (DEPTH, len(POOL_WINDOWS), B_GROUP_DIM, B_GROUP_DIM), B_GROUP_DIM ** -0.5),
        "b_scale": 1.0 + nrm(ks[8], (DEPTH, B_WIDTH), 0.1),
        "w_br_a": nrm(ks[9], (DEPTH, A_WIDTH, D), A_WIDTH ** -0.5),
        "w_br_b": nrm(ks[10], (DEPTH, B_WIDTH, D), B_WIDTH ** -0.5),
        "w_br_c": nrm(ks[11], (DEPTH, C_OUT_WIDTH, D), C_OUT_WIDTH ** -0.5),
        "w_out": nrm(ks[12], (DEPTH, D, D), D ** -0.5),
        "norm_ffn_g": gain(ks[13], (DEPTH, D)),
        "peer_w_q": nrm(ks[14], (DEPTH, D, PEER_HEADS * PEER_KEY_DIM), D ** -0.5),
        "peer_sub_keys_1": nrm(ks[15], (DEPTH, PEER_KEYS, PEER_KEY_DIM // 2), (PEER_KEY_DIM // 2) ** -0.5),
        "peer_sub_keys_2": nrm(ks[16], (DEPTH, PEER_KEYS, PEER_KEY_DIM // 2), (PEER_KEY_DIM // 2) ** -0.5),
        "peer_u": nrm(ks[17], (DEPTH, PEER_N_EXPERTS, D), D ** -0.5),
        "peer_v": nrm(ks[18], (DEPTH, PEER_N_EXPERTS, D), PEER_HEADS ** -0.5),
        "final_norm_g": gain(ks[19], (D,)),
    }


def reference(x, rel_bias_table, norm_mix_g, w_in, a_norm_g, a_w_s, a_b_s, b_w_pool, b_scale,
              w_br_a, w_br_b, w_br_c, w_out, norm_ffn_g, peer_w_q, peer_sub_keys_1, peer_sub_keys_2,
              peer_u, peer_v, final_norm_g):
    for l in range(DEPTH):
        x = hybrid_layer(x, rel_bias_table, norm_mix_g[l], w_in[l], a_norm_g[l], a_w_s[l], a_b_s[l],
                         b_w_pool[l], b_scale[l], w_br_a[l], w_br_b[l], w_br_c[l], w_out[l],
                         norm_ffn_g[l], peer_w_q[l], peer_sub_keys_1[l], peer_sub_keys_2[l],
                         peer_u[l], peer_v[l])
    return rmsnorm(x, final_norm_g)
```

```cpp
#include <hip/hip_runtime.h>
#include <cstdio>
#include <cstdint>
namespace pg8 {
#define PG8_LAS __attribute__((address_space(3)))
typedef unsigned short bf16_t;
typedef short bf16x8 __attribute__((ext_vector_type(8)));
typedef float f32x4 __attribute__((ext_vector_type(4)));
typedef unsigned u32x4 __attribute__((ext_vector_type(4)));
constexpr int BM = 256, BK = 64, HALF = 128, HTB = HALF * BK * 2  , STAGE_BYTES = 8 * HTB, NXCD = 8, WGM = 8;

__host__ __device__ __forceinline__ int lds_byte(int r, int c) { const int st = (r >> 4) * 2 + (c >> 5), rr = r & 15, cc = c & 31, ob = rr * 64 + cc * 2; return st * 1024 + (ob ^ (((ob >> 9) & 1) << 5)); }
__host__ __device__ __forceinline__ void stage_rc(int b, int& R, int& C) { const int st = b / 1024, sb = b % 1024, swz = sb ^ (((sb >> 9) & 1) << 5); R = (st >> 1) * 16 + swz / 64; C = (st & 1) * 32 + (swz % 64) / 2; }
__host__ __device__ __forceinline__ int perm32(int rho) { const int n = rho >> 4, i = rho & 15; return 8 * (i >> 2) + 4 * n + (i & 3); }

struct Unit { int pm, pn; };
struct Gemm { const bf16_t* A; const bf16_t* Bt; int M, N, K; };

struct StaticOrder {
    int nM, nN, nwg, G, c;
    __host__ __device__ void init(int M, int N, int G_, int c_) { nM = M / BM; nN = N / BM; nwg = nM * nN; G = G_; c = c_; }
    __host__ __device__ bool next(int i, Unit& u) const {
        const long L = (long)i * G + c; if (L >= nwg) return false;
        int wgid = (int)L; { const int q = nwg / NXCD, r = nwg % NXCD, xcd = wgid % NXCD, off = wgid / NXCD; wgid = (xcd < r ? xcd * (q + 1) : r * (q + 1) + (xcd - r) * q) + off; }
        const int nig = WGM * nN, gid = wgid / nig, fm = gid * WGM, gsz = (nM - fm) < WGM ? (nM - fm) : WGM;
        u.pm = fm + ((wgid % nig) % gsz); u.pn = (wgid % nig) / gsz; return true;
    }
    __device__ __forceinline__ void a_ready(const Unit&) const {}
    __device__ __forceinline__ void done(const Unit&) const {}
};
struct CountedOrder : StaticOrder {
    const unsigned* ready; unsigned need; unsigned* tmo;
    __device__ __forceinline__ void a_ready(const Unit& u) const {
        if (threadIdx.x < 64) {
            const unsigned long long t0 = __builtin_amdgcn_s_memrealtime(); unsigned polls = 0;
            while ((unsigned)__builtin_amdgcn_readfirstlane(__hip_atomic_load(ready + 64 * u.pm, __ATOMIC_RELAXED, __HIP_MEMORY_SCOPE_AGENT)) < need) {
                if ((++polls & 255u) == 0u && __builtin_amdgcn_readfirstlane(__hip_atomic_load(tmo, __ATOMIC_RELAXED, __HIP_MEMORY_SCOPE_AGENT)) != 0u) break;
                if (__builtin_amdgcn_s_memrealtime() - t0 > 2000000ull) {
                    if (threadIdx.x == 0) { unsigned expect = 0u; __hip_atomic_compare_exchange_strong(tmo + 1, &expect, 0x600u | (unsigned)(u.pm & 0xff), __ATOMIC_RELAXED, __ATOMIC_RELAXED, __HIP_MEMORY_SCOPE_AGENT); __hip_atomic_store(tmo, 1u, __ATOMIC_RELAXED, __HIP_MEMORY_SCOPE_AGENT); }
                    break; }
                __builtin_amdgcn_s_sleep(2); }
            __builtin_amdgcn_fence(__ATOMIC_ACQUIRE, "agent");
            asm volatile("s_waitcnt vmcnt(0)" ::: "memory");
        }
#if !defined(BROKEN_HOOK_NO_BARRIER)
        asm volatile("" ::: "memory"); __builtin_amdgcn_s_barrier(); asm volatile("" ::: "memory");
#endif
    }
};

__device__ __forceinline__ unsigned cvt_pk_bf16(float lo, float hi) { unsigned r; asm volatile("v_cvt_pk_bf16_f32 %0, %1, %2" : "=v"(r) : "v"(lo), "v"(hi)); return r; }
typedef float f32x2 __attribute__((ext_vector_type(2)));
__device__ __forceinline__ f32x2 gelu_pk(f32x2 v) {
    const f32x2 av = __builtin_elementwise_abs(v), d = av * 0.2316418882f + 1.0f;
    f32x2 t; t.x = __builtin_amdgcn_rcpf(d.x); t.y = __builtin_amdgcn_rcpf(d.y);
    f32x2 q = t * 0.5307027145f + (-0.7265760135f); q = q * t + 0.7107068705f; q = q * t + (-0.142248368f); q = q * t + 0.127414796f; q = q * t;
    const f32x2 s = (v * v) * (-0.72134752044f);
    f32x2 e; e.x = __builtin_amdgcn_exp2f(s.x); e.y = __builtin_amdgcn_exp2f(s.y);
    const f32x2 m = v * (q * e), r = v - m;
    f32x2 o; o.x = v.x < 0.f ? m.x : r.x; o.y = v.y < 0.f ? m.y : r.y; return o;
}

struct EpiF32 {
    static constexpr bool PERM = false, AFTER_DRAIN = false;
    float* C; int ldc; const float* bias;
    __device__ __forceinline__ void operator()(const f32x4 (&acc)[2][2][4][2], const Unit& u, int wr, int wc, int fr, int fq) const {
        const int row0 = u.pm * BM + wr * 64 + fr, col0 = u.pn * BM + wc * 32 + 4 * fq;
        f32x4 bv[2][2];
#pragma unroll
        for (int bj = 0; bj < 2; ++bj)
#pragma unroll
            for (int n = 0; n < 2; ++n) bv[bj][n] = bias ? *(const f32x4*)(bias + col0 + bj * HALF + n * 16) : (f32x4){0.f, 0.f, 0.f, 0.f};
#pragma unroll
        for (int ai = 0; ai < 2; ++ai)
#pragma unroll
            for (int m = 0; m < 4; ++m) { float* rowp = C + (size_t)(row0 + ai * HALF + m * 16) * ldc + col0;
#pragma unroll
                for (int bj = 0; bj < 2; ++bj)
#pragma unroll
                    for (int n = 0; n < 2; ++n) *(f32x4*)(rowp + bj * HALF + n * 16) = acc[ai][bj][m][n] + bv[bj][n]; }
    }
};
template <int ACT  > struct EpiBf16 {
    static constexpr bool PERM = true, AFTER_DRAIN = false;
    bf16_t* O; int ldc; const float* bias; int split_cols; size_t split_stride;
    __device__ __forceinline__ void operator()(const f32x4 (&acc)[2][2][4][2], const Unit& u, int wr, int wc, int fr, int fq) const {
        const int row0 = u.pm * BM + wr * 64 + fr; int colt = u.pn * BM; bf16_t* base = O;
        if (split_cols) { const int t = colt / split_cols; base += (size_t)t * split_stride; colt -= t * split_cols; }
        const int col0 = colt + wc * 32 + 8 * fq, bcol0 = u.pn * BM + wc * 32 + 8 * fq;
        f32x4 bv[2][2];
#pragma unroll
        for (int bj = 0; bj < 2; ++bj)
#pragma unroll
            for (int n = 0; n < 2; ++n) bv[bj][n] = bias ? *(const f32x4*)(bias + bcol0 + bj * HALF + 4 * n) : (f32x4){0.f, 0.f, 0.f, 0.f};
#pragma unroll
        for (int ai = 0; ai < 2; ++ai)
#pragma unroll
            for (int m = 0; m < 4; ++m) { bf16_t* rowp = base + (size_t)(row0 + ai * HALF + m * 16) * ldc + col0;
#pragma unroll
                for (int bj = 0; bj < 2; ++bj) { f32x4 v0 = acc[ai][bj][m][0] + bv[bj][0], v1 = acc[ai][bj][m][1] + bv[bj][1];
                    if (ACT == 1) { f32x2 a = gelu_pk((f32x2){v0[0], v0[1]}), b = gelu_pk((f32x2){v0[2], v0[3]}), c = gelu_pk((f32x2){v1[0], v1[1]}), d = gelu_pk((f32x2){v1[2], v1[3]});
                        v0 = (f32x4){a.x, a.y, b.x, b.y}; v1 = (f32x4){c.x, c.y, d.x, d.y}; }
                    if (ACT == 2) {
#pragma unroll
                        for (int j = 0; j < 4; ++j) { v0[j] = 0.5f * v0[j] * (1.0f + erff(v0[j] * 0.70710678f)); v1[j] = 0.5f * v1[j] * (1.0f + erff(v1[j] * 0.70710678f)); } }
                    u32x4 w; w.x = cvt_pk_bf16(v0[0], v0[1]); w.y = cvt_pk_bf16(v0[2], v0[3]); w.z = cvt_pk_bf16(v1[0], v1[1]); w.w = cvt_pk_bf16(v1[2], v1[3]);
                    *(u32x4*)(rowp + bj * HALF) = w; } }
    }
};

struct PanelStats {
    unsigned* xbuf;
    unsigned* cnt;
    unsigned* tmo;
    int ntn; float eps;
    unsigned code;
    __device__ __forceinline__ bool run(const f32x4 (&v)[2][2][4][2], const Unit& u, int wr, int wc, int fr, int fq, PG8_LAS unsigned char* lds, int wid, int lane) const {
        typedef float f32x2v __attribute__((ext_vector_type(2)));
        PG8_LAS f32x2v* P = (PG8_LAS f32x2v*)lds;
        PG8_LAS f32x2v* S = (PG8_LAS f32x2v*)(lds + 8192);
        PG8_LAS unsigned* flag = (PG8_LAS unsigned*)(lds + 8192 + 2048);
#pragma unroll
        for (int ai = 0; ai < 2; ++ai)
#pragma unroll
            for (int m = 0; m < 4; ++m) {
                float s = 0.f;
#pragma unroll
                for (int bj = 0; bj < 2; ++bj)
#pragma unroll
                    for (int n = 0; n < 2; ++n) { const f32x4 x = v[ai][bj][m][n]; s += (x[0] + x[1]) + (x[2] + x[3]); }
                s += __shfl_xor(s, 16); s += __shfl_xor(s, 32);
                const float mw = s * (1.0f / 64.0f); float q = 0.f;
#pragma unroll
                for (int bj = 0; bj < 2; ++bj)
#pragma unroll
                    for (int n = 0; n < 2; ++n) { const f32x4 d = v[ai][bj][m][n] - mw; q += (d[0] * d[0] + d[1] * d[1]) + (d[2] * d[2] + d[3] * d[3]); }
                q += __shfl_xor(q, 16); q += __shfl_xor(q, 32);
                if (fq == 0) P[(ai * HALF + wr * 64 + m * 16 + fr) * 4 + wc] = (f32x2v){mw, q};
            }
        asm volatile("s_waitcnt lgkmcnt(0)" ::: "memory"); __builtin_amdgcn_s_barrier(); asm volatile("" ::: "memory");
#if defined(BROKEN_NO_WAIT)
        if (blockIdx.x >= 64) { const long long t0 = clock64(); while (clock64() - t0 < 60000) __builtin_amdgcn_s_sleep(8); }
#endif
        const int row = wid * 32 + (lane & 31);
        if (lane < 32) {
            const f32x2v a = P[row * 4 + 0], b = P[row * 4 + 1], c = P[row * 4 + 2], d = P[row * 4 + 3];
            const float mt = (a.x + b.x + c.x + d.x) * 0.25f;
            const float da = a.x - mt, db = b.x - mt, dc = c.x - mt, dd = d.x - mt;
            const float m2 = (a.y + b.y) + (c.y + d.y) + 64.0f * ((da * da + db * db) + (dc * dc + dd * dd));
            unsigned long long* slot = (unsigned long long*)xbuf + ((size_t)(u.pm * BM + row) * 4 + u.pn);
            __hip_atomic_store(slot, ((unsigned long long)__float_as_uint(m2) << 32) | __float_as_uint(mt), __ATOMIC_RELAXED, __HIP_MEMORY_SCOPE_AGENT);
        }
        asm volatile("s_waitcnt vmcnt(0)" ::: "memory");
        if (lane == 0) __hip_atomic_fetch_add(cnt + 64 * u.pm, 1u, __ATOMIC_RELAXED, __HIP_MEMORY_SCOPE_AGENT);
        if (wid == 0) {
            bool dead = false; const unsigned long long t0 = __builtin_amdgcn_s_memrealtime(); const unsigned want = 8u * (unsigned)ntn;
            for (;;) {
#if defined(BROKEN_NO_WAIT)
                break;
#endif
                if ((unsigned)__builtin_amdgcn_readfirstlane(__hip_atomic_load(cnt + 64 * u.pm, __ATOMIC_RELAXED, __HIP_MEMORY_SCOPE_AGENT)) >= want) break;
                if (__builtin_amdgcn_s_memrealtime() - t0 > 2000000ull) {
                    if (lane == 0) { unsigned expect = 0u; __hip_atomic_compare_exchange_strong(tmo + 1, &expect, code | (unsigned)(u.pm & 0xff), __ATOMIC_RELAXED, __ATOMIC_RELAXED, __HIP_MEMORY_SCOPE_AGENT);
                                     __hip_atomic_store(tmo, 1u, __ATOMIC_RELAXED, __HIP_MEMORY_SCOPE_AGENT); }
                    dead = true; break; }
                __builtin_amdgcn_s_sleep(2);
            }
            __builtin_amdgcn_fence(__ATOMIC_ACQUIRE, "agent");
            if (lane == 0) flag[0] = dead ? 1u : 0u;
        }
        asm volatile("s_waitcnt vmcnt(0) lgkmcnt(0)" ::: "memory"); __builtin_amdgcn_s_barrier(); asm volatile("" ::: "memory");
        const bool bad = flag[0] != 0u;
        if (lane < 32) {
            const unsigned long long* slot = (const unsigned long long*)xbuf + (size_t)(u.pm * BM + row) * 4; float mt[4], m2[4]; float ms = 0.f;
#pragma unroll
            for (int t = 0; t < 4; ++t) { if (t < ntn) { const unsigned long long w = __hip_atomic_load(slot + t, __ATOMIC_RELAXED, __HIP_MEMORY_SCOPE_AGENT); mt[t] = __uint_as_float((unsigned)w); m2[t] = __uint_as_float((unsigned)(w >> 32)); } else { mt[t] = 0.f; m2[t] = 0.f; } ms += mt[t]; }
            const float mean = ms / (float)ntn; float q = 0.f;
#pragma unroll
            for (int t = 0; t < 4; ++t) if (t < ntn) { const float dm = mt[t] - mean; q += m2[t] + 256.0f * dm * dm; }
            S[row] = (f32x2v){mean, 1.0f / sqrtf(q / (256.0f * (float)ntn) + eps)};
        }
        asm volatile("s_waitcnt lgkmcnt(0)" ::: "memory"); __builtin_amdgcn_s_barrier(); asm volatile("" ::: "memory");
        return bad;
    }
};
struct EpiLnRes {
    static constexpr bool PERM = false, AFTER_DRAIN = true;
    const float* base; float* out; int ldc; const float* bias; PanelStats st; unsigned poison;
    __device__ __forceinline__ void refuse(size_t i0, size_t stride, int M, int N) const { const float q = __builtin_nanf(""); for (size_t i = i0; i < (size_t)M * N; i += stride) out[(i / N) * ldc + i % N] = q;
        if (i0 == 0) { unsigned expect = 0u; __hip_atomic_compare_exchange_strong(st.tmo + 1, &expect, 0x7f0u, __ATOMIC_RELAXED, __ATOMIC_RELAXED, __HIP_MEMORY_SCOPE_AGENT); __hip_atomic_store(st.tmo, 1u, __ATOMIC_RELAXED, __HIP_MEMORY_SCOPE_AGENT); } }
    __device__ __forceinline__ void fused(f32x4 (&acc)[2][2][4][2], const Unit& u, int wr, int wc, int fr, int fq, PG8_LAS unsigned char* lds, int wid, int lane) const {
        typedef float f32x2v __attribute__((ext_vector_type(2)));
        const PG8_LAS f32x2v* S = (const PG8_LAS f32x2v*)(lds + 8192);
        const int col0 = u.pn * BM + wc * 32 + 4 * fq;
#pragma unroll
        for (int bj = 0; bj < 2; ++bj)
#pragma unroll
            for (int n = 0; n < 2; ++n) { const f32x4 bv = bias ? *(const f32x4*)(bias + col0 + bj * HALF + n * 16) : (f32x4){0.f, 0.f, 0.f, 0.f};
#pragma unroll
                for (int ai = 0; ai < 2; ++ai)
#pragma unroll
                    for (int m = 0; m < 4; ++m) acc[ai][bj][m][n] += bv; }
        const bool bad = st.run(acc, u, wr, wc, fr, fq, lds, wid, lane) || poison != 0u;
        const float qnan = __builtin_nanf("");
#pragma unroll
        for (int ai = 0; ai < 2; ++ai)
#pragma unroll
            for (int m = 0; m < 4; ++m) { const int r = ai * HALF + wr * 64 + m * 16 + fr; const f32x2v sr = S[r]; const size_t off = (size_t)(u.pm * BM + r) * ldc + col0;
#pragma unroll
                for (int bj = 0; bj < 2; ++bj)
#pragma unroll
                    for (int n = 0; n < 2; ++n) { const f32x4 bs = *(const f32x4*)(base + off + bj * HALF + n * 16); f32x4 o = bs + (acc[ai][bj][m][n] - sr.x) * sr.y;
                        if (bad) o = (f32x4){qnan, qnan, qnan, qnan}; *(f32x4*)(out + off + bj * HALF + n * 16) = o; }
                asm volatile("" ::: "memory"); }
    }
};
struct EpiLnResLn {
    static constexpr bool PERM = false, AFTER_DRAIN = true;
    const float* base; float* out; bf16_t* xn; int ldc; const float* bias; PanelStats st1, st2; unsigned poison;
    __device__ __forceinline__ void refuse(size_t i0, size_t stride, int M, int N) const { const float q = __builtin_nanf(""); for (size_t i = i0; i < (size_t)M * N; i += stride) { const size_t o = (i / N) * ldc + i % N; out[o] = q; xn[o] = (bf16_t)0x7fc0u; }
        if (i0 == 0) { unsigned expect = 0u; __hip_atomic_compare_exchange_strong(st1.tmo + 1, &expect, 0x7f0u, __ATOMIC_RELAXED, __ATOMIC_RELAXED, __HIP_MEMORY_SCOPE_AGENT); __hip_atomic_store(st1.tmo, 1u, __ATOMIC_RELAXED, __HIP_MEMORY_SCOPE_AGENT); } }
    __device__ __forceinline__ void fused(f32x4 (&acc)[2][2][4][2], const Unit& u, int wr, int wc, int fr, int fq, PG8_LAS unsigned char* lds, int wid, int lane) const {
        typedef float f32x2v __attribute__((ext_vector_type(2))); typedef unsigned u32x2v __attribute__((ext_vector_type(2)));
        const PG8_LAS f32x2v* S = (const PG8_LAS f32x2v*)(lds + 8192);
        const int col0 = u.pn * BM + wc * 32 + 4 * fq;
#pragma unroll
        for (int bj = 0; bj < 2; ++bj)
#pragma unroll
            for (int n = 0; n < 2; ++n) { const f32x4 bv = bias ? *(const f32x4*)(bias + col0 + bj * HALF + n * 16) : (f32x4){0.f, 0.f, 0.f, 0.f};
#pragma unroll
                for (int ai = 0; ai < 2; ++ai)
#pragma unroll
                    for (int m = 0; m < 4; ++m) acc[ai][bj][m][n] += bv; }
        bool bad = st1.run(acc, u, wr, wc, fr, fq, lds, wid, lane) || poison != 0u;
        const float qnan = __builtin_nanf("");
#pragma unroll
        for (int ai = 0; ai < 2; ++ai)
#pragma unroll
            for (int m = 0; m < 4; ++m) { const int r = ai * HALF + wr * 64 + m * 16 + fr; const f32x2v sr = S[r]; const size_t off = (size_t)(u.pm * BM + r) * ldc + col0;
#pragma unroll
                for (int bj = 0; bj < 2; ++bj)
#pragma unroll
                    for (int n = 0; n < 2; ++n) { const f32x4 bs = *(const f32x4*)(base + off + bj * HALF + n * 16); acc[ai][bj][m][n] = bs + (acc[ai][bj][m][n] - sr.x) * sr.y; }
                asm volatile("" : "+v"(acc[ai][0][m][0]), "+v"(acc[ai][0][m][1]), "+v"(acc[ai][1][m][0]), "+v"(acc[ai][1][m][1]));
                if (m & 1) asm volatile("" ::: "memory"); }
        const bool bad1 = bad;
        bad = st2.run(acc, u, wr, wc, fr, fq, lds, wid, lane) || bad;
#pragma unroll
        for (int ai = 0; ai < 2; ++ai)
#pragma unroll
            for (int m = 0; m < 4; ++m) { const int r = ai * HALF + wr * 64 + m * 16 + fr; const f32x2v sr = S[r]; const size_t off = (size_t)(u.pm * BM + r) * ldc + col0;
#pragma unroll
                for (int bj = 0; bj < 2; ++bj)
#pragma unroll
                    for (int n = 0; n < 2; ++n) { const f32x4 x1 = acc[ai][bj][m][n]; *(f32x4*)(out + off + bj * HALF + n * 16) = bad1 ? (f32x4){qnan, qnan, qnan, qnan} : x1;
                        const f32x4 o = (x1 - sr.x) * sr.y; u32x2v w; w.x = cvt_pk_bf16(o[0], o[1]); w.y = cvt_pk_bf16(o[2], o[3]);
                        if (bad) { w.x = 0x7fc07fc0u; w.y = 0x7fc07fc0u; } *(u32x2v*)(xn + off + bj * HALF + n * 16) = w; }
                asm volatile("" ::: "memory"); }
    }
};

template <class Epi, class Sched, bool STAMP = false>
__device__ __forceinline__ void gemm_phase(PG8_LAS unsigned char* lds, const Gemm g, const Sched& S, const Epi& E, unsigned long long* stamps) {
    int tid_opaque = threadIdx.x; asm volatile("" : "+v"(tid_opaque));
    const int tid = tid_opaque, wid = __builtin_amdgcn_readfirstlane(tid >> 6), lane = tid & 63, wr = wid >> 2, wc = wid & 3, fr = lane & 15, fq = lane >> 4;
    const int K = g.K, nt = K / BK;
    int ts_lo = 0, ts_hi = 0, nts = 0; const unsigned long long rt_entry = STAMP ? (unsigned long long)wall_clock64() : 0ull;
#define PG8_STAMP() do { if (STAMP && wid == 0 && nts < 64) { const unsigned long long _c = (unsigned long long)clock64(); \
        ts_lo = (lane == nts) ? (int)(unsigned)_c : ts_lo; ts_hi = (lane == nts) ? (int)(unsigned)(_c >> 32) : ts_hi; ++nts; } } while (0)
    PG8_STAMP();
    unsigned voffA[2], voffB[2];
#pragma unroll
    for (int i = 0; i < 2; ++i) { int R, C; stage_rc(tid * 16 + i * 8192, R, C); const int Rb = Epi::PERM ? ((R & ~31) + perm32(R & 31)) : R;
        voffA[i] = (unsigned)(R * K + C) * 2u; voffB[i] = (unsigned)(Rb * K + C) * 2u; }
    const size_t kstep = (size_t)(BK * 2);
    const size_t hstep = (size_t)HALF * K * 2;
    const size_t tstep = 2 * hstep;
    const unsigned ldsw = (unsigned)wid * 1024u;
    const int aoff = lds_byte(wr * 64 + fr, fq * 8), boff = lds_byte(wc * 32 + fr, fq * 8);
#define PG8_SA(b, h) (((b) * 2 + (h)) * HTB)
#define PG8_SB(b, h) ((4 + (b) * 2 + (h)) * HTB)
#define PG8_STAGE(bufoff, gbase, voff) do { _Pragma("unroll") for (int _i = 0; _i < 2; ++_i) \
        __builtin_amdgcn_global_load_lds((const unsigned*)((const char*)(gbase) + (voff)[_i]), (PG8_LAS unsigned*)(lds + (bufoff) + ldsw + _i * 8192), 16, 0, 0); } while (0)
#define PG8_LDA(dst, b, h) do { _Pragma("unroll") for (int m = 0; m < 4; ++m) _Pragma("unroll") for (int k = 0; k < 2; ++k) dst[m][k] = *(const PG8_LAS bf16x8*)(lds + PG8_SA(b, h) + aoff + m * 2048 + k * 1024); } while (0)
#define PG8_LDB(dst, b, h) do { _Pragma("unroll") for (int n = 0; n < 2; ++n) _Pragma("unroll") for (int k = 0; k < 2; ++k) dst[n][k] = *(const PG8_LAS bf16x8*)(lds + PG8_SB(b, h) + boff + n * 2048 + k * 1024); } while (0)
#define PG8_MMA(ai, bj, At, Bt) do { __builtin_amdgcn_s_setprio(1); _Pragma("unroll") for (int m = 0; m < 4; ++m) _Pragma("unroll") for (int n = 0; n < 2; ++n) _Pragma("unroll") for (int k = 0; k < 2; ++k) \
        acc[ai][bj][m][n] = __builtin_amdgcn_mfma_f32_16x16x32_bf16(Bt[n][k], At[m][k], acc[ai][bj][m][n], 0, 0, 0); __builtin_amdgcn_s_setprio(0); } while (0)
#define PG8_WAIT_V(n) asm volatile("s_waitcnt vmcnt(" #n ")" ::: "memory")
#define PG8_WAIT_L(n) asm volatile("s_waitcnt lgkmcnt(" #n ")" ::: "memory")
#define PG8_BAR __builtin_amdgcn_s_barrier()
#define PG8_SCHED __builtin_amdgcn_sched_barrier(0)
    Unit cur, nxt; int ui = 0;
    if (!S.next(0, cur)) return;
    f32x4 acc[2][2][4][2];
#pragma unroll
    for (int a = 0; a < 2; ++a)
#pragma unroll
        for (int b = 0; b < 2; ++b)
#pragma unroll
            for (int m = 0; m < 4; ++m)
#pragma unroll
                for (int n = 0; n < 2; ++n) acc[a][b][m][n] = (f32x4){0.f, 0.f, 0.f, 0.f};
    bf16x8 At[4][2], B0[2][2], B1[2][2];
    const char* cA = (const char*)g.A + (size_t)cur.pm * tstep; const char* cB = (const char*)g.Bt + (size_t)cur.pn * tstep;
    S.a_ready(cur);
    PG8_STAGE(PG8_SB(0, 0), cB, voffB); PG8_STAGE(PG8_SA(0, 0), cA, voffA); PG8_STAGE(PG8_SB(0, 1), cB + hstep, voffB); PG8_STAGE(PG8_SA(0, 1), cA + hstep, voffA);
    if (wr == 1) PG8_BAR;
    PG8_WAIT_V(4); PG8_BAR;
    PG8_STAGE(PG8_SB(1, 0), cB + kstep, voffB); PG8_STAGE(PG8_SA(1, 0), cA + kstep, voffA); PG8_STAGE(PG8_SB(1, 1), cB + hstep + kstep, voffB);
    PG8_WAIT_V(6); PG8_BAR;
    PG8_STAMP();
    for (;;) {
        const bool has_next = S.next(ui + 1, nxt);
        const char* nA = has_next ? (const char*)g.A + (size_t)nxt.pm * tstep : cA; const char* nB = has_next ? (const char*)g.Bt + (size_t)nxt.pn * tstep : cB;
        for (int t = 0; t < nt; t += 2) {
            const bool last = (t == nt - 2);
            const char* a1 = cA + (size_t)(t + 1) * kstep;
            const char* a2 = last ? nA : cA + (size_t)(t + 2) * kstep; const char* b2 = last ? nB : cB + (size_t)(t + 2) * kstep;
            const char* a3 = a2 + kstep; const char* b3 = b2 + kstep;
            if (last && has_next) S.a_ready(nxt);
            PG8_LDB(B0, 0, 0); PG8_SCHED; PG8_LDA(At, 0, 0); PG8_STAGE(PG8_SA(1, 1), a1 + hstep, voffA);
            PG8_WAIT_L(8); PG8_BAR; PG8_WAIT_L(0); PG8_MMA(0, 0, At, B0); PG8_BAR; PG8_SCHED;
            PG8_LDB(B1, 0, 1); PG8_STAGE(PG8_SB(0, 0), b2, voffB);
            PG8_BAR; PG8_WAIT_L(0); PG8_MMA(0, 1, At, B1); PG8_BAR;
            PG8_LDA(At, 0, 1); PG8_STAGE(PG8_SA(0, 0), a2, voffA);
            PG8_BAR; PG8_WAIT_L(0); PG8_MMA(1, 0, At, B0); PG8_BAR; PG8_SCHED;
            PG8_STAGE(PG8_SB(0, 1), b2 + hstep, voffB);
            PG8_WAIT_V(6); PG8_BAR; PG8_MMA(1, 1, At, B1); PG8_BAR;
            PG8_LDB(B0, 1, 0); PG8_SCHED; PG8_LDA(At, 1, 0); PG8_STAGE(PG8_SA(0, 1), a2 + hstep, voffA);
            PG8_WAIT_L(8); PG8_BAR; PG8_WAIT_L(0); PG8_MMA(0, 0, At, B0); PG8_BAR; PG8_SCHED;
            PG8_LDB(B1, 1, 1); PG8_STAGE(PG8_SB(1, 0), b3, voffB);
            PG8_BAR; PG8_WAIT_L(0); PG8_MMA(0, 1, At, B1); PG8_BAR;
            PG8_LDA(At, 1, 1); PG8_STAGE(PG8_SA(1, 0), a3, voffA);
            PG8_BAR; PG8_WAIT_L(0); PG8_MMA(1, 0, At, B0); PG8_BAR; PG8_SCHED;
            PG8_STAGE(PG8_SB(1, 1), b3 + hstep, voffB);
            PG8_WAIT_V(6); PG8_BAR; PG8_MMA(1, 1, At, B1); PG8_BAR;
        }
        PG8_STAMP();
        if constexpr (!Epi::AFTER_DRAIN) { E(acc, cur, wr, wc, fr, fq); S.done(cur); }
        PG8_STAMP();
        if (!has_next) break;
#pragma unroll
        for (int a = 0; a < 2; ++a)
#pragma unroll
            for (int b = 0; b < 2; ++b)
#pragma unroll
                for (int m = 0; m < 4; ++m)
#pragma unroll
                    for (int n = 0; n < 2; ++n) acc[a][b][m][n] = (f32x4){0.f, 0.f, 0.f, 0.f};
        cur = nxt; cA = nA; cB = nB; ++ui;
    }
    PG8_WAIT_V(0);
    if (wr == 0) PG8_BAR;
    PG8_BAR;
    if constexpr (Epi::AFTER_DRAIN) { E.fused(acc, cur, wr, wc, fr, fq, lds, wid, lane); S.done(cur); }
    PG8_STAMP();
    if (STAMP && wid == 0) { stamps[lane] = lane < nts ? (((unsigned long long)(unsigned)ts_hi << 32) | (unsigned)ts_lo) : 0ull;
        if (lane == 62) stamps[62] = rt_entry; if (lane == 63) stamps[63] = (unsigned long long)wall_clock64(); }
#undef PG8_STAMP
#undef PG8_SA
#undef PG8_SB
#undef PG8_STAGE
#undef PG8_LDA
#undef PG8_LDB
#undef PG8_MMA
#undef PG8_WAIT_V
#undef PG8_WAIT_L
#undef PG8_BAR
#undef PG8_SCHED
}
}

namespace mk {
using pg8::bf16_t; using pg8::f32x4; using pg8::u32x4; using pg8::Unit; using pg8::f32x2;
#define LAS __attribute__((address_space(3)))
#define GAS __attribute__((address_space(1)))
typedef unsigned u32x2 __attribute__((ext_vector_type(2)));

constexpr int NWAVES = 8, NTHR = 512;
constexpr int T = 16384, D = 2048, SEQ = 2048, DEPTH = 2, INW = 13824, NEXP = 16384;
constexpr float EPS = 1e-6f;
constexpr size_t MiB = 1u << 20;
constexpr size_t WS_CTL = 0, CTL_ZERO_BYTES = 1 * MiB;
constexpr size_t WS_WIN = 1 * MiB;
constexpr size_t WS_WA = 55 * MiB;
constexpr size_t WS_WB = 59 * MiB;
constexpr size_t WS_WC = 63 * MiB;
constexpr size_t WS_WOUT = 65 * MiB;
constexpr size_t WS_WSC = 73 * MiB;
constexpr size_t WS_WM = 81 * MiB;
constexpr size_t WS_WP = 82 * MiB;
constexpr size_t WS_U = 83 * MiB;
constexpr size_t WS_V = 211 * MiB;
constexpr size_t WS_XB = 339 * MiB;
constexpr size_t WS_RSTD = 403 * MiB;
constexpr size_t WS_PA = 404 * MiB;
constexpr size_t WS_PB = 468 * MiB;
constexpr size_t WS_PQKV = 500 * MiB;
constexpr size_t WS_PG = 644 * MiB;
constexpr size_t WS_YA = 836 * MiB;
constexpr size_t WS_YB = 868 * MiB;
constexpr size_t WS_YC = 900 * MiB;
constexpr size_t WS_OG = 916 * MiB;
constexpr size_t WS_LSE = 964 * MiB;
constexpr size_t WS_END = 965 * MiB;
constexpr int CW_BAR = 4096;

constexpr int RING_BYTES = 131072, MISC_OFF = RING_BYTES + 320, LDS_BYTES = 147456;

__constant__ unsigned char kBucket[3 * 129] = {
0,1,2,3,4,5,6,7,8,9,10,11,12,13,14,15,16,16,16,16,16,16,17,17,17,17,17,17,17,17,18,18,18,18,18,18,18,18,18,18,19,19,19,19,19,19,19,19,19,19,19,19,19,19,20,20,20,20,20,20,20,20,20,20,20,20,20,20,20,20,20,20,20,21,21,21,21,21,21,21,21,21,21,21,21,21,21,21,21,21,21,21,21,21,21,21,21,21,21,22,22,22,22,22,22,22,22,22,22,22,22,22,22,22,22,22,22,22,22,22,22,22,22,22,22,22,22,22,22,
0,4,8,12,16,16,17,17,18,18,19,19,19,19,20,20,20,20,20,21,21,21,21,21,21,22,22,22,22,22,22,22,22,22,23,23,23,23,23,23,23,23,23,23,23,23,24,24,24,24,24,24,24,24,24,24,24,24,24,24,24,24,25,25,25,25,25,25,25,25,25,25,25,25,25,25,25,25,25,25,25,25,25,26,26,26,26,26,26,26,26,26,26,26,26,26,26,26,26,26,26,26,26,26,26,26,26,26,26,26,26,26,26,27,27,27,27,27,27,27,27,27,27,27,27,27,27,27,27,
0,16,18,19,20,21,21,22,22,23,23,23,24,24,24,24,25,25,25,25,25,26,26,26,26,26,26,26,26,27,27,27,27,27,27,27,27,27,27,28,28,28,28,28,28,28,28,28,28,28,28,28,29,29,29,29,29,29,29,29,29,29,29,29,29,29,29,29,29,29,30,30,30,30,30,30,30,30,30,30,30,30,30,30,30,30,30,30,30,30,30,30,30,30,30,31,31,31,31,31,31,31,31,31,31,31,31,31,31,31,31,31,31,31,31,31,31,31,31,31,31,31,31,31,31,31,31,31,31};

__device__ __forceinline__ float bflo(unsigned w) { return __uint_as_float(w << 16); }
__device__ __forceinline__ float bfhi(unsigned w) { return __uint_as_float(w & 0xffff0000u); }
__device__ __forceinline__ float bf2f(bf16_t b) { return __uint_as_float(((unsigned)b) << 16); }
__device__ __forceinline__ unsigned f2bf(float f) { unsigned u = __float_as_uint(f); return (u + 0x7fffu + ((u >> 16) & 1u)) >> 16; }
__device__ __forceinline__ unsigned pk2(float lo, float hi) { return f2bf(lo) | (f2bf(hi) << 16); }
__device__ __forceinline__ float wave_sum(float v) {
#pragma unroll
    for (int o = 1; o < 64; o <<= 1) v += __shfl_xor(v, o);
    return v;
}
__device__ __forceinline__ float wave_max(float v) {
#pragma unroll
    for (int o = 1; o < 64; o <<= 1) v = fmaxf(v, __shfl_xor(v, o));
    return v;
}
__device__ __forceinline__ float dot8(const u32x4 a, const u32x4 b) {
    return bflo(a.x) * bflo(b.x) + bfhi(a.x) * bfhi(b.x) + bflo(a.y) * bflo(b.y) + bfhi(a.y) * bfhi(b.y)
         + bflo(a.z) * bflo(b.z) + bfhi(a.z) * bfhi(b.z) + bflo(a.w) * bflo(b.w) + bfhi(a.w) * bfhi(b.w);
}
__device__ __forceinline__ float gelu_erf(float a) { return 0.5f * a * (1.0f + erff(a * 0.70710678118654752f)); }
#define LDS_WAIT() asm volatile("s_waitcnt lgkmcnt(0)" ::: "memory")
#define VM_WAIT() asm volatile("s_waitcnt vmcnt(0)" ::: "memory")

#define XB_TMO      128
#define XB_XCNT(j)  (256  + 64 * (j))
#define XB_XSUB(j)  (1280 + 64 * (j))
#define XB_XGEN(j)  (2304 + 64 * (j))
#define XB_TOP      3328
#define XB_TOPGEN   3392
#define XCD_BAR_WORDS 3456
#define XB_SPIN_CAP (1u << 18)
__device__ __forceinline__ unsigned xb_ld(unsigned* p)              { return __hip_atomic_load(p, __ATOMIC_RELAXED, __HIP_MEMORY_SCOPE_AGENT); }
__device__ __forceinline__ unsigned xb_add(unsigned* p, unsigned v) { return __hip_atomic_fetch_add(p, v, __ATOMIC_RELAXED, __HIP_MEMORY_SCOPE_AGENT); }
__device__ __forceinline__ unsigned xb_xcc_id() { return (unsigned)__builtin_amdgcn_s_getreg((3 << 11) | 20) & 0xFu; }
#define XB_SPIN(cond, bar) do { unsigned _sp = 0; while (cond) { __builtin_amdgcn_s_sleep(1); \
    if ((++_sp & 255u) == 0u) { if (xb_ld(&(bar)[XB_TMO])) break; if (_sp > XB_SPIN_CAP) { atomicAdd(&(bar)[XB_TMO], 1u); break; } } } } while (0)
struct XcdBarrier { unsigned* bar; unsigned x; volatile LAS unsigned* st; };
__device__ __forceinline__ XcdBarrier xcd_barrier_post(unsigned* bar, volatile LAS unsigned* st) {
    XcdBarrier b; b.bar = bar; b.x = xb_xcc_id(); b.st = st;
    if (threadIdx.x == 0) (void)xb_add(&bar[XB_XCNT(b.x)], 1u);
    return b;
}
__device__ __forceinline__ void xcd_barrier_complete(unsigned* bar, unsigned x, unsigned& nloc, unsigned& nx) {
    const unsigned G = gridDim.x * gridDim.y * gridDim.z;
    unsigned sum, cnt, mine, sp = 0u;
    for (;;) {
        sum = 0u; cnt = 0u; mine = 0u;
#pragma unroll
        for (unsigned j = 0; j < 16; ++j) { const unsigned c = xb_ld(&bar[XB_XCNT(j)]); sum += c; cnt += (c > 0u) ? 1u : 0u; mine = (j == x) ? c : mine; }
        if (sum == G) break;
        __builtin_amdgcn_s_sleep(1);
        if ((++sp & 255u) == 0u) { if (xb_ld(&bar[XB_TMO])) break; if (sp > XB_SPIN_CAP) { atomicAdd(&bar[XB_TMO], 1u); break; } }
    }
    nloc = mine > 0u ? mine : 1u; nx = cnt > 0u ? cnt : 1u;
}
__device__ __forceinline__ void xcd_barrier(const XcdBarrier& b) {
    asm volatile("s_waitcnt vmcnt(0)" ::: "memory");
    __syncthreads();
    if (threadIdx.x == 0) {
        unsigned* bar = b.bar;
        __builtin_amdgcn_s_waitcnt(0);
        unsigned nloc = b.st[0], nx = b.st[1];
        if (nloc == 0u) { xcd_barrier_complete(bar, b.x, nloc, nx); b.st[0] = nloc; b.st[1] = nx; }
        const unsigned old = xb_add(&bar[XB_XSUB(b.x)], 1u);
        const unsigned gen = old / nloc;
        if (old + 1u == (gen + 1u) * nloc) {
            __builtin_amdgcn_fence(__ATOMIC_RELEASE, "agent");
            asm volatile("s_waitcnt vmcnt(0)" ::: "memory");
            const unsigned og = xb_add(&bar[XB_TOP], 1u);
            const unsigned tg = og / nx;
            if (og + 1u == (tg + 1u) * nx) xb_add(&bar[XB_TOPGEN], 1u);
            else XB_SPIN(xb_ld(&bar[XB_TOPGEN]) == tg, bar);
            __builtin_amdgcn_fence(__ATOMIC_ACQUIRE, "agent");
            xb_add(&bar[XB_XGEN(b.x)], 1u);
            asm volatile("s_waitcnt vmcnt(0)" ::: "memory");
        } else {
            XB_SPIN(xb_ld(&bar[XB_XGEN(b.x)]) == gen, bar);
            __builtin_amdgcn_fence(__ATOMIC_ACQUIRE, "agent");
            asm volatile("s_waitcnt vmcnt(0)" ::: "memory");
        }
    }
    __syncthreads();
}

#define EPI_STEP(m) (((m) == 3) ? (128 - 48) : 16)
struct EpiG1 {
    static constexpr bool PERM = true, AFTER_DRAIN = false;
    bf16_t *PA, *PB, *PQKV, *PG; const float* rstd;
    __device__ __forceinline__ void operator()(const f32x4 (&acc)[2][2][4][2], const Unit& u, int wr, int wc, int fr, int fq) const {
        const int pn = u.pn;
        bf16_t* base; int ldc, colt, act; float sc = 1.f;
        if (pn < 8) { base = PA; ldc = 2048; colt = pn * 256; act = 1; }
        else if (pn < 12) { base = PB; ldc = 1024; colt = (pn - 8) * 256; act = 0; }
        else if (pn < 30) { base = PQKV; ldc = 4608; colt = (pn - 12) * 256; act = 0; if (pn < 18) sc = 0.08838834764831845f; }
        else { base = PG; ldc = 6144; colt = (pn - 30) * 256; act = 2; }
        const int row0 = u.pm * 256 + wr * 64 + fr, col0 = colt + wc * 32 + 8 * fq;
        GAS bf16_t* rowp = (GAS bf16_t*)(base + (size_t)row0 * ldc + col0); const GAS float* rp = (const GAS float*)(rstd + row0);
#pragma unroll
        for (int ai = 0; ai < 2; ++ai)
#pragma unroll
            for (int m = 0; m < 4; ++m) {
                const float r = *rp * sc;
#pragma unroll
                for (int bj = 0; bj < 2; ++bj) { f32x4 v0 = acc[ai][bj][m][0] * r, v1 = acc[ai][bj][m][1] * r;
                    if (act == 1) { f32x2 a = pg8::gelu_pk((f32x2){v0[0], v0[1]}), b = pg8::gelu_pk((f32x2){v0[2], v0[3]}), c = pg8::gelu_pk((f32x2){v1[0], v1[1]}), d = pg8::gelu_pk((f32x2){v1[2], v1[3]});
                        v0 = (f32x4){a.x, a.y, b.x, b.y}; v1 = (f32x4){c.x, c.y, d.x, d.y}; }
                    else if (act == 2) {
#pragma unroll
                        for (int j = 0; j < 4; ++j) { v0[j] = __builtin_amdgcn_rcpf(1.0f + __expf(-v0[j])); v1[j] = __builtin_amdgcn_rcpf(1.0f + __expf(-v1[j])); } }
                    u32x4 w; w.x = pk2(v0[0], v0[1]); w.y = pk2(v0[2], v0[3]); w.z = pk2(v1[0], v1[1]); w.w = pk2(v1[2], v1[3]);
                    *(GAS u32x4*)(rowp + bj * 128) = w; }
                rowp += (size_t)EPI_STEP(m) * ldc; rp += EPI_STEP(m);
                asm volatile("" : "+v"(rowp), "+v"(rp) :: "memory");
            }
    }
};
template <int FIRST> struct EpiBranch {
    static constexpr bool PERM = true, AFTER_DRAIN = false;
    bf16_t* MG; const bf16_t* gate;
    __device__ __forceinline__ void operator()(const f32x4 (&acc)[2][2][4][2], const Unit& u, int wr, int wc, int fr, int fq) const {
        const int row0 = u.pm * 256 + wr * 64 + fr, col0 = u.pn * 256 + wc * 32 + 8 * fq;
        const GAS bf16_t* gp = (const GAS bf16_t*)(gate + (size_t)row0 * 6144 + col0); GAS bf16_t* mp = (GAS bf16_t*)(MG + (size_t)row0 * 2048 + col0);
#pragma unroll
        for (int ai = 0; ai < 2; ++ai)
#pragma unroll
            for (int m = 0; m < 4; ++m) {
#pragma unroll
                for (int bj = 0; bj < 2; ++bj) {
                    const u32x4 g = *(const GAS u32x4*)(gp + bj * 128);
                    f32x4 v0 = acc[ai][bj][m][0], v1 = acc[ai][bj][m][1];
                    v0[0] *= bflo(g.x); v0[1] *= bfhi(g.x); v0[2] *= bflo(g.y); v0[3] *= bfhi(g.y);
                    v1[0] *= bflo(g.z); v1[1] *= bfhi(g.z); v1[2] *= bflo(g.w); v1[3] *= bfhi(g.w);
                    GAS u32x4* dst = (GAS u32x4*)(mp + bj * 128);
                    if (!FIRST) { const u32x4 o = *dst;
                        v0[0] += bflo(o.x); v0[1] += bfhi(o.x); v0[2] += bflo(o.y); v0[3] += bfhi(o.y);
                        v1[0] += bflo(o.z); v1[1] += bfhi(o.z); v1[2] += bflo(o.w); v1[3] += bfhi(o.w); }
                    u32x4 w; w.x = pk2(v0[0], v0[1]); w.y = pk2(v0[2], v0[3]); w.z = pk2(v1[0], v1[1]); w.w = pk2(v1[2], v1[3]);
                    *dst = w; }
                gp += (size_t)EPI_STEP(m) * 6144; mp += (size_t)EPI_STEP(m) * 2048;
                asm volatile("" : "+v"(gp), "+v"(mp) :: "memory");
            }
    }
};
struct EpiWout {
    static constexpr bool PERM = false, AFTER_DRAIN = false;
    const float* xin; float* xout; bf16_t* XB;
    __device__ __forceinline__ void operator()(const f32x4 (&acc)[2][2][4][2], const Unit& u, int wr, int wc, int fr, int fq) const {
        const int row0 = u.pm * 256 + wr * 64 + fr, col0 = u.pn * 256 + wc * 32 + 4 * fq;
        size_t off = (size_t)row0 * 2048 + col0;
#pragma unroll
        for (int ai = 0; ai < 2; ++ai)
#pragma unroll
            for (int m = 0; m < 4; ++m) {
#pragma unroll
                for (int bj = 0; bj < 2; ++bj)
#pragma unroll
                    for (int n = 0; n < 2; ++n) { const size_t o = off + bj * 128 + n * 16;
                        const f32x4 v = *(const GAS f32x4*)(xin + o) + acc[ai][bj][m][n];
                        *(GAS f32x4*)(xout + o) = v; u32x2 w; w.x = pk2(v[0], v[1]); w.y = pk2(v[2], v[3]); *(GAS u32x2*)(XB + o) = w; }
                off += (size_t)EPI_STEP(m) * 2048;
                asm volatile("" : "+v"(off) :: "memory"); }
    }
};
struct EpiF32 {
    static constexpr bool PERM = false, AFTER_DRAIN = false;
    float* C; int ldc;
    __device__ __forceinline__ void operator()(const f32x4 (&acc)[2][2][4][2], const Unit& u, int wr, int wc, int fr, int fq) const {
        const int row0 = u.pm * 256 + wr * 64 + fr, col0 = u.pn * 256 + wc * 32 + 4 * fq;
        GAS float* rowp = (GAS float*)(C + (size_t)row0 * ldc + col0);
#pragma unroll
        for (int ai = 0; ai < 2; ++ai)
#pragma unroll
            for (int m = 0; m < 4; ++m) {
#pragma unroll
                for (int bj = 0; bj < 2; ++bj)
#pragma unroll
                    for (int n = 0; n < 2; ++n) *(GAS f32x4*)(rowp + bj * 128 + n * 16) = acc[ai][bj][m][n];
                rowp += (size_t)EPI_STEP(m) * ldc;
                asm volatile("" : "+v"(rowp) :: "memory"); }
    }
};

struct Ctx {
    LAS unsigned char* lds;
    int tid, lane, wave, G, bx;
    float* out; unsigned char* ws;
};
constexpr int PTR_OFF = 131072 + 512;
__device__ __forceinline__ const float* inptr(const Ctx& C, int i) {
    const LAS unsigned* p = (const LAS unsigned*)(C.lds + PTR_OFF) + 2 * i;
    const unsigned lo = (unsigned)__builtin_amdgcn_readfirstlane((int)p[0]), hi = (unsigned)__builtin_amdgcn_readfirstlane((int)p[1]);
    return (const float*)(const GAS float*)(((unsigned long long)hi << 32) | lo);
}

__device__ __forceinline__ void transpose_item(const float* W, const float* g, int K, int N, bf16_t* WT, LAS float* scr, int item, int lane) {
    const int nblk = N / 32, kb = item / nblk, nb = item % nblk, k0 = 64 * kb, n0 = 32 * nb;
#pragma unroll 8
    for (int i = 0; i < 32; ++i) { const int kk = 2 * i + (lane >> 5); float w = W[(size_t)(k0 + kk) * N + n0 + (lane & 31)]; if (g) w *= g[k0 + kk]; scr[kk * 33 + (lane & 31)] = w; }
    LDS_WAIT();
    const int c = lane & 7;
#pragma unroll
    for (int j = 0; j < 4; ++j) { const int n = (lane >> 3) + 8 * j; const LAS float* s = scr + (8 * c) * 33 + n;
        u32x4 o; o.x = pk2(s[0 * 33], s[1 * 33]); o.y = pk2(s[2 * 33], s[3 * 33]); o.z = pk2(s[4 * 33], s[5 * 33]); o.w = pk2(s[6 * 33], s[7 * 33]);
        *(u32x4*)(WT + (size_t)(n0 + n) * K + k0 + 8 * c) = o; }
    LDS_WAIT();
}
__device__ __forceinline__ void cvt_rows(const Ctx& C, const float* src, const float* g, bf16_t* dst, size_t nelem) {
    const size_t n8 = nelem / 8, stride = (size_t)C.G * NTHR;
    for (size_t i = (size_t)C.bx * NTHR + C.tid; i < n8; i += stride) {
        f32x4 a = *(const f32x4*)(src + i * 8), b = *(const f32x4*)(src + i * 8 + 4);
        if (g) { const int d = (int)((i * 8) & 2047); const f32x4 ga = *(const f32x4*)(g + d), gb = *(const f32x4*)(g + d + 4); a = a * ga; b = b * gb; }
        u32x4 w; w.x = pk2(a[0], a[1]); w.y = pk2(a[2], a[3]); w.z = pk2(b[0], b[1]); w.w = pk2(b[2], b[3]);
        *(u32x4*)(dst + i * 8) = w;
    }
}
__device__ __forceinline__ void cvt_layer_weights(const Ctx& C, int l) {
    LAS float* scr = (LAS float*)(C.lds + C.wave * 16384);
    const int gw = C.bx * NWAVES + C.wave, NGW = C.G * NWAVES;
    const float* w_in = inptr(C, 3) + (size_t)l * D * INW; const float* gmix = inptr(C, 2) + (size_t)l * D;
    const float* wa = inptr(C, 9) + (size_t)l * 1024 * D; const float* wb = inptr(C, 10) + (size_t)l * 1024 * D; const float* wc = inptr(C, 11) + (size_t)l * 512 * D;
    const float* wo = inptr(C, 12) + (size_t)l * D * D;
    bf16_t* WIN = (bf16_t*)(C.ws + WS_WIN); bf16_t* WA = (bf16_t*)(C.ws + WS_WA); bf16_t* WB = (bf16_t*)(C.ws + WS_WB); bf16_t* WC = (bf16_t*)(C.ws + WS_WC);
    bf16_t* WOUT = (bf16_t*)(C.ws + WS_WOUT);
    constexpr int I_IN = (D / 64) * (INW / 32), I_A = (1024 / 64) * (D / 32), I_C = (512 / 64) * (D / 32), I_O = (D / 64) * (D / 32);
    constexpr int NITEMS = I_IN + 2 * I_A + I_C + I_O;
    for (int it = gw; it < NITEMS; it += NGW) {
        int r = it;
        if (r < I_IN) { transpose_item(w_in, gmix, D, INW, WIN, scr, r, C.lane); continue; } r -= I_IN;
        if (r < I_A) { transpose_item(wa, nullptr, 1024, D, WA, scr, r, C.lane); continue; } r -= I_A;
        if (r < I_A) { transpose_item(wb, nullptr, 1024, D, WB, scr, r, C.lane); continue; } r -= I_A;
        if (r < I_C) { transpose_item(wc, nullptr, 512, D, WC, scr, r, C.lane); continue; } r -= I_C;
        transpose_item(wo, nullptr, D, D, WOUT, scr, r, C.lane);
    }
    const size_t gt = (size_t)C.bx * NTHR + C.tid, gs = (size_t)C.G * NTHR;
    {
        const float* wq = inptr(C, 14) + (size_t)l * D * D; const float* k1 = inptr(C, 15) + (size_t)l * 128 * 128; const float* k2 = inptr(C, 16) + (size_t)l * 128 * 128;
        const float* gf = inptr(C, 13) + (size_t)l * D; bf16_t* WSC = (bf16_t*)(C.ws + WS_WSC);
        for (size_t i = gt; i < (size_t)D * D; i += gs) {
            const int n = (int)(i >> 11), k = (int)(i & 2047);
            const float* kr = ((n >> 7) & 1 ? k2 : k1) + (size_t)(n & 127) * 128; const float* wr = wq + (size_t)k * D + (n & ~127);
            float acc = 0.f;
#pragma unroll 4
            for (int c = 0; c < 128; c += 4) { const f32x4 a = *(const f32x4*)(wr + c), b = *(const f32x4*)(kr + c); acc += a[0] * b[0] + a[1] * b[1] + a[2] * b[2] + a[3] * b[3]; }
            WSC[i] = (bf16_t)f2bf(acc * gf[k]);
        }
    }
    {
        const float* ws_ = inptr(C, 5) + (size_t)l * 8 * 128 * 128; bf16_t* WM = (bf16_t*)(C.ws + WS_WM);
        for (size_t i = gt; i < (size_t)8 * 128 * 128; i += gs) { const int s = (int)(i & 127), t = (int)((i >> 7) & 127); WM[i] = (bf16_t)f2bf(s <= t ? ws_[i] : 0.f); }
    }
    {
        const float* wp = inptr(C, 7) + (size_t)l * 4 * 256 * 256; const float* sc = inptr(C, 8) + (size_t)l * 1024; bf16_t* WP = (bf16_t*)(C.ws + WS_WP);
        for (size_t i = gt; i < (size_t)4 * 256 * 256; i += gs) { const int c = (int)(i & 255), e = (int)((i >> 8) & 255), g = (int)(i >> 16); WP[i] = (bf16_t)f2bf(wp[((size_t)g * 256 + c) * 256 + e] * sc[g * 256 + e]); }
    }
}
__device__ __forceinline__ void prologue(const Ctx& C) {
    for (int l = 0; l < DEPTH; ++l) {
        cvt_rows(C, inptr(C, 17) + (size_t)l * NEXP * D, inptr(C, 13) + (size_t)l * D, (bf16_t*)(C.ws + WS_U) + (size_t)l * NEXP * D, (size_t)NEXP * D);
        cvt_rows(C, inptr(C, 18) + (size_t)l * NEXP * D, nullptr, (bf16_t*)(C.ws + WS_V) + (size_t)l * NEXP * D, (size_t)NEXP * D);
    }
    cvt_layer_weights(C, 0);
    const int gw = C.bx * NWAVES + C.wave, NGW = C.G * NWAVES;
    const float* x = inptr(C, 0); bf16_t* XB = (bf16_t*)(C.ws + WS_XB); float* RS = (float*)(C.ws + WS_RSTD);
    for (int m = gw; m < T; m += NGW) {
        const f32x4* xr = (const f32x4*)(x + (size_t)m * D) + C.lane; f32x4 v[8]; float s = 0.f;
#pragma unroll
        for (int j = 0; j < 8; ++j) { v[j] = xr[64 * j]; s += (v[j][0] * v[j][0] + v[j][1] * v[j][1]) + (v[j][2] * v[j][2] + v[j][3] * v[j][3]); }
        s = wave_sum(s);
        u32x2* o = (u32x2*)(XB + (size_t)m * D) + C.lane;
#pragma unroll
        for (int j = 0; j < 8; ++j) { u32x2 w; w.x = pk2(v[j][0], v[j][1]); w.y = pk2(v[j][2], v[j][3]); o[64 * j] = w; }
        if (C.lane == 0) RS[m] = rsqrtf(s * (1.0f / D) + EPS);
    }
}

__device__ __forceinline__ void att_naive(const Ctx& C) {
    const bf16_t* P = (const bf16_t*)(C.ws + WS_PQKV); bf16_t* OG = (bf16_t*)(C.ws + WS_OG); float* LSE = (float*)(C.ws + WS_LSE); const float* rel = inptr(C, 1);
    LAS float* pl = (LAS float*)(C.lds + C.wave * 1024);
    const int gw = C.bx * NWAVES + C.wave, NGW = C.G * NWAVES, lane = C.lane;
    for (int item = gw; item < 12 * T; item += NGW) {
        const int gh = item / T, token = item - gh * T, g = gh >> 2, h = gh & 3;
        const int d = g == 0 ? 1 : (g == 1 ? 4 : 16);
        const int tl = token & (SEQ - 1);
        const int jmax = min(128, tl / d);
        const bf16_t* qrow = P + (size_t)token * 4608 + gh * 128;
        float lg[3]; bool okk[3];
#pragma unroll
        for (int s = 0; s < 3; ++s) {
            const int j = lane + 64 * s; const bool ok = (j <= jmax); const int jj = ok ? j : 0;
            const bf16_t* krow = P + (size_t)(token - jj * d) * 4608 + 1536 + gh * 128;
            float acc = 0.f;
#pragma unroll 4
            for (int c = 0; c < 16; ++c) acc += dot8(*(const u32x4*)(qrow + c * 8), *(const u32x4*)(krow + c * 8));
            const float bias = rel[(int)kBucket[g * 129 + jj] * 12 + gh];
            lg[s] = ok ? acc + bias : -1e30f; okk[s] = ok;
        }
        const float mx = wave_max(fmaxf(lg[0], fmaxf(lg[1], lg[2])));
        const float e0 = okk[0] ? __expf(lg[0] - mx) : 0.f, e1 = okk[1] ? __expf(lg[1] - mx) : 0.f, e2 = okk[2] ? __expf(lg[2] - mx) : 0.f;
        const float ssum = wave_sum(e0 + e1 + e2);
        pl[lane] = e0; pl[lane + 64] = e1; if (lane == 0) pl[128] = e2;
        LDS_WAIT();
        float o0 = 0.f, o1 = 0.f;
        const bf16_t* vb = P + (size_t)token * 4608 + 3072 + gh * 128 + 2 * lane;
        for (int j = 0; j <= jmax; ++j) { const float p = pl[j]; const unsigned vv = *(const unsigned*)(vb - (size_t)j * d * 4608); o0 += p * bflo(vv); o1 += p * bfhi(vv); }
        const float inv = 1.0f / ssum;
        *(unsigned*)(OG + ((size_t)g * T + token) * 512 + h * 128 + 2 * lane) = pk2(o0 * inv, o1 * inv);
        if (lane == 0) LSE[((size_t)g * T + token) * 4 + h] = mx + __logf(ssum);
        LDS_WAIT();
    }
}
__device__ __forceinline__ void vss_rows(const Ctx& C) {
    const bf16_t* PA = (const bf16_t*)(C.ws + WS_PA); float* VS = (float*)(C.ws + WS_RSTD + 131072);
    const int gw = C.bx * NWAVES + C.wave, NGW = C.G * NWAVES;
    for (int m = gw; m < T; m += NGW) {
        const u32x4* r = (const u32x4*)(PA + (size_t)m * 2048 + 1024) + C.lane; float s = 0.f;
#pragma unroll
        for (int j = 0; j < 2; ++j) { const u32x4 w = r[64 * j]; s += dot8(w, w); }
        s = wave_sum(s);
        if (C.lane == 0) VS[m] = rsqrtf(s * (1.0f / 1024.0f) + EPS);
    }
}
__device__ __forceinline__ void mixa_naive(const Ctx& C, int l) {
    const bf16_t* PA = (const bf16_t*)(C.ws + WS_PA); const float* VS = (const float*)(C.ws + WS_RSTD + 131072); const bf16_t* WM = (const bf16_t*)(C.ws + WS_WM);
    bf16_t* YA = (bf16_t*)(C.ws + WS_YA); const float* ang = inptr(C, 4) + (size_t)l * 1024; const float* bs = inptr(C, 6) + (size_t)l * 1024;
    const int gw = C.bx * NWAVES + C.wave, NGW = C.G * NWAVES, lane = C.lane;
    for (int item = gw; item < 8 * T; item += NGW) {
        const int h = item / T, token = item - h * T, t = token & 127, c0 = token - t;
        float s0 = 0.f, s1 = 0.f;
        const bf16_t* wrow = WM + ((size_t)h * 128 + t) * 128;
        for (int s = 0; s <= t; ++s) { const float w = bf2f(wrow[s]) * VS[c0 + s]; const unsigned vv = *(const unsigned*)(PA + (size_t)(c0 + s) * 2048 + 1024 + h * 128 + 2 * lane); s0 += w * bflo(vv); s1 += w * bfhi(vv); }
        const float b = bs[h * 128 + t];
        const float S0 = s0 * ang[h * 128 + 2 * lane] + b, S1 = s1 * ang[h * 128 + 2 * lane + 1] + b;
        const unsigned uu = *(const unsigned*)(PA + (size_t)token * 2048 + h * 128 + 2 * lane);
        *(unsigned*)(YA + (size_t)token * 1024 + h * 128 + 2 * lane) = pk2(bflo(uu) * S0, bfhi(uu) * S1);
    }
}
__device__ __forceinline__ void mixb_naive(const Ctx& C) {
    const bf16_t* PB = (const bf16_t*)(C.ws + WS_PB); const bf16_t* WP = (const bf16_t*)(C.ws + WS_WP); bf16_t* YB = (bf16_t*)(C.ws + WS_YB);
    const int half = C.tid >> 8, c = C.tid & 255; LAS float* dsh = (LAS float*)(C.lds + half * 1024);
    for (int base = C.bx * 2; base < 4 * T; base += C.G * 2) {
        const int it = base + half, gb = it & 3, token = it >> 2, tl = token & (SEQ - 1);
        const int w = 2 << gb, cnt = min(w, tl + 1), col = gb * 256 + c;
        float sum = 0.f;
        for (int j = 0; j < cnt; ++j) sum += bf2f(PB[(size_t)(token - j) * 1024 + col]);
        dsh[c] = sum / (float)cnt - bf2f(PB[(size_t)token * 1024 + col]);
        __syncthreads();
        const bf16_t* wr = WP + ((size_t)gb * 256 + c) * 256; float y = 0.f;
#pragma unroll 4
        for (int k = 0; k < 256; k += 8) { const u32x4 wv = *(const u32x4*)(wr + k);
            y += dsh[k] * bflo(wv.x) + dsh[k + 1] * bfhi(wv.x) + dsh[k + 2] * bflo(wv.y) + dsh[k + 3] * bfhi(wv.y) + dsh[k + 4] * bflo(wv.z) + dsh[k + 5] * bfhi(wv.z) + dsh[k + 6] * bflo(wv.w) + dsh[k + 7] * bfhi(wv.w); }
        YB[(size_t)token * 1024 + col] = (bf16_t)f2bf(y);
        __syncthreads();
    }
}
__device__ __forceinline__ void combine_groups(const Ctx& C) {
    const bf16_t* OG = (const bf16_t*)(C.ws + WS_OG); const float* LSE = (const float*)(C.ws + WS_LSE); bf16_t* YC = (bf16_t*)(C.ws + WS_YC);
    const int gw = C.bx * NWAVES + C.wave, NGW = C.G * NWAVES, lane = C.lane, h = lane >> 4;
    for (int m = gw; m < T; m += NGW) {
        const float l0 = LSE[((size_t)0 * T + m) * 4 + h], l1 = LSE[((size_t)1 * T + m) * 4 + h], l2 = LSE[((size_t)2 * T + m) * 4 + h];
        const float mx = fmaxf(l0, fmaxf(l1, l2)); float w0 = __expf(l0 - mx), w1 = __expf(l1 - mx), w2 = __expf(l2 - mx); const float inv = 1.0f / (w0 + w1 + w2); w0 *= inv; w1 *= inv; w2 *= inv;
        const u32x4 a = *((const u32x4*)(OG + ((size_t)0 * T + m) * 512) + lane), b = *((const u32x4*)(OG + ((size_t)1 * T + m) * 512) + lane), c = *((const u32x4*)(OG + ((size_t)2 * T + m) * 512) + lane);
        u32x4 o;
        o.x = pk2(w0 * bflo(a.x) + w1 * bflo(b.x) + w2 * bflo(c.x), w0 * bfhi(a.x) + w1 * bfhi(b.x) + w2 * bfhi(c.x));
        o.y = pk2(w0 * bflo(a.y) + w1 * bflo(b.y) + w2 * bflo(c.y), w0 * bfhi(a.y) + w1 * bfhi(b.y) + w2 * bfhi(c.y));
        o.z = pk2(w0 * bflo(a.z) + w1 * bflo(b.z) + w2 * bflo(c.z), w0 * bfhi(a.z) + w1 * bfhi(b.z) + w2 * bfhi(c.z));
        o.w = pk2(w0 * bflo(a.w) + w1 * bflo(b.w) + w2 * bflo(c.w), w0 * bfhi(a.w) + w1 * bfhi(b.w) + w2 * bfhi(c.w));
        *((u32x4*)(YC + (size_t)m * 512) + lane) = o;
    }
}
__device__ __forceinline__ void peer_naive(const Ctx& C, int l, bool last) {
    LAS float* xs = (LAS float*)(C.lds); LAS float* sc = (LAS float*)(C.lds + 8192);
    LAS float* v1s = (LAS float*)(C.lds + 16384); LAS int* i1s = (LAS int*)(C.lds + 16896); LAS float* v2s = (LAS float*)(C.lds + 17408); LAS int* i2s = (LAS int*)(C.lds + 17920);
    LAS int* ex = (LAS int*)(C.lds + 18432); LAS float* gt = (LAS float*)(C.lds + 18944); LAS float* hs = (LAS float*)(C.lds + 19456); LAS float* red = (LAS float*)(C.lds + 19968);
    LAS float* selv = (LAS float*)(C.lds + 20480); LAS int* sele = (LAS int*)(C.lds + 20992);
    const float* SC = (const float*)(C.ws + WS_PQKV); const bf16_t* U = (const bf16_t*)(C.ws + WS_U) + (size_t)l * NEXP * D; const bf16_t* V = (const bf16_t*)(C.ws + WS_V) + (size_t)l * NEXP * D;
    bf16_t* XB = (bf16_t*)(C.ws + WS_XB); float* RS = (float*)(C.ws + WS_RSTD); const float* fg = inptr(C, 19);
    const int tid = C.tid, lane = C.lane, wave = C.wave, h = wave;
    for (int token = C.bx; token < T; token += C.G) {
        const f32x4 xv = *((const f32x4*)(C.out + (size_t)token * D) + tid);
        *((LAS f32x4*)xs + tid) = xv; *((LAS f32x4*)sc + tid) = *((const f32x4*)(SC + (size_t)token * D) + tid);
        float ss = wave_sum((xv[0] * xv[0] + xv[1] * xv[1]) + (xv[2] * xv[2] + xv[3] * xv[3]));
        if (lane == 0) red[wave] = ss;
        __syncthreads();
        ss = 0.f;
#pragma unroll
        for (int i = 0; i < 8; ++i) ss += red[i];
        const float rstd = rsqrtf(ss * (1.0f / D) + EPS);
#pragma unroll
        for (int half = 0; half < 2; ++half) { const LAS float* src = sc + h * 256 + half * 128; LAS float* vd = half ? v2s : v1s; LAS int* id = half ? i2s : i1s;
#pragma unroll
            for (int q = 0; q < 2; ++q) { const int j = lane + 64 * q; const float v = src[j]; int rank = 0;
                for (int i = 0; i < 128; ++i) { const float u = src[i]; rank += (u > v || (u == v && i < j)) ? 1 : 0; }
                if (rank < 16) { vd[h * 16 + rank] = v; id[h * 16 + rank] = j; } } }
        __syncthreads();
#pragma unroll
        for (int q = 0; q < 4; ++q) { const int pos = lane + 64 * q; const float cv = v1s[h * 16 + (pos >> 4)] + v2s[h * 16 + (pos & 15)]; int rank = 0;
            for (int i = 0; i < 256; ++i) { const float u = v1s[h * 16 + (i >> 4)] + v2s[h * 16 + (i & 15)]; rank += (u > cv || (u == cv && i < pos)) ? 1 : 0; }
            if (rank < 16) { selv[h * 16 + rank] = cv; sele[h * 16 + rank] = i1s[h * 16 + (pos >> 4)] * 128 + i2s[h * 16 + (pos & 15)]; } }
        __syncthreads();
        { const float v = selv[h * 16 + (lane & 15)] * rstd; float mx = v;
#pragma unroll
          for (int o = 1; o < 16; o <<= 1) mx = fmaxf(mx, __shfl_xor(mx, o));
          const float e = __expf(v - mx); float sm = e;
#pragma unroll
          for (int o = 1; o < 16; o <<= 1) sm += __shfl_xor(sm, o);
          if (lane < 16) { gt[h * 16 + lane] = e / sm; ex[h * 16 + lane] = sele[h * 16 + lane]; } }
        __syncthreads();
        { float xr[32];
#pragma unroll
          for (int i = 0; i < 4; ++i) { const f32x4 a = *(const LAS f32x4*)(xs + i * 512 + lane * 8), b = *(const LAS f32x4*)(xs + i * 512 + lane * 8 + 4);
              xr[i * 8 + 0] = a[0]; xr[i * 8 + 1] = a[1]; xr[i * 8 + 2] = a[2]; xr[i * 8 + 3] = a[3]; xr[i * 8 + 4] = b[0]; xr[i * 8 + 5] = b[1]; xr[i * 8 + 6] = b[2]; xr[i * 8 + 7] = b[3]; }
          for (int kk = 0; kk < 16; ++kk) { const int k = wave * 16 + kk; const bf16_t* urow = U + (size_t)ex[k] * D; float acc = 0.f;
#pragma unroll
              for (int i = 0; i < 4; ++i) { const u32x4 uv = *(const u32x4*)(urow + i * 512 + lane * 8);
                  acc += xr[i * 8 + 0] * bflo(uv.x) + xr[i * 8 + 1] * bfhi(uv.x) + xr[i * 8 + 2] * bflo(uv.y) + xr[i * 8 + 3] * bfhi(uv.y)
                       + xr[i * 8 + 4] * bflo(uv.z) + xr[i * 8 + 5] * bfhi(uv.z) + xr[i * 8 + 6] * bflo(uv.w) + xr[i * 8 + 7] * bfhi(uv.w); }
              acc = wave_sum(acc);
              if (lane == 0) hs[k] = gelu_erf(acc * rstd) * gt[k]; } }
        __syncthreads();
        float y0 = 0.f, y1 = 0.f, y2 = 0.f, y3 = 0.f;
#pragma unroll 8
        for (int k = 0; k < 128; ++k) { const float hk = hs[k]; const u32x2 vv = *(const u32x2*)(V + (size_t)ex[k] * D + tid * 4);
            y0 += hk * bflo(vv.x); y1 += hk * bfhi(vv.x); y2 += hk * bflo(vv.y); y3 += hk * bfhi(vv.y); }
        f32x4 xn; xn[0] = xv[0] + y0; xn[1] = xv[1] + y1; xn[2] = xv[2] + y2; xn[3] = xv[3] + y3;
        float s2 = wave_sum((xn[0] * xn[0] + xn[1] * xn[1]) + (xn[2] * xn[2] + xn[3] * xn[3]));
        if (lane == 0) red[8 + wave] = s2;
        __syncthreads();
        s2 = 0.f;
#pragma unroll
        for (int i = 0; i < 8; ++i) s2 += red[8 + i];
        const float rstd2 = rsqrtf(s2 * (1.0f / D) + EPS);
        if (last) { const f32x4 g = *((const f32x4*)fg + tid); f32x4 o; o[0] = xn[0] * rstd2 * g[0]; o[1] = xn[1] * rstd2 * g[1]; o[2] = xn[2] * rstd2 * g[2]; o[3] = xn[3] * rstd2 * g[3];
            *((f32x4*)(C.out + (size_t)token * D) + tid) = o; }
        else { *((f32x4*)(C.out + (size_t)token * D) + tid) = xn; u32x2 w; w.x = pk2(xn[0], xn[1]); w.y = pk2(xn[2], xn[3]); *((u32x2*)(XB + (size_t)token * D) + tid) = w;
            if (tid == 0) RS[token] = rstd2; }
        __syncthreads();
    }
}

constexpr int NPHASE = 1 + 8 * DEPTH - 1;
struct Args { const float* in[20]; float* out; unsigned char* ws; int ph_lo, ph_hi; };

__global__ void __launch_bounds__(NTHR, 2) fwd(Args args) {
    extern __shared__ __attribute__((aligned(16))) unsigned char lds_raw[];
    Ctx C;
    C.lds = (LAS unsigned char*)lds_raw; C.tid = threadIdx.x; C.lane = C.tid & 63; C.wave = __builtin_amdgcn_readfirstlane(C.tid >> 6); C.G = gridDim.x; C.bx = blockIdx.x;
    C.out = args.out; C.ws = args.ws;
    PG8_LAS unsigned char* lds = (PG8_LAS unsigned char*)lds_raw;
    volatile LAS unsigned* MISC = (volatile LAS unsigned*)(lds + MISC_OFF);
    for (int u = C.tid; u < (LDS_BYTES - RING_BYTES) / 4; u += NTHR) ((LAS unsigned*)(lds + RING_BYTES))[u] = 0u;
    __syncthreads();
    if (C.tid < 20) { const unsigned long long pv = (unsigned long long)args.in[C.tid]; LAS unsigned* p = (LAS unsigned*)(lds + PTR_OFF) + 2 * C.tid; p[0] = (unsigned)pv; p[1] = (unsigned)(pv >> 32); }
    __syncthreads();
    const int lo = args.ph_lo, hi = args.ph_hi;
    unsigned* barw = (unsigned*)(C.ws + WS_CTL) + CW_BAR;
    XcdBarrier bar; bar.bar = barw; bar.x = 0; bar.st = nullptr;
    if (hi - lo > 1) bar = xcd_barrier_post(barw, MISC + 8);
#ifndef PH_MASK
#define PH_MASK 0xFF
#endif
#define PHEN(i) (((PH_MASK) >> (i)) & 1)
#define IN(k) (lo <= (k) && (k) < hi)
#define SEAM(k) do { if (IN(k) && IN((k) + 1)) xcd_barrier(bar); } while (0)

#define PHASE_CTX() Ctx P; P.lds = C.lds; P.out = C.out; P.ws = C.ws; P.G = C.G; P.bx = C.bx; P.tid = C.tid; \
    asm volatile("" : "+s"(P.out), "+s"(P.ws), "+s"(P.G), "+s"(P.bx), "+v"(P.tid)); \
    P.out = (float*)(GAS float*)P.out; P.ws = (unsigned char*)(GAS unsigned char*)P.ws; P.lane = P.tid & 63; P.wave = __builtin_amdgcn_readfirstlane(P.tid >> 6)
    if (PHEN(0) && IN(0)) { PHASE_CTX(); prologue(P); SEAM(0); }
    for (int l = 0; l < DEPTH; ++l) {
        const int base = 1 + 8 * l;
        if (PHEN(1) && IN(base + 0)) {
            PHASE_CTX();
            pg8::Gemm g{(const bf16_t*)(P.ws + WS_XB), (const bf16_t*)(P.ws + WS_WIN), T, INW, D}; pg8::StaticOrder S; S.init(T, INW, P.G, P.bx);
            EpiG1 E{(bf16_t*)(P.ws + WS_PA), (bf16_t*)(P.ws + WS_PB), (bf16_t*)(P.ws + WS_PQKV), (bf16_t*)(P.ws + WS_PG), (const float*)(P.ws + WS_RSTD)};
            pg8::gemm_phase<EpiG1, pg8::StaticOrder, false>(lds, g, S, E, nullptr);
            SEAM(base + 0);
        }
        if (PHEN(2) && IN(base + 1)) { PHASE_CTX(); att_naive(P); vss_rows(P); SEAM(base + 1); }
        if (PHEN(3) && IN(base + 2)) { PHASE_CTX(); mixa_naive(P, l); mixb_naive(P); combine_groups(P); SEAM(base + 2); }
        if (PHEN(4) && IN(base + 3)) {
            { PHASE_CTX(); bf16_t* MG = (bf16_t*)(P.ws + WS_PA); const bf16_t* PG = (const bf16_t*)(P.ws + WS_PG); pg8::StaticOrder S; S.init(T, D, P.G, P.bx);
              pg8::Gemm g{(const bf16_t*)(P.ws + WS_YA), (const bf16_t*)(P.ws + WS_WA), T, D, 1024}; EpiBranch<1> E{MG, PG}; pg8::gemm_phase<EpiBranch<1>, pg8::StaticOrder, false>(lds, g, S, E, nullptr); }
            __syncthreads();
            { PHASE_CTX(); bf16_t* MG = (bf16_t*)(P.ws + WS_PA); const bf16_t* PG = (const bf16_t*)(P.ws + WS_PG); pg8::StaticOrder S; S.init(T, D, P.G, P.bx);
              pg8::Gemm g{(const bf16_t*)(P.ws + WS_YB), (const bf16_t*)(P.ws + WS_WB), T, D, 1024}; EpiBranch<0> E{MG, PG + 2048}; pg8::gemm_phase<EpiBranch<0>, pg8::StaticOrder, false>(lds, g, S, E, nullptr); }
            __syncthreads();
            { PHASE_CTX(); bf16_t* MG = (bf16_t*)(P.ws + WS_PA); const bf16_t* PG = (const bf16_t*)(P.ws + WS_PG); pg8::StaticOrder S; S.init(T, D, P.G, P.bx);
              pg8::Gemm g{(const bf16_t*)(P.ws + WS_YC), (const bf16_t*)(P.ws + WS_WC), T, D, 512}; EpiBranch<0> E{MG, PG + 4096}; pg8::gemm_phase<EpiBranch<0>, pg8::StaticOrder, false>(lds, g, S, E, nullptr); }
            SEAM(base + 3);
        }
        if (PHEN(5) && IN(base + 4)) {
            PHASE_CTX();
            pg8::Gemm g{(const bf16_t*)(P.ws + WS_PA), (const bf16_t*)(P.ws + WS_WOUT), T, D, D}; pg8::StaticOrder S; S.init(T, D, P.G, P.bx);
            const float* xin0 = inptr(P, 0); EpiWout E{l == 0 ? xin0 : P.out, P.out, (bf16_t*)(P.ws + WS_XB)};
            pg8::gemm_phase<EpiWout, pg8::StaticOrder, false>(lds, g, S, E, nullptr);
            SEAM(base + 4);
        }
        if (PHEN(6) && IN(base + 5)) {
            PHASE_CTX();
            pg8::Gemm g{(const bf16_t*)(P.ws + WS_XB), (const bf16_t*)(P.ws + WS_WSC), T, D, D}; pg8::StaticOrder S; S.init(T, D, P.G, P.bx);
            EpiF32 E{(float*)(P.ws + WS_PQKV), D};
            pg8::gemm_phase<EpiF32, pg8::StaticOrder, false>(lds, g, S, E, nullptr);
            SEAM(base + 5);
        }
        if (PHEN(7) && IN(base + 6)) { PHASE_CTX(); peer_naive(P, l, l == DEPTH - 1); if (l + 1 < DEPTH) SEAM(base + 6); }
        if (PHEN(0) && l + 1 < DEPTH && IN(base + 7)) { PHASE_CTX(); cvt_layer_weights(P, l + 1); SEAM(base + 7); }
    }
#undef IN
#undef SEAM
}
}

#ifndef MK_ONE_LAUNCH
#define MK_ONE_LAUNCH 1
#endif
extern "C" void kernel_launch(void* const* d_in, const int* in_sizes, int n_in, void* d_out, int out_size, void* d_ws, size_t ws_size, hipStream_t stream) {
    using namespace mk;
    static int grid = 0;
    if (grid == 0) {
        if (n_in != 20 || in_sizes[0] != T * D || out_size != T * D || ws_size < WS_END) { fprintf(stderr, "kernel_launch: unexpected shapes (n_in %d, in0 %d, out %d, ws %zu < %zu); nothing launched\n", n_in, n_in > 0 ? in_sizes[0] : -1, out_size, ws_size, (size_t)WS_END); grid = -1; return; }
        int dev = 0, cus = 0, per_cu = 0;
        if (hipGetDevice(&dev) != hipSuccess || hipDeviceGetAttribute(&cus, hipDeviceAttributeMultiprocessorCount, dev) != hipSuccess) { fprintf(stderr, "kernel_launch: device query failed\n"); grid = -1; return; }
        if (hipFuncSetAttribute((const void*)fwd, hipFuncAttributeMaxDynamicSharedMemorySize, LDS_BYTES) != hipSuccess) { fprintf(stderr, "kernel_launch: hipFuncSetAttribute failed\n"); grid = -1; return; }
        if (hipOccupancyMaxActiveBlocksPerMultiprocessor(&per_cu, (const void*)fwd, NTHR, LDS_BYTES) != hipSuccess || per_cu < 1) fprintf(stderr, "kernel_launch: note: occupancy query reports %d workgroups per CU\n", per_cu);
        (void)hipGetLastError();
        grid = cus;
    }
    if (grid < 0) return;
    if (hipMemsetAsync((char*)d_ws + WS_CTL, 0, CTL_ZERO_BYTES, stream) != hipSuccess) { fprintf(stderr, "kernel_launch: memset failed\n"); return; }
    Args a{};
    for (int i = 0; i < 20; ++i) a.in[i] = (const float*)d_in[i];
    a.out = (float*)d_out; a.ws = (unsigned char*)d_ws;
#if MK_ONE_LAUNCH
    a.ph_lo = 0; a.ph_hi = NPHASE;
    hipLaunchKernelGGL(fwd, dim3(grid), dim3(NTHR), LDS_BYTES, stream, a);
#else
    for (int p = 0; p < NPHASE; ++p) { a.ph_lo = p; a.ph_hi = p + 1; hipLaunchKernelGGL(fwd, dim3(grid), dim3(NTHR), LDS_BYTES, stream, a); }
#endif
    const hipError_t le = hipPeekAtLastError();
    if (le != hipSuccess) fprintf(stderr, "kernel_launch: launch failed: %s\n", hipGetErrorName(le));
}
```

```cpp
#include <hip/hip_runtime.h>
#include <cstdio>
#include <cstdint>
namespace pg8 {
#define PG8_LAS __attribute__((address_space(3)))
typedef unsigned short bf16_t;
typedef short bf16x8 __attribute__((ext_vector_type(8)));
typedef float f32x4 __attribute__((ext_vector_type(4)));
typedef unsigned u32x4 __attribute__((ext_vector_type(4)));
constexpr int BM = 256, BK = 64, HALF = 128, HTB = HALF * BK * 2  , STAGE_BYTES = 8 * HTB, NXCD = 8, WGM = 8;

__host__ __device__ __forceinline__ int lds_byte(int r, int c) { const int st = (r >> 4) * 2 + (c >> 5), rr = r & 15, cc = c & 31, ob = rr * 64 + cc * 2; return st * 1024 + (ob ^ (((ob >> 9) & 1) << 5)); }
__host__ __device__ __forceinline__ void stage_rc(int b, int& R, int& C) { const int st = b / 1024, sb = b % 1024, swz = sb ^ (((sb >> 9) & 1) << 5); R = (st >> 1) * 16 + swz / 64; C = (st & 1) * 32 + (swz % 64) / 2; }
__host__ __device__ __forceinline__ int perm32(int rho) { const int n = rho >> 4, i = rho & 15; return 8 * (i >> 2) + 4 * n + (i & 3); }
__host__ __device__ __forceinline__ int perm32b(int rho) { const int n = rho >> 4, i = rho & 15; return 16 * (i >> 2) + 4 * n + (i & 3); }

struct Unit { int pm, pn; };
struct Gemm { const bf16_t* A; const bf16_t* Bt; int M, N, K; };

struct StaticOrder {
    int nM, nN, nwg, G, c;
    __host__ __device__ void init(int M, int N, int G_, int c_) { nM = M / BM; nN = N / BM; nwg = nM * nN; G = G_; c = c_; }
    __host__ __device__ bool next(int i, Unit& u) const {
        const long L = (long)i * G + c; if (L >= nwg) return false;
        int wgid = (int)L; { const int q = nwg / NXCD, r = nwg % NXCD, xcd = wgid % NXCD, off = wgid / NXCD; wgid = (xcd < r ? xcd * (q + 1) : r * (q + 1) + (xcd - r) * q) + off; }
        const int nig = WGM * nN, gid = wgid / nig, fm = gid * WGM, gsz = (nM - fm) < WGM ? (nM - fm) : WGM;
        u.pm = fm + ((wgid % nig) % gsz); u.pn = (wgid % nig) / gsz; return true;
    }
    __device__ __forceinline__ void a_ready(const Unit&) const {}
    __device__ __forceinline__ void done(const Unit&) const {}
};
struct CountedOrder : StaticOrder {
    const unsigned* ready; unsigned need; unsigned* tmo;
    __device__ __forceinline__ void a_ready(const Unit& u) const {
        if (threadIdx.x < 64) {
            const unsigned long long t0 = __builtin_amdgcn_s_memrealtime(); unsigned polls = 0;
            while ((unsigned)__builtin_amdgcn_readfirstlane(__hip_atomic_load(ready + 64 * u.pm, __ATOMIC_RELAXED, __HIP_MEMORY_SCOPE_AGENT)) < need) {
                if ((++polls & 255u) == 0u && __builtin_amdgcn_readfirstlane(__hip_atomic_load(tmo, __ATOMIC_RELAXED, __HIP_MEMORY_SCOPE_AGENT)) != 0u) break;
                if (__builtin_amdgcn_s_memrealtime() - t0 > 2000000ull) {
                    if (threadIdx.x == 0) { unsigned expect = 0u; __hip_atomic_compare_exchange_strong(tmo + 1, &expect, 0x600u | (unsigned)(u.pm & 0xff), __ATOMIC_RELAXED, __ATOMIC_RELAXED, __HIP_MEMORY_SCOPE_AGENT); __hip_atomic_store(tmo, 1u, __ATOMIC_RELAXED, __HIP_MEMORY_SCOPE_AGENT); }
                    break; }
                __builtin_amdgcn_s_sleep(2); }
            __builtin_amdgcn_fence(__ATOMIC_ACQUIRE, "agent");
            asm volatile("s_waitcnt vmcnt(0)" ::: "memory");
        }
#if !defined(BROKEN_HOOK_NO_BARRIER)
        asm volatile("" ::: "memory"); __builtin_amdgcn_s_barrier(); asm volatile("" ::: "memory");
#endif
    }
};

__device__ __forceinline__ unsigned cvt_pk_bf16(float lo, float hi) { unsigned r; asm volatile("v_cvt_pk_bf16_f32 %0, %1, %2" : "=v"(r) : "v"(lo), "v"(hi)); return r; }
typedef float f32x2 __attribute__((ext_vector_type(2)));
__device__ __forceinline__ f32x2 gelu_pk(f32x2 v) {
    const f32x2 av = __builtin_elementwise_abs(v), d = av * 0.2316418882f + 1.0f;
    f32x2 t; t.x = __builtin_amdgcn_rcpf(d.x); t.y = __builtin_amdgcn_rcpf(d.y);
    f32x2 q = t * 0.5307027145f + (-0.7265760135f); q = q * t + 0.7107068705f; q = q * t + (-0.142248368f); q = q * t + 0.127414796f; q = q * t;
    const f32x2 s = (v * v) * (-0.72134752044f);
    f32x2 e; e.x = __builtin_amdgcn_exp2f(s.x); e.y = __builtin_amdgcn_exp2f(s.y);
    const f32x2 m = v * (q * e), r = v - m;
    f32x2 o; o.x = v.x < 0.f ? m.x : r.x; o.y = v.y < 0.f ? m.y : r.y; return o;
}

struct EpiF32 {
    static constexpr bool PERM = false, AFTER_DRAIN = false, HOOK = false;
    float* C; int ldc; const float* bias;
    __device__ __forceinline__ void operator()(const f32x4 (&acc)[2][2][4][2], const Unit& u, int wr, int wc, int fr, int fq) const {
        const int row0 = u.pm * BM + wr * 64 + fr, col0 = u.pn * BM + wc * 32 + 4 * fq;
        f32x4 bv[2][2];
#pragma unroll
        for (int bj = 0; bj < 2; ++bj)
#pragma unroll
            for (int n = 0; n < 2; ++n) bv[bj][n] = bias ? *(const f32x4*)(bias + col0 + bj * HALF + n * 16) : (f32x4){0.f, 0.f, 0.f, 0.f};
#pragma unroll
        for (int ai = 0; ai < 2; ++ai)
#pragma unroll
            for (int m = 0; m < 4; ++m) { float* rowp = C + (size_t)(row0 + ai * HALF + m * 16) * ldc + col0;
#pragma unroll
                for (int bj = 0; bj < 2; ++bj)
#pragma unroll
                    for (int n = 0; n < 2; ++n) *(f32x4*)(rowp + bj * HALF + n * 16) = acc[ai][bj][m][n] + bv[bj][n]; }
    }
};
template <int ACT  > struct EpiBf16 {
    static constexpr bool PERM = true, AFTER_DRAIN = false;
    bf16_t* O; int ldc; const float* bias; int split_cols; size_t split_stride;
    __device__ __forceinline__ void operator()(const f32x4 (&acc)[2][2][4][2], const Unit& u, int wr, int wc, int fr, int fq) const {
        const int row0 = u.pm * BM + wr * 64 + fr; int colt = u.pn * BM; bf16_t* base = O;
        if (split_cols) { const int t = colt / split_cols; base += (size_t)t * split_stride; colt -= t * split_cols; }
        const int col0 = colt + wc * 32 + 8 * fq, bcol0 = u.pn * BM + wc * 32 + 8 * fq;
        f32x4 bv[2][2];
#pragma unroll
        for (int bj = 0; bj < 2; ++bj)
#pragma unroll
            for (int n = 0; n < 2; ++n) bv[bj][n] = bias ? *(const f32x4*)(bias + bcol0 + bj * HALF + 4 * n) : (f32x4){0.f, 0.f, 0.f, 0.f};
#pragma unroll
        for (int ai = 0; ai < 2; ++ai)
#pragma unroll
            for (int m = 0; m < 4; ++m) { bf16_t* rowp = base + (size_t)(row0 + ai * HALF + m * 16) * ldc + col0;
#pragma unroll
                for (int bj = 0; bj < 2; ++bj) { f32x4 v0 = acc[ai][bj][m][0] + bv[bj][0], v1 = acc[ai][bj][m][1] + bv[bj][1];
                    if (ACT == 1) { f32x2 a = gelu_pk((f32x2){v0[0], v0[1]}), b = gelu_pk((f32x2){v0[2], v0[3]}), c = gelu_pk((f32x2){v1[0], v1[1]}), d = gelu_pk((f32x2){v1[2], v1[3]});
                        v0 = (f32x4){a.x, a.y, b.x, b.y}; v1 = (f32x4){c.x, c.y, d.x, d.y}; }
                    if (ACT == 2) {
#pragma unroll
                        for (int j = 0; j < 4; ++j) { v0[j] = 0.5f * v0[j] * (1.0f + erff(v0[j] * 0.70710678f)); v1[j] = 0.5f * v1[j] * (1.0f + erff(v1[j] * 0.70710678f)); } }
                    u32x4 w; w.x = cvt_pk_bf16(v0[0], v0[1]); w.y = cvt_pk_bf16(v0[2], v0[3]); w.z = cvt_pk_bf16(v1[0], v1[1]); w.w = cvt_pk_bf16(v1[2], v1[3]);
                    *(u32x4*)(rowp + bj * HALF) = w; } }
    }
};

struct PanelStats {
    unsigned* xbuf;
    unsigned* cnt;
    unsigned* tmo;
    int ntn; float eps;
    unsigned code;
    __device__ __forceinline__ bool run(const f32x4 (&v)[2][2][4][2], const Unit& u, int wr, int wc, int fr, int fq, PG8_LAS unsigned char* lds, int wid, int lane) const {
        typedef float f32x2v __attribute__((ext_vector_type(2)));
        PG8_LAS f32x2v* P = (PG8_LAS f32x2v*)lds;
        PG8_LAS f32x2v* S = (PG8_LAS f32x2v*)(lds + 8192);
        PG8_LAS unsigned* flag = (PG8_LAS unsigned*)(lds + 8192 + 2048);
#pragma unroll
        for (int ai = 0; ai < 2; ++ai)
#pragma unroll
            for (int m = 0; m < 4; ++m) {
                float s = 0.f;
#pragma unroll
                for (int bj = 0; bj < 2; ++bj)
#pragma unroll
                    for (int n = 0; n < 2; ++n) { const f32x4 x = v[ai][bj][m][n]; s += (x[0] + x[1]) + (x[2] + x[3]); }
                s += __shfl_xor(s, 16); s += __shfl_xor(s, 32);
                const float mw = s * (1.0f / 64.0f); float q = 0.f;
#pragma unroll
                for (int bj = 0; bj < 2; ++bj)
#pragma unroll
                    for (int n = 0; n < 2; ++n) { const f32x4 d = v[ai][bj][m][n] - mw; q += (d[0] * d[0] + d[1] * d[1]) + (d[2] * d[2] + d[3] * d[3]); }
                q += __shfl_xor(q, 16); q += __shfl_xor(q, 32);
                if (fq == 0) P[(ai * HALF + wr * 64 + m * 16 + fr) * 4 + wc] = (f32x2v){mw, q};
            }
        asm volatile("s_waitcnt lgkmcnt(0)" ::: "memory"); __builtin_amdgcn_s_barrier(); asm volatile("" ::: "memory");
#if defined(BROKEN_NO_WAIT)
        if (blockIdx.x >= 64) { const long long t0 = clock64(); while (clock64() - t0 < 60000) __builtin_amdgcn_s_sleep(8); }
#endif
        const int row = wid * 32 + (lane & 31);
        if (lane < 32) {
            const f32x2v a = P[row * 4 + 0], b = P[row * 4 + 1], c = P[row * 4 + 2], d = P[row * 4 + 3];
            const float mt = (a.x + b.x + c.x + d.x) * 0.25f;
            const float da = a.x - mt, db = b.x - mt, dc = c.x - mt, dd = d.x - mt;
            const float m2 = (a.y + b.y) + (c.y + d.y) + 64.0f * ((da * da + db * db) + (dc * dc + dd * dd));
            unsigned long long* slot = (unsigned long long*)xbuf + ((size_t)(u.pm * BM + row) * 4 + u.pn);
            __hip_atomic_store(slot, ((unsigned long long)__float_as_uint(m2) << 32) | __float_as_uint(mt), __ATOMIC_RELAXED, __HIP_MEMORY_SCOPE_AGENT);
        }
        asm volatile("s_waitcnt vmcnt(0)" ::: "memory");
        if (lane == 0) __hip_atomic_fetch_add(cnt + 64 * u.pm, 1u, __ATOMIC_RELAXED, __HIP_MEMORY_SCOPE_AGENT);
        if (wid == 0) {
            bool dead = false; const unsigned long long t0 = __builtin_amdgcn_s_memrealtime(); const unsigned want = 8u * (unsigned)ntn;
            for (;;) {
#if defined(BROKEN_NO_WAIT)
                break;
#endif
                if ((unsigned)__builtin_amdgcn_readfirstlane(__hip_atomic_load(cnt + 64 * u.pm, __ATOMIC_RELAXED, __HIP_MEMORY_SCOPE_AGENT)) >= want) break;
                if (__builtin_amdgcn_s_memrealtime() - t0 > 2000000ull) {
                    if (lane == 0) { unsigned expect = 0u; __hip_atomic_compare_exchange_strong(tmo + 1, &expect, code | (unsigned)(u.pm & 0xff), __ATOMIC_RELAXED, __ATOMIC_RELAXED, __HIP_MEMORY_SCOPE_AGENT);
                                     __hip_atomic_store(tmo, 1u, __ATOMIC_RELAXED, __HIP_MEMORY_SCOPE_AGENT); }
                    dead = true; break; }
                __builtin_amdgcn_s_sleep(2);
            }
            __builtin_amdgcn_fence(__ATOMIC_ACQUIRE, "agent");
            if (lane == 0) flag[0] = dead ? 1u : 0u;
        }
        asm volatile("s_waitcnt vmcnt(0) lgkmcnt(0)" ::: "memory"); __builtin_amdgcn_s_barrier(); asm volatile("" ::: "memory");
        const bool bad = flag[0] != 0u;
        if (lane < 32) {
            const unsigned long long* slot = (const unsigned long long*)xbuf + (size_t)(u.pm * BM + row) * 4; float mt[4], m2[4]; float ms = 0.f;
#pragma unroll
            for (int t = 0; t < 4; ++t) { if (t < ntn) { const unsigned long long w = __hip_atomic_load(slot + t, __ATOMIC_RELAXED, __HIP_MEMORY_SCOPE_AGENT); mt[t] = __uint_as_float((unsigned)w); m2[t] = __uint_as_float((unsigned)(w >> 32)); } else { mt[t] = 0.f; m2[t] = 0.f; } ms += mt[t]; }
            const float mean = ms / (float)ntn; float q = 0.f;
#pragma unroll
            for (int t = 0; t < 4; ++t) if (t < ntn) { const float dm = mt[t] - mean; q += m2[t] + 256.0f * dm * dm; }
            S[row] = (f32x2v){mean, 1.0f / sqrtf(q / (256.0f * (float)ntn) + eps)};
        }
        asm volatile("s_waitcnt lgkmcnt(0)" ::: "memory"); __builtin_amdgcn_s_barrier(); asm volatile("" ::: "memory");
        return bad;
    }
};
struct EpiLnRes {
    static constexpr bool PERM = false, AFTER_DRAIN = true;
    const float* base; float* out; int ldc; const float* bias; PanelStats st; unsigned poison;
    __device__ __forceinline__ void refuse(size_t i0, size_t stride, int M, int N) const { const float q = __builtin_nanf(""); for (size_t i = i0; i < (size_t)M * N; i += stride) out[(i / N) * ldc + i % N] = q;
        if (i0 == 0) { unsigned expect = 0u; __hip_atomic_compare_exchange_strong(st.tmo + 1, &expect, 0x7f0u, __ATOMIC_RELAXED, __ATOMIC_RELAXED, __HIP_MEMORY_SCOPE_AGENT); __hip_atomic_store(st.tmo, 1u, __ATOMIC_RELAXED, __HIP_MEMORY_SCOPE_AGENT); } }
    __device__ __forceinline__ void fused(f32x4 (&acc)[2][2][4][2], const Unit& u, int wr, int wc, int fr, int fq, PG8_LAS unsigned char* lds, int wid, int lane) const {
        typedef float f32x2v __attribute__((ext_vector_type(2)));
        const PG8_LAS f32x2v* S = (const PG8_LAS f32x2v*)(lds + 8192);
        const int col0 = u.pn * BM + wc * 32 + 4 * fq;
#pragma unroll
        for (int bj = 0; bj < 2; ++bj)
#pragma unroll
            for (int n = 0; n < 2; ++n) { const f32x4 bv = bias ? *(const f32x4*)(bias + col0 + bj * HALF + n * 16) : (f32x4){0.f, 0.f, 0.f, 0.f};
#pragma unroll
                for (int ai = 0; ai < 2; ++ai)
#pragma unroll
                    for (int m = 0; m < 4; ++m) acc[ai][bj][m][n] += bv; }
        const bool bad = st.run(acc, u, wr, wc, fr, fq, lds, wid, lane) || poison != 0u;
        const float qnan = __builtin_nanf("");
#pragma unroll
        for (int ai = 0; ai < 2; ++ai)
#pragma unroll
            for (int m = 0; m < 4; ++m) { const int r = ai * HALF + wr * 64 + m * 16 + fr; const f32x2v sr = S[r]; const size_t off = (size_t)(u.pm * BM + r) * ldc + col0;
#pragma unroll
                for (int bj = 0; bj < 2; ++bj)
#pragma unroll
                    for (int n = 0; n < 2; ++n) { const f32x4 bs = *(const f32x4*)(base + off + bj * HALF + n * 16); f32x4 o = bs + (acc[ai][bj][m][n] - sr.x) * sr.y;
                        if (bad) o = (f32x4){qnan, qnan, qnan, qnan}; *(f32x4*)(out + off + bj * HALF + n * 16) = o; }
                asm volatile("" ::: "memory"); }
    }
};
struct EpiLnResLn {
    static constexpr bool PERM = false, AFTER_DRAIN = true;
    const float* base; float* out; bf16_t* xn; int ldc; const float* bias; PanelStats st1, st2; unsigned poison;
    __device__ __forceinline__ void refuse(size_t i0, size_t stride, int M, int N) const { const float q = __builtin_nanf(""); for (size_t i = i0; i < (size_t)M * N; i += stride) { const size_t o = (i / N) * ldc + i % N; out[o] = q; xn[o] = (bf16_t)0x7fc0u; }
        if (i0 == 0) { unsigned expect = 0u; __hip_atomic_compare_exchange_strong(st1.tmo + 1, &expect, 0x7f0u, __ATOMIC_RELAXED, __ATOMIC_RELAXED, __HIP_MEMORY_SCOPE_AGENT); __hip_atomic_store(st1.tmo, 1u, __ATOMIC_RELAXED, __HIP_MEMORY_SCOPE_AGENT); } }
    __device__ __forceinline__ void fused(f32x4 (&acc)[2][2][4][2], const Unit& u, int wr, int wc, int fr, int fq, PG8_LAS unsigned char* lds, int wid, int lane) const {
        typedef float f32x2v __attribute__((ext_vector_type(2))); typedef unsigned u32x2v __attribute__((ext_vector_type(2)));
        const PG8_LAS f32x2v* S = (const PG8_LAS f32x2v*)(lds + 8192);
        const int col0 = u.pn * BM + wc * 32 + 4 * fq;
#pragma unroll
        for (int bj = 0; bj < 2; ++bj)
#pragma unroll
            for (int n = 0; n < 2; ++n) { const f32x4 bv = bias ? *(const f32x4*)(bias + col0 + bj * HALF + n * 16) : (f32x4){0.f, 0.f, 0.f, 0.f};
#pragma unroll
                for (int ai = 0; ai < 2; ++ai)
#pragma unroll
                    for (int m = 0; m < 4; ++m) acc[ai][bj][m][n] += bv; }
        bool bad = st1.run(acc, u, wr, wc, fr, fq, lds, wid, lane) || poison != 0u;
        const float qnan = __builtin_nanf("");
#pragma unroll
        for (int ai = 0; ai < 2; ++ai)
#pragma unroll
            for (int m = 0; m < 4; ++m) { const int r = ai * HALF + wr * 64 + m * 16 + fr; const f32x2v sr = S[r]; const size_t off = (size_t)(u.pm * BM + r) * ldc + col0;
#pragma unroll
                for (int bj = 0; bj < 2; ++bj)
#pragma unroll
                    for (int n = 0; n < 2; ++n) { const f32x4 bs = *(const f32x4*)(base + off + bj * HALF + n * 16); acc[ai][bj][m][n] = bs + (acc[ai][bj][m][n] - sr.x) * sr.y; }
                asm volatile("" : "+v"(acc[ai][0][m][0]), "+v"(acc[ai][0][m][1]), "+v"(acc[ai][1][m][0]), "+v"(acc[ai][1][m][1]));
                if (m & 1) asm volatile("" ::: "memory"); }
        const bool bad1 = bad;
        bad = st2.run(acc, u, wr, wc, fr, fq, lds, wid, lane) || bad;
#pragma unroll
        for (int ai = 0; ai < 2; ++ai)
#pragma unroll
            for (int m = 0; m < 4; ++m) { const int r = ai * HALF + wr * 64 + m * 16 + fr; const f32x2v sr = S[r]; const size_t off = (size_t)(u.pm * BM + r) * ldc + col0;
#pragma unroll
                for (int bj = 0; bj < 2; ++bj)
#pragma unroll
                    for (int n = 0; n < 2; ++n) { const f32x4 x1 = acc[ai][bj][m][n]; *(f32x4*)(out + off + bj * HALF + n * 16) = bad1 ? (f32x4){qnan, qnan, qnan, qnan} : x1;
                        const f32x4 o = (x1 - sr.x) * sr.y; u32x2v w; w.x = cvt_pk_bf16(o[0], o[1]); w.y = cvt_pk_bf16(o[2], o[3]);
                        if (bad) { w.x = 0x7fc07fc0u; w.y = 0x7fc07fc0u; } *(u32x2v*)(xn + off + bj * HALF + n * 16) = w; }
                asm volatile("" ::: "memory"); }
    }
};

typedef int pg8_v8i __attribute__((ext_vector_type(8)));
typedef int pg8_v4i __attribute__((ext_vector_type(4)));
__device__ __forceinline__ pg8_v8i cat32(const bf16x8 lo, const bf16x8 hi) { return __builtin_shufflevector(__builtin_bit_cast(pg8_v4i, lo), __builtin_bit_cast(pg8_v4i, hi), 0, 1, 2, 3, 4, 5, 6, 7); }
template <class Epi, class Sched, bool STAMP = false, bool FP8 = false>
__device__ __forceinline__ void gemm_phase(PG8_LAS unsigned char* lds, const Gemm g, const Sched& S, const Epi& E, unsigned long long* stamps) {
    int tid_opaque = threadIdx.x; asm volatile("" : "+v"(tid_opaque));
    const int tid = tid_opaque, wid = __builtin_amdgcn_readfirstlane(tid >> 6), lane = tid & 63, wr = wid >> 2, wc = wid & 3, fr = lane & 15, fq = lane >> 4;
    const int K = g.K, nt = K / BK;
    int ts_lo = 0, ts_hi = 0, nts = 0; const unsigned long long rt_entry = STAMP ? (unsigned long long)wall_clock64() : 0ull;
#define PG8_STAMP() do { if (STAMP && wid == 0 && nts < 64) { const unsigned long long _c = (unsigned long long)clock64(); \
        ts_lo = (lane == nts) ? (int)(unsigned)_c : ts_lo; ts_hi = (lane == nts) ? (int)(unsigned)(_c >> 32) : ts_hi; ++nts; } } while (0)
    PG8_STAMP();
    unsigned voffA[2], voffB[2];
#pragma unroll
    for (int i = 0; i < 2; ++i) { int R, C; stage_rc(tid * 16 + i * 8192, R, C); const int Rb = (int)Epi::PERM == 2 ? (64 * (R >> 5) + perm32b(R & 31)) : Epi::PERM ? (64 * (R >> 5) + perm32(R & 31)) : R;
        voffA[i] = (unsigned)(R * K + C) * 2u; voffB[i] = (unsigned)(Rb * K + C) * 2u; }
    const size_t kstep = (size_t)(BK * 2);
    const size_t hstep = (size_t)HALF * K * 2;
    const size_t tstep = 2 * hstep;
    const size_t hstepB = (int)Epi::PERM == 2 ? (size_t)8 * K * 2 : Epi::PERM ? (size_t)32 * K * 2 : hstep;
    const unsigned ldsw = (unsigned)wid * 1024u;
    const int aoff = lds_byte(wr * 64 + fr, fq * 8), boff = lds_byte(wc * 32 + fr, fq * 8);
#define PG8_SA(b, h) (((b) * 2 + (h)) * HTB)
#define PG8_SB(b, h) ((4 + (b) * 2 + (h)) * HTB)
#define PG8_STAGE(bufoff, gbase, voff) do { _Pragma("unroll") for (int _i = 0; _i < 2; ++_i) \
        __builtin_amdgcn_global_load_lds((const unsigned*)((const char*)(gbase) + (voff)[_i]), (PG8_LAS unsigned*)(lds + (bufoff) + ldsw + _i * 8192), 16, 0, 0); } while (0)
#define PG8_LDA(dst, b, h) do { _Pragma("unroll") for (int m = 0; m < 4; ++m) _Pragma("unroll") for (int k = 0; k < 2; ++k) dst[m][k] = *(const PG8_LAS bf16x8*)(lds + PG8_SA(b, h) + aoff + m * 2048 + k * 1024); } while (0)
#define PG8_LDB(dst, b, h) do { _Pragma("unroll") for (int n = 0; n < 2; ++n) _Pragma("unroll") for (int k = 0; k < 2; ++k) dst[n][k] = *(const PG8_LAS bf16x8*)(lds + PG8_SB(b, h) + boff + n * 2048 + k * 1024); } while (0)
#define PG8_MMA(ai, bj, At, Bt) do { __builtin_amdgcn_s_setprio(1); _Pragma("unroll") for (int m = 0; m < 4; ++m) _Pragma("unroll") for (int n = 0; n < 2; ++n) { \
        if constexpr (FP8) { const pg8_v8i b8_ = cat32(Bt[n][0], Bt[n][1]), a8_ = cat32(At[m][0], At[m][1]); asm volatile("v_mfma_f32_16x16x128_f8f6f4 %0, %1, %2, %0" : "+v"(acc[ai][bj][m][n]) : "v"(b8_), "v"(a8_)); }   \
        else { _Pragma("unroll") for (int k = 0; k < 2; ++k) acc[ai][bj][m][n] = __builtin_amdgcn_mfma_f32_16x16x32_bf16(Bt[n][k], At[m][k], acc[ai][bj][m][n], 0, 0, 0); } } \
        __builtin_amdgcn_s_setprio(0); } while (0)
#define PG8_WAIT_V(n) asm volatile("s_waitcnt vmcnt(" #n ")" ::: "memory")
#define PG8_WAIT_L(n) asm volatile("s_waitcnt lgkmcnt(" #n ")" ::: "memory")
#define PG8_BAR __builtin_amdgcn_s_barrier()
#define PG8_SCHED __builtin_amdgcn_sched_barrier(0)
    Unit cur, nxt; int ui = 0;
    if (!S.next(0, cur)) return;
    f32x4 acc[2][2][4][2];
#pragma unroll
    for (int a = 0; a < 2; ++a)
#pragma unroll
        for (int b = 0; b < 2; ++b)
#pragma unroll
            for (int m = 0; m < 4; ++m)
#pragma unroll
                for (int n = 0; n < 2; ++n) acc[a][b][m][n] = (f32x4){0.f, 0.f, 0.f, 0.f};
    bf16x8 At[4][2], B0[2][2], B1[2][2];
    const char* cA = (const char*)g.A + (size_t)cur.pm * tstep; const char* cB = (const char*)g.Bt + (size_t)cur.pn * tstep;
    const unsigned long long ga64_ = (unsigned long long)g.A, gb64_ = (unsigned long long)g.Bt;
    const char* gA_ = (const char*)(((unsigned long long)(unsigned)__builtin_amdgcn_readfirstlane((int)(unsigned)(ga64_ >> 32)) << 32) | (unsigned)__builtin_amdgcn_readfirstlane((int)(unsigned)ga64_));
    const char* gB_ = (const char*)(((unsigned long long)(unsigned)__builtin_amdgcn_readfirstlane((int)(unsigned)(gb64_ >> 32)) << 32) | (unsigned)__builtin_amdgcn_readfirstlane((int)(unsigned)gb64_));
    S.a_ready(cur);
    PG8_STAGE(PG8_SB(0, 0), cB, voffB); PG8_STAGE(PG8_SA(0, 0), cA, voffA); PG8_STAGE(PG8_SB(0, 1), cB + hstepB, voffB); PG8_STAGE(PG8_SA(0, 1), cA + hstep, voffA);
    if (wr == 1) PG8_BAR;
    PG8_WAIT_V(4); PG8_BAR;
    PG8_STAGE(PG8_SB(1, 0), cB + kstep, voffB); PG8_STAGE(PG8_SA(1, 0), cA + kstep, voffA); PG8_STAGE(PG8_SB(1, 1), cB + hstepB + kstep, voffB);
    PG8_WAIT_V(6); PG8_BAR;
    PG8_STAMP();
    for (;;) {
        const bool has_next = S.next(ui + 1, nxt);
        const char* nA = has_next ? gA_ + (size_t)nxt.pm * tstep : cA; const char* nB = has_next ? gB_ + (size_t)nxt.pn * tstep : cB;
        for (int t = 0; t < nt; t += 2) {
            if constexpr (Epi::HOOK) { if (t == Epi::H0 || t == Epi::H1) E.hook(acc, cur, t, wr, wc, fr, fq); }
            const bool last = (t == nt - 2);
            const char* a1 = cA + (size_t)(t + 1) * kstep;
            const char* a2 = last ? nA : cA + (size_t)(t + 2) * kstep; const char* b2 = last ? nB : cB + (size_t)(t + 2) * kstep;
            const char* a3 = a2 + kstep; const char* b3 = b2 + kstep;
            if (last && has_next) S.a_ready(nxt);
            PG8_LDB(B0, 0, 0); PG8_SCHED; PG8_LDA(At, 0, 0); PG8_STAGE(PG8_SA(1, 1), a1 + hstep, voffA);
            PG8_WAIT_L(8); PG8_BAR; PG8_WAIT_L(0); PG8_MMA(0, 0, At, B0); PG8_BAR; PG8_SCHED;
            PG8_LDB(B1, 0, 1); PG8_STAGE(PG8_SB(0, 0), b2, voffB);
            PG8_BAR; PG8_WAIT_L(0); PG8_MMA(0, 1, At, B1); PG8_BAR;
            PG8_LDA(At, 0, 1); PG8_STAGE(PG8_SA(0, 0), a2, voffA);
            PG8_BAR; PG8_WAIT_L(0); PG8_MMA(1, 0, At, B0); PG8_BAR; PG8_SCHED;
            PG8_STAGE(PG8_SB(0, 1), b2 + hstepB, voffB);
            PG8_WAIT_V(6); PG8_BAR; PG8_MMA(1, 1, At, B1); PG8_BAR;
            PG8_LDB(B0, 1, 0); PG8_SCHED; PG8_LDA(At, 1, 0); PG8_STAGE(PG8_SA(0, 1), a2 + hstep, voffA);
            PG8_WAIT_L(8); PG8_BAR; PG8_WAIT_L(0); PG8_MMA(0, 0, At, B0); PG8_BAR; PG8_SCHED;
            PG8_LDB(B1, 1, 1); PG8_STAGE(PG8_SB(1, 0), b3, voffB);
            PG8_BAR; PG8_WAIT_L(0); PG8_MMA(0, 1, At, B1); PG8_BAR;
            PG8_LDA(At, 1, 1); PG8_STAGE(PG8_SA(1, 0), a3, voffA);
            PG8_BAR; PG8_WAIT_L(0); PG8_MMA(1, 0, At, B0); PG8_BAR; PG8_SCHED;
            PG8_STAGE(PG8_SB(1, 1), b3 + hstepB, voffB);
            PG8_WAIT_V(6); PG8_BAR; PG8_MMA(1, 1, At, B1); PG8_BAR;
        }
        PG8_STAMP();
        if constexpr (!Epi::AFTER_DRAIN) { E(acc, cur, wr, wc, fr, fq); S.done(cur); }
        PG8_STAMP();
        if (!has_next) break;
#pragma unroll
        for (int a = 0; a < 2; ++a)
#pragma unroll
            for (int b = 0; b < 2; ++b)
#pragma unroll
                for (int m = 0; m < 4; ++m)
#pragma unroll
                    for (int n = 0; n < 2; ++n) acc[a][b][m][n] = (f32x4){0.f, 0.f, 0.f, 0.f};
        cur = nxt; cA = nA; cB = nB; ++ui;
    }
    PG8_WAIT_V(0);
    if (wr == 0) PG8_BAR;
    PG8_BAR;
    if constexpr (Epi::AFTER_DRAIN) { E.fused(acc, cur, wr, wc, fr, fq, lds, wid, lane); S.done(cur); }
    PG8_STAMP();
    if (STAMP && wid == 0) { stamps[lane] = lane < nts ? (((unsigned long long)(unsigned)ts_hi << 32) | (unsigned)ts_lo) : 0ull;
        if (lane == 62) stamps[62] = rt_entry; if (lane == 63) stamps[63] = (unsigned long long)wall_clock64(); }
#undef PG8_STAMP
#undef PG8_SA
#undef PG8_SB
#undef PG8_STAGE
#undef PG8_LDA
#undef PG8_LDB
#undef PG8_MMA
#undef PG8_WAIT_V
#undef PG8_WAIT_L
#undef PG8_BAR
#undef PG8_SCHED
}
}
#ifndef BG_TABLES0
#define BG_TABLES0 1
#endif
#ifndef BG_TABLES
#define BG_TABLES 1
#endif
#ifndef PROBE_DUP
#define PROBE_DUP 0
#endif
#ifndef BR8
#define BR8 0
#endif
#ifndef G1_NBF
#define G1_NBF 3072
#endif

namespace mk {
using pg8::bf16_t; using pg8::f32x4; using pg8::u32x4; using pg8::Unit; using pg8::f32x2;
#define LAS __attribute__((address_space(3)))
#define GAS __attribute__((address_space(1)))
typedef unsigned u32x2 __attribute__((ext_vector_type(2)));

constexpr int NWAVES = 8, NTHR = 512;
constexpr int T = 16384, D = 2048, SEQ = 2048, DEPTH = 2, INW = 13824, NEXP = 16384;
constexpr float EPS = 1e-6f;
constexpr size_t MiB = 1u << 20;
constexpr size_t WS_CTL = 0, CTL_ZERO_BYTES = 1 * MiB;
constexpr size_t WS_WIN = 1 * MiB;
constexpr size_t WS_WA = 55 * MiB;
constexpr size_t WS_WB = 59 * MiB;
constexpr size_t WS_WC = 63 * MiB;
constexpr size_t WS_WOUT = 65 * MiB;
constexpr size_t WS_WSC = 73 * MiB;
constexpr size_t WS_WM = 81 * MiB;
constexpr size_t WS_WP = 82 * MiB;
constexpr size_t WS_U = 83 * MiB;
constexpr size_t WS_V = 211 * MiB;
constexpr size_t WS_XB = 339 * MiB;
constexpr size_t WS_RSTD = 403 * MiB;
constexpr size_t WS_PA = 404 * MiB;
constexpr size_t WS_PB = 468 * MiB;
constexpr size_t WS_PQKV = 500 * MiB;
constexpr size_t WS_PG = 644 * MiB;
constexpr size_t WS_YA = 836 * MiB;
constexpr size_t WS_YB = 868 * MiB;
constexpr size_t WS_YC = 900 * MiB;
constexpr size_t WS_OG = 916 * MiB;
constexpr size_t WS_LSE = 964 * MiB;
constexpr size_t WS_XB8 = 147 * MiB;
constexpr size_t WS_WIN8 = 179 * MiB;
constexpr size_t WS_XH4 = 243 * MiB;
constexpr size_t WS_XL4 = 259 * MiB;
constexpr size_t WS_EXG = 965 * MiB;
constexpr size_t WS_CVG = 973 * MiB;
constexpr size_t WS_END = 981 * MiB;
constexpr int CW_BAR = 4096;
#ifndef PEER_FP4
#define PEER_FP4 1
#endif
constexpr float SCALE_U4 = 90.5f, SCALE_V4 = 5.657f;

constexpr int RING_BYTES = 131072, LDS_BYTES = 163840, TOP_OFF = LDS_BYTES - 1024, MISC_OFF = TOP_OFF + 320;

__constant__ unsigned char kBucket[3 * 129] = {
0,1,2,3,4,5,6,7,8,9,10,11,12,13,14,15,16,16,16,16,16,16,17,17,17,17,17,17,17,17,18,18,18,18,18,18,18,18,18,18,19,19,19,19,19,19,19,19,19,19,19,19,19,19,20,20,20,20,20,20,20,20,20,20,20,20,20,20,20,20,20,20,20,21,21,21,21,21,21,21,21,21,21,21,21,21,21,21,21,21,21,21,21,21,21,21,21,21,21,22,22,22,22,22,22,22,22,22,22,22,22,22,22,22,22,22,22,22,22,22,22,22,22,22,22,22,22,22,22,
0,4,8,12,16,16,17,17,18,18,19,19,19,19,20,20,20,20,20,21,21,21,21,21,21,22,22,22,22,22,22,22,22,22,23,23,23,23,23,23,23,23,23,23,23,23,24,24,24,24,24,24,24,24,24,24,24,24,24,24,24,24,25,25,25,25,25,25,25,25,25,25,25,25,25,25,25,25,25,25,25,25,25,26,26,26,26,26,26,26,26,26,26,26,26,26,26,26,26,26,26,26,26,26,26,26,26,26,26,26,26,26,26,27,27,27,27,27,27,27,27,27,27,27,27,27,27,27,27,
0,16,18,19,20,21,21,22,22,23,23,23,24,24,24,24,25,25,25,25,25,26,26,26,26,26,26,26,26,27,27,27,27,27,27,27,27,27,27,28,28,28,28,28,28,28,28,28,28,28,28,28,29,29,29,29,29,29,29,29,29,29,29,29,29,29,29,29,29,29,30,30,30,30,30,30,30,30,30,30,30,30,30,30,30,30,30,30,30,30,30,30,30,30,30,31,31,31,31,31,31,31,31,31,31,31,31,31,31,31,31,31,31,31,31,31,31,31,31,31,31,31,31,31,31,31,31,31,31};

__device__ __forceinline__ float bflo(unsigned w) { return __uint_as_float(w << 16); }
__device__ __forceinline__ float bfhi(unsigned w) { return __uint_as_float(w & 0xffff0000u); }
__device__ __forceinline__ float bf2f(bf16_t b) { return __uint_as_float(((unsigned)b) << 16); }
__device__ __forceinline__ unsigned f2bf(float f) { unsigned u = __float_as_uint(f); return (u + 0x7fffu + ((u >> 16) & 1u)) >> 16; }
typedef __bf16 bf16x2_t __attribute__((ext_vector_type(2)));
__device__ __forceinline__ unsigned pk2(float lo, float hi) { return __builtin_bit_cast(unsigned, __builtin_convertvector((f32x2){lo, hi}, bf16x2_t)); }
__device__ __forceinline__ unsigned pk2s(float lo, float hi) { return pk2(lo, hi); }
typedef int v2i_t __attribute__((ext_vector_type(2)));
typedef float f32x16 __attribute__((ext_vector_type(16)));
constexpr float Y8S = 8.0f;
__device__ __forceinline__ unsigned pk4_fp8(float a, float b, float c, float d) {
    int pk = 0;
    pk = __builtin_amdgcn_cvt_pk_fp8_f32(__builtin_amdgcn_fmed3f(a, -448.f, 448.f), __builtin_amdgcn_fmed3f(b, -448.f, 448.f), pk, false);
    pk = __builtin_amdgcn_cvt_pk_fp8_f32(__builtin_amdgcn_fmed3f(c, -448.f, 448.f), __builtin_amdgcn_fmed3f(d, -448.f, 448.f), pk, true);
    return (unsigned)pk;
}
__device__ __forceinline__ float wave_sum(float v) {
#pragma unroll
    for (int o = 1; o < 64; o <<= 1) v += __shfl_xor(v, o);
    return v;
}
__device__ __forceinline__ float wave_max(float v) {
#pragma unroll
    for (int o = 1; o < 64; o <<= 1) v = fmaxf(v, __shfl_xor(v, o));
    return v;
}
__device__ __forceinline__ float dot8(const u32x4 a, const u32x4 b) {
    return bflo(a.x) * bflo(b.x) + bfhi(a.x) * bfhi(b.x) + bflo(a.y) * bflo(b.y) + bfhi(a.y) * bfhi(b.y)
         + bflo(a.z) * bflo(b.z) + bfhi(a.z) * bfhi(b.z) + bflo(a.w) * bflo(b.w) + bfhi(a.w) * bfhi(b.w);
}
__device__ __forceinline__ float gelu_erf(float a) { return 0.5f * a * (1.0f + erff(a * 0.70710678118654752f)); }
#define LDS_WAIT() asm volatile("s_waitcnt lgkmcnt(0)" ::: "memory")
#define VM_WAIT() asm volatile("s_waitcnt vmcnt(0)" ::: "memory")

#define XB_TMO      128
#define XB_XCNT(j)  (256  + 64 * (j))
#define XB_XSUB(j)  (1280 + 64 * (j))
#define XB_XGEN(j)  (2304 + 64 * (j))
#define XB_TOP      3328
#define XB_TOPGEN   3392
#define XCD_BAR_WORDS 3456
#define XB_SPIN_CAP (1u << 18)
__device__ __forceinline__ unsigned xb_ld(unsigned* p)              { return __hip_atomic_load(p, __ATOMIC_RELAXED, __HIP_MEMORY_SCOPE_AGENT); }
__device__ __forceinline__ unsigned xb_add(unsigned* p, unsigned v) { return __hip_atomic_fetch_add(p, v, __ATOMIC_RELAXED, __HIP_MEMORY_SCOPE_AGENT); }
__device__ __forceinline__ unsigned xb_xcc_id() { return (unsigned)__builtin_amdgcn_s_getreg((3 << 11) | 20) & 0xFu; }
#define XB_SPIN(cond, bar) do { unsigned _sp = 0; while (cond) { __builtin_amdgcn_s_sleep(1); \
    if ((++_sp & 255u) == 0u) { if (xb_ld(&(bar)[XB_TMO])) break; if (_sp > XB_SPIN_CAP) { atomicAdd(&(bar)[XB_TMO], 1u); break; } } } } while (0)
struct XcdBarrier { unsigned* bar; unsigned x; volatile LAS unsigned* st; };
__device__ __forceinline__ XcdBarrier xcd_barrier_post(unsigned* bar, volatile LAS unsigned* st) {
    XcdBarrier b; b.bar = bar; b.x = xb_xcc_id(); b.st = st;
    if (threadIdx.x == 0) (void)xb_add(&bar[XB_XCNT(b.x)], 1u);
    return b;
}
__device__ __forceinline__ void xcd_barrier_complete(unsigned* bar, unsigned x, unsigned& nloc, unsigned& nx) {
    const unsigned G = gridDim.x * gridDim.y * gridDim.z;
    unsigned sum, cnt, mine, sp = 0u;
    for (;;) {
        sum = 0u; cnt = 0u; mine = 0u;
#pragma unroll
        for (unsigned j = 0; j < 16; ++j) { const unsigned c = xb_ld(&bar[XB_XCNT(j)]); sum += c; cnt += (c > 0u) ? 1u : 0u; mine = (j == x) ? c : mine; }
        if (sum == G) break;
        __builtin_amdgcn_s_sleep(1);
        if ((++sp & 255u) == 0u) { if (xb_ld(&bar[XB_TMO])) break; if (sp > XB_SPIN_CAP) { atomicAdd(&bar[XB_TMO], 1u); break; } }
    }
    nloc = mine > 0u ? mine : 1u; nx = cnt > 0u ? cnt : 1u;
}
__device__ __forceinline__ void xcd_barrier(const XcdBarrier& b) {
    asm volatile("s_waitcnt vmcnt(0)" ::: "memory");
    __syncthreads();
    if (threadIdx.x == 0) {
        unsigned* bar = b.bar;
        __builtin_amdgcn_s_waitcnt(0);
        unsigned nloc = b.st[0], nx = b.st[1];
        if (nloc == 0u) { xcd_barrier_complete(bar, b.x, nloc, nx); b.st[0] = nloc; b.st[1] = nx; }
        const unsigned old = xb_add(&bar[XB_XSUB(b.x)], 1u);
        const unsigned gen = old / nloc;
        if (old + 1u == (gen + 1u) * nloc) {
            __builtin_amdgcn_fence(__ATOMIC_RELEASE, "agent");
            asm volatile("s_waitcnt vmcnt(0)" ::: "memory");
            const unsigned og = xb_add(&bar[XB_TOP], 1u);
            const unsigned tg = og / nx;
            if (og + 1u == (tg + 1u) * nx) xb_add(&bar[XB_TOPGEN], 1u);
            else XB_SPIN(xb_ld(&bar[XB_TOPGEN]) == tg, bar);
            __builtin_amdgcn_fence(__ATOMIC_ACQUIRE, "agent");
            xb_add(&bar[XB_XGEN(b.x)], 1u);
            asm volatile("s_waitcnt vmcnt(0)" ::: "memory");
        } else {
            XB_SPIN(xb_ld(&bar[XB_XGEN(b.x)]) == gen, bar);
            __builtin_amdgcn_fence(__ATOMIC_ACQUIRE, "agent");
            asm volatile("s_waitcnt vmcnt(0)" ::: "memory");
        }
    }
    __syncthreads();
}

#define EPI_STEP(m) (((m) == 3) ? (128 - 48) : 16)
__device__ __forceinline__ unsigned dpp_hi8(unsigned keep, unsigned src) { return (unsigned)__builtin_amdgcn_update_dpp((int)keep, (int)src, 0x128, 0xF, 0xC, false); }
__device__ __forceinline__ unsigned dpp_lo8(unsigned keep, unsigned src) { return (unsigned)__builtin_amdgcn_update_dpp((int)keep, (int)src, 0x128, 0xF, 0x3, false); }
__device__ __forceinline__ void store_rows8(GAS bf16_t* p, size_t ld8, const u32x4 x0, const u32x4 x1) {
    u32x4 s0, s1;
#pragma unroll
    for (int j = 0; j < 4; ++j) { s0[j] = dpp_hi8(x0[j], x1[j]); s1[j] = dpp_lo8(x1[j], x0[j]); }
    *(GAS u32x4*)p = s0; *(GAS u32x4*)(p + ld8) = s1;
}
__device__ __forceinline__ void store_rows8_b8(GAS unsigned char* p, size_t ld8, const u32x2 x0, const u32x2 x1) {
    u32x2 s0, s1;
#pragma unroll
    for (int j = 0; j < 2; ++j) { s0[j] = dpp_hi8(x0[j], x1[j]); s1[j] = dpp_lo8(x1[j], x0[j]); }
    *(GAS u32x2*)p = s0; *(GAS u32x2*)(p + ld8) = s1;
}
struct EpiG1 {
    static constexpr bool PERM = true, AFTER_DRAIN = false, HOOK = false;
    bf16_t *PA, *PB, *PQKV, *PG; const float* rstd; int pn_off; float scale;
    template <int ACT> __device__ __forceinline__ void body(const f32x4 (&acc)[2][2][4][2], bf16_t* base, const int ldc, const int colt, const float sc, const int rowg, int wc, int fr, int fq) const {
        GAS bf16_t* rowp = (GAS bf16_t*)(base + (size_t)(rowg + (fr & 7)) * ldc + colt + wc * 64 + ((fr >> 3) * 4 + fq) * 8);
        GAS unsigned char* rowp8 = (GAS unsigned char*)base + (size_t)(rowg + fr) * ldc + colt + wc * 64 + 8 * fq;
        const GAS float* rp = (const GAS float*)(rstd + rowg + fr);
        float rv[8];
#pragma unroll
        for (int i = 0; i < 8; ++i) rv[i] = rp[(i >> 2) * 128 + (i & 3) * 16] * sc;
#pragma unroll
        for (int ai = 0; ai < 2; ++ai)
#pragma unroll
            for (int m = 0; m < 4; ++m) {
                const float r = rv[ai * 4 + m];
                u32x4 xw[2]; u32x2 xb[2];
#pragma unroll
                for (int bj = 0; bj < 2; ++bj) { f32x4 v0 = acc[ai][bj][m][0] * r, v1 = acc[ai][bj][m][1] * r;
                    if (ACT == 1) { f32x2 a = pg8::gelu_pk((f32x2){v0[0], v0[1]}), b = pg8::gelu_pk((f32x2){v0[2], v0[3]}), c = pg8::gelu_pk((f32x2){v1[0], v1[1]}), d = pg8::gelu_pk((f32x2){v1[2], v1[3]});
                        v0 = (f32x4){a.x, a.y, b.x, b.y}; v1 = (f32x4){c.x, c.y, d.x, d.y}; }
                    if (ACT == 2) {
#pragma unroll
                        for (int j = 0; j < 4; ++j) { v0[j] = __builtin_amdgcn_rcpf(1.0f + __expf(-v0[j])); v1[j] = __builtin_amdgcn_rcpf(1.0f + __expf(-v1[j])); }
                        xb[bj].x = (unsigned)(v0[0] * 255.f + 0.5f) | ((unsigned)(v0[1] * 255.f + 0.5f) << 8) | ((unsigned)(v0[2] * 255.f + 0.5f) << 16) | ((unsigned)(v0[3] * 255.f + 0.5f) << 24);
                        xb[bj].y = (unsigned)(v1[0] * 255.f + 0.5f) | ((unsigned)(v1[1] * 255.f + 0.5f) << 8) | ((unsigned)(v1[2] * 255.f + 0.5f) << 16) | ((unsigned)(v1[3] * 255.f + 0.5f) << 24); }
                    else { xw[bj].x = pk2(v0[0], v0[1]); xw[bj].y = pk2(v0[2], v0[3]); xw[bj].z = pk2(v1[0], v1[1]); xw[bj].w = pk2(v1[2], v1[3]); } }
                if (ACT == 2) { *(GAS u32x2*)rowp8 = xb[0]; *(GAS u32x2*)(rowp8 + 32) = xb[1]; rowp8 += (size_t)EPI_STEP(m) * ldc; asm volatile("" : "+v"(rowp8)); }
                else { store_rows8(rowp, (size_t)8 * ldc, xw[0], xw[1]); rowp += (size_t)EPI_STEP(m) * ldc; asm volatile("" : "+v"(rowp)); }
            }
    }
    __device__ __forceinline__ void operator()(const f32x4 (&acc)[2][2][4][2], const Unit& u, int wr, int wc, int fr, int fq) const {
        const int pn = u.pn + pn_off, rowg = u.pm * 256 + wr * 64;
        if (pn < 8) body<1>(acc, PA, 2048, pn * 256, scale, rowg, wc, fr, fq);
        else if (pn < 12) body<0>(acc, PB, 1024, (pn - 8) * 256, scale, rowg, wc, fr, fq);
        else if (pn < 30) body<0>(acc, PQKV, 4608, (pn - 12) * 256, pn < 18 ? scale * 0.08838834764831845f : scale, rowg, wc, fr, fq);
        else body<2>(acc, PG, 6144, (pn - 30) * 256, scale, rowg, wc, fr, fq);
    }
};
struct EpiG1B {
    static constexpr int PERM = 2; static constexpr bool AFTER_DRAIN = false, HOOK = false;
    unsigned char *PQKV8, *PG; const float* rstd; int pn_off; float scale;
    template <int ACT> __device__ __forceinline__ void body(const f32x4 (&acc)[2][2][4][2], unsigned char* base, const int ldc, const int colt, const int rowg, int wc, int fr, int fq) const {
        GAS unsigned char* rowp = (GAS unsigned char*)base + (size_t)(rowg + fr) * ldc + colt + wc * 64 + 16 * fq;
        const GAS float* rp = (const GAS float*)(rstd + rowg + fr);
        float rv[8];
#pragma unroll
        for (int i = 0; i < 8; ++i) rv[i] = rp[(i >> 2) * 128 + (i & 3) * 16] * scale;
#pragma unroll
        for (int ai = 0; ai < 2; ++ai)
#pragma unroll
            for (int m = 0; m < 4; ++m) {
                const float r = rv[ai * 4 + m];
                u32x4 w;
#pragma unroll
                for (int bj = 0; bj < 2; ++bj)
#pragma unroll
                    for (int n = 0; n < 2; ++n) { f32x4 v = acc[ai][bj][m][n] * r; unsigned pk;
                        if (ACT == 2) {
#pragma unroll
                            for (int j = 0; j < 4; ++j) v[j] = __builtin_amdgcn_rcpf(1.0f + __expf(-v[j]));
                            pk = (unsigned)(v[0] * 255.f + 0.5f) | ((unsigned)(v[1] * 255.f + 0.5f) << 8) | ((unsigned)(v[2] * 255.f + 0.5f) << 16) | ((unsigned)(v[3] * 255.f + 0.5f) << 24); }
                        else pk = pk4_fp8(v[0], v[1], v[2], v[3]);
                        w[bj * 2 + n] = pk; }
                *(GAS u32x4*)rowp = w;
                rowp += (size_t)EPI_STEP(m) * ldc;
                asm volatile("" : "+v"(rowp));
            }
    }
    __device__ __forceinline__ void operator()(const f32x4 (&acc)[2][2][4][2], const Unit& u, int wr, int wc, int fr, int fq) const {
        const int pn = u.pn + pn_off, rowg = u.pm * 256 + wr * 64;
        if (pn < 30) body<3>(acc, PQKV8, 4608, (pn - 12) * 256, rowg, wc, fr, fq);
        else body<2>(acc, PG, 6144, (pn - 30) * 256, rowg, wc, fr, fq);
    }
};
template <int FIRST> struct EpiBranch {
    static constexpr bool PERM = true, AFTER_DRAIN = false, HOOK = false;
    bf16_t* MG; const bf16_t* gate;
    __device__ __forceinline__ void operator()(const f32x4 (&acc)[2][2][4][2], const Unit& u, int wr, int wc, int fr, int fq) const {
        const int row0 = u.pm * 256 + wr * 64 + fr, col0 = u.pn * 256 + wc * 32 + 8 * fq;
        const GAS bf16_t* gp = (const GAS bf16_t*)(gate + (size_t)row0 * 6144 + col0); GAS bf16_t* mp = (GAS bf16_t*)(MG + (size_t)row0 * 2048 + col0);
#pragma unroll
        for (int ai = 0; ai < 2; ++ai) {
            u32x4 g[4][2], o[4][2];
#pragma unroll
            for (int m = 0; m < 4; ++m)
#pragma unroll
                for (int bj = 0; bj < 2; ++bj) { g[m][bj] = *(const GAS u32x4*)(gp + (size_t)m * 16 * 6144 + bj * 128); if (!FIRST) o[m][bj] = *(const GAS u32x4*)(mp + (size_t)m * 16 * 2048 + bj * 128); }
#pragma unroll
            for (int m = 0; m < 4; ++m)
#pragma unroll
                for (int bj = 0; bj < 2; ++bj) { const u32x4 gg = g[m][bj];
                    f32x4 v0 = acc[ai][bj][m][0], v1 = acc[ai][bj][m][1];
                    v0[0] *= bflo(gg.x); v0[1] *= bfhi(gg.x); v0[2] *= bflo(gg.y); v0[3] *= bfhi(gg.y);
                    v1[0] *= bflo(gg.z); v1[1] *= bfhi(gg.z); v1[2] *= bflo(gg.w); v1[3] *= bfhi(gg.w);
                    if (!FIRST) { const u32x4 oo = o[m][bj];
                        v0[0] += bflo(oo.x); v0[1] += bfhi(oo.x); v0[2] += bflo(oo.y); v0[3] += bfhi(oo.y);
                        v1[0] += bflo(oo.z); v1[1] += bfhi(oo.z); v1[2] += bflo(oo.w); v1[3] += bfhi(oo.w); }
                    u32x4 w; w.x = pk2(v0[0], v0[1]); w.y = pk2(v0[2], v0[3]); w.z = pk2(v1[0], v1[1]); w.w = pk2(v1[2], v1[3]);
                    *(GAS u32x4*)(mp + (size_t)m * 16 * 2048 + bj * 128) = w; }
            gp += (size_t)128 * 6144; mp += (size_t)128 * 2048;
            asm volatile("" : "+v"(gp), "+v"(mp) :: "memory");
        }
    }
};
template <int F8> struct EpiBranchF {
    static constexpr bool PERM = true, AFTER_DRAIN = false, HOOK = true;
    static constexpr int H0 = F8 ? 8 : 16, H1 = F8 ? 16 : 32;
    static constexpr float OS = F8 ? 1.0f / (Y8S * 1024.0f) : 1.0f;
    bf16_t* MG; const unsigned char* gate;
    static __device__ __forceinline__ float gb(unsigned w, int k) { return fmaxf((float)((w >> (8 * k)) & 0xffu) * (1.0f / 255.0f), 1e-6f); }
    __device__ __forceinline__ void hook(f32x4 (&acc)[2][2][4][2], const Unit& u, int t, int wr, int wc, int fr, int fq) const {
        const int row0 = u.pm * 256 + wr * 64 + fr, col0 = u.pn * 256 + wc * 64 + 8 * fq;
        const GAS unsigned char* gp = (const GAS unsigned char*)(gate + (size_t)row0 * 6144 + col0 + (t == H0 ? 0 : 2048));
#pragma unroll
        for (int ai = 0; ai < 2; ++ai) {
            u32x2 gn[4][2], gd[4][2];
#pragma unroll
            for (int m = 0; m < 4; ++m)
#pragma unroll
                for (int bj = 0; bj < 2; ++bj) { gn[m][bj] = *(const GAS u32x2*)(gp + (size_t)m * 16 * 6144 + bj * 32); gd[m][bj] = *(const GAS u32x2*)(gp + (size_t)m * 16 * 6144 + bj * 32 + 2048); }
#pragma unroll
            for (int m = 0; m < 4; ++m)
#pragma unroll
                for (int bj = 0; bj < 2; ++bj) { const u32x2 a = gn[m][bj], d = gd[m][bj];
#pragma unroll
                    for (int k = 0; k < 4; ++k) { acc[ai][bj][m][0][k] *= gb(a.x, k) * __builtin_amdgcn_rcpf(gb(d.x, k)); acc[ai][bj][m][1][k] *= gb(a.y, k) * __builtin_amdgcn_rcpf(gb(d.y, k)); } }
            gp += (size_t)128 * 6144;
            asm volatile("" : "+v"(gp) :: "memory");
        }
    }
    __device__ __forceinline__ void operator()(const f32x4 (&acc)[2][2][4][2], const Unit& u, int wr, int wc, int fr, int fq) const {
        const int rowg = u.pm * 256 + wr * 64, col0 = u.pn * 256 + wc * 64 + 8 * fq;
        const GAS unsigned char* gp = (const GAS unsigned char*)(gate + (size_t)(rowg + fr) * 6144 + col0 + 4096);
        GAS bf16_t* mp = (GAS bf16_t*)(MG + (size_t)(rowg + (fr & 7)) * 2048 + u.pn * 256 + wc * 64 + ((fr >> 3) * 4 + fq) * 8);
#pragma unroll
        for (int ai = 0; ai < 2; ++ai) {
            u32x2 g[4][2];
#pragma unroll
            for (int m = 0; m < 4; ++m)
#pragma unroll
                for (int bj = 0; bj < 2; ++bj) g[m][bj] = *(const GAS u32x2*)(gp + (size_t)m * 16 * 6144 + bj * 32);
#pragma unroll
            for (int m = 0; m < 4; ++m) { u32x4 w[2];
#pragma unroll
                for (int bj = 0; bj < 2; ++bj) { const u32x2 gg = g[m][bj]; const f32x4 v0 = acc[ai][bj][m][0], v1 = acc[ai][bj][m][1];
                    w[bj].x = pk2(v0[0] * (gb(gg.x, 0) * OS), v0[1] * (gb(gg.x, 1) * OS)); w[bj].y = pk2(v0[2] * (gb(gg.x, 2) * OS), v0[3] * (gb(gg.x, 3) * OS));
                    w[bj].z = pk2(v1[0] * (gb(gg.y, 0) * OS), v1[1] * (gb(gg.y, 1) * OS)); w[bj].w = pk2(v1[2] * (gb(gg.y, 2) * OS), v1[3] * (gb(gg.y, 3) * OS)); }
                store_rows8(mp + (size_t)m * 16 * 2048, (size_t)8 * 2048, w[0], w[1]); }
            gp += (size_t)128 * 6144; mp += (size_t)128 * 2048;
            asm volatile("" : "+v"(gp), "+v"(mp) :: "memory");
        }
    }
};
template <int XIN_BF16> struct EpiWout {
    static constexpr bool PERM = true, AFTER_DRAIN = false, HOOK = false;
    const float* xin; float* xout; bf16_t* XB; unsigned char* XB8;
    __device__ __forceinline__ void operator()(const f32x4 (&acc)[2][2][4][2], const Unit& u, int wr, int wc, int fr, int fq) const {
        const int rowg = u.pm * 256 + wr * 64, colw = u.pn * 256 + wc * 64;
        size_t off = (size_t)(rowg + fr) * 2048 + colw + 8 * fq;
        GAS bf16_t* sp = (GAS bf16_t*)(XB + (size_t)(rowg + (fr & 7)) * 2048 + colw + ((fr >> 3) * 4 + fq) * 8);
#pragma unroll
        for (int ai = 0; ai < 2; ++ai) {
            f32x4 xv[4][2][2];
#pragma unroll
            for (int m = 0; m < 4; ++m)
#pragma unroll
                for (int bj = 0; bj < 2; ++bj) { const size_t o = off + (size_t)m * 16 * 2048 + bj * 32;
                    if (XIN_BF16) { const u32x4 wv = *(const GAS u32x4*)(XB + o); xv[m][bj][0] = (f32x4){bflo(wv.x), bfhi(wv.x), bflo(wv.y), bfhi(wv.y)}; xv[m][bj][1] = (f32x4){bflo(wv.z), bfhi(wv.z), bflo(wv.w), bfhi(wv.w)}; }
                    else { xv[m][bj][0] = *(const GAS f32x4*)(xin + o); xv[m][bj][1] = *(const GAS f32x4*)(xin + o + 4); } }
#pragma unroll
            for (int m = 0; m < 4; ++m) { u32x4 w[2];
#pragma unroll
                for (int bj = 0; bj < 2; ++bj) { const f32x4 v0 = xv[m][bj][0] + acc[ai][bj][m][0], v1 = xv[m][bj][1] + acc[ai][bj][m][1];
                    w[bj].x = pk2(v0[0], v0[1]); w[bj].y = pk2(v0[2], v0[3]); w[bj].z = pk2(v1[0], v1[1]); w[bj].w = pk2(v1[2], v1[3]); }
                store_rows8(sp + (size_t)m * 16 * 2048, (size_t)8 * 2048, w[0], w[1]); }
            off += (size_t)128 * 2048; sp += (size_t)128 * 2048;
            asm volatile("" : "+v"(off), "+v"(sp) :: "memory");
        }
    }
};
struct EpiF32 {
    static constexpr bool PERM = false, AFTER_DRAIN = false, HOOK = false;
    float* C; int ldc;
    __device__ __forceinline__ void operator()(const f32x4 (&acc)[2][2][4][2], const Unit& u, int wr, int wc, int fr, int fq) const {
        const int row0 = u.pm * 256 + wr * 64 + fr, col0 = u.pn * 256 + wc * 32 + 4 * fq;
        GAS float* rowp = (GAS float*)(C + (size_t)row0 * ldc + col0);
#pragma unroll
        for (int ai = 0; ai < 2; ++ai)
#pragma unroll
            for (int m = 0; m < 4; ++m) {
#pragma unroll
                for (int bj = 0; bj < 2; ++bj)
#pragma unroll
                    for (int n = 0; n < 2; ++n) *(GAS f32x4*)(rowp + bj * 128 + n * 16) = acc[ai][bj][m][n];
                rowp += (size_t)EPI_STEP(m) * ldc;
                asm volatile("" : "+v"(rowp) :: "memory"); }
    }
};


struct SplitOrder : pg8::StaticOrder {
    int cut, nA, nB;
    __device__ bool next(int i, Unit& u) const {
        long L;
        if (c < cut) { if (i >= nA) return false; L = (long)i * cut + c; } else { if (i >= nB) return false; L = (long)nA * cut + (long)i * (G - cut) + (c - cut); }
        if (L >= nwg) return false;
        int wgid = (int)L; { const int q = nwg / pg8::NXCD, r = nwg % pg8::NXCD, xcd = wgid % pg8::NXCD, off = wgid / pg8::NXCD; wgid = (xcd < r ? xcd * (q + 1) : r * (q + 1) + (xcd - r) * q) + off; }
        const int nig = pg8::WGM * nN, gid = wgid / nig, fm = gid * pg8::WGM, gsz = (nM - fm) < pg8::WGM ? (nM - fm) : pg8::WGM;
        u.pm = fm + ((wgid % nig) % gsz); u.pn = (wgid % nig) / gsz; return true;
    }
};

struct EpiNull {
    static constexpr bool PERM = true, AFTER_DRAIN = false, HOOK = false;
    __device__ __forceinline__ void operator()(const f32x4 (&acc)[2][2][4][2], const Unit& u, int wr, int wc, int fr, int fq) const {
#pragma unroll
        for (int ai = 0; ai < 2; ++ai)
#pragma unroll
            for (int bj = 0; bj < 2; ++bj)
#pragma unroll
                for (int m = 0; m < 4; ++m) { asm volatile("" :: "v"(acc[ai][bj][m][0]), "v"(acc[ai][bj][m][1])); }
    }
};
struct EpiLocal {
    static constexpr bool PERM = true, AFTER_DRAIN = false, HOOK = false;
    bf16_t* C;
    __device__ __forceinline__ void operator()(const f32x4 (&acc)[2][2][4][2], const Unit& u, int wr, int wc, int fr, int fq) const {
        const int col0 = wc * 32 + 8 * fq;
#pragma unroll
        for (int ai = 0; ai < 2; ++ai)
#pragma unroll
            for (int m = 0; m < 4; ++m) {
                GAS bf16_t* rowp = (GAS bf16_t*)(C + (size_t)(blockIdx.x * 64 + 16 * m + fr) * 2048 + col0);
#pragma unroll
                for (int bj = 0; bj < 2; ++bj) { const f32x4 v0 = acc[ai][bj][m][0], v1 = acc[ai][bj][m][1];
                    u32x4 w; w.x = pk2s(v0[0], v0[1]); w.y = pk2s(v0[2], v0[3]); w.z = pk2s(v1[0], v1[1]); w.w = pk2s(v1[2], v1[3]);
                    *(GAS u32x4*)(rowp + bj * 128) = w; }
            }
    }
};
struct EpiContig {
    static constexpr bool PERM = true, AFTER_DRAIN = false, HOOK = false;
    bf16_t* C;
    __device__ __forceinline__ void operator()(const f32x4 (&acc)[2][2][4][2], const Unit& u, int wr, int wc, int fr, int fq) const {
        GAS unsigned char* tp = (GAS unsigned char*)C + (size_t)(u.pm * 8 + (u.pn & 7)) * 131072 + (wr * 4 + wc) * 16384 + (fq * 16 + fr) * 16;
#pragma unroll
        for (int ai = 0; ai < 2; ++ai)
#pragma unroll
            for (int m = 0; m < 4; ++m) {
#pragma unroll
                for (int bj = 0; bj < 2; ++bj) { const f32x4 v0 = acc[ai][bj][m][0], v1 = acc[ai][bj][m][1];
                    u32x4 w; w.x = pk2s(v0[0], v0[1]); w.y = pk2s(v0[2], v0[3]); w.z = pk2s(v1[0], v1[1]); w.w = pk2s(v1[2], v1[3]);
                    *(GAS u32x4*)(tp + ((ai * 4 + m) * 2 + bj) * 1024) = w; }
            }
    }
};
struct EpiNT {
    static constexpr bool PERM = true, AFTER_DRAIN = false, HOOK = false;
    bf16_t* C;
    __device__ __forceinline__ void operator()(const f32x4 (&acc)[2][2][4][2], const Unit& u, int wr, int wc, int fr, int fq) const {
        const int row0 = u.pm * 256 + wr * 64 + fr, col0 = u.pn * 256 + wc * 32 + 8 * fq;
        GAS bf16_t* rowp = (GAS bf16_t*)(C + (size_t)row0 * 2048 + col0);
#pragma unroll
        for (int ai = 0; ai < 2; ++ai)
#pragma unroll
            for (int m = 0; m < 4; ++m) {
#pragma unroll
                for (int bj = 0; bj < 2; ++bj) { const f32x4 v0 = acc[ai][bj][m][0], v1 = acc[ai][bj][m][1];
                    u32x4 w; w.x = pk2s(v0[0], v0[1]); w.y = pk2s(v0[2], v0[3]); w.z = pk2s(v1[0], v1[1]); w.w = pk2s(v1[2], v1[3]);
                    __builtin_nontemporal_store(w, (GAS u32x4*)(rowp + bj * 128)); }
                rowp += (size_t)EPI_STEP(m) * 2048;
                asm volatile("" : "+v"(rowp));
            }
    }
};
struct EpiRows8 {
    static constexpr bool PERM = true, AFTER_DRAIN = false, HOOK = false;
    bf16_t* C;
    __device__ __forceinline__ void operator()(const f32x4 (&acc)[2][2][4][2], const Unit& u, int wr, int wc, int fr, int fq) const {
        const int lane = fq * 16 + fr, r8 = lane & 7, ch = lane >> 3;
        GAS bf16_t* rowp = (GAS bf16_t*)(C + (size_t)(u.pm * 256 + wr * 64 + r8) * 2048 + u.pn * 256 + wc * 64 + ch * 8);
#pragma unroll
        for (int ai = 0; ai < 2; ++ai)
#pragma unroll
            for (int m = 0; m < 4; ++m) {
#pragma unroll
                for (int bj = 0; bj < 2; ++bj) { const f32x4 v0 = acc[ai][bj][m][0], v1 = acc[ai][bj][m][1];
                    u32x4 w; w.x = pk2s(v0[0], v0[1]); w.y = pk2s(v0[2], v0[3]); w.z = pk2s(v1[0], v1[1]); w.w = pk2s(v1[2], v1[3]);
                    *(GAS u32x4*)(rowp + (size_t)(bj * 8) * 2048) = w; }
                rowp += (size_t)EPI_STEP(m) * 2048;
                asm volatile("" : "+v"(rowp));
            }
    }
};
struct EpiHalf {
    static constexpr bool PERM = true, AFTER_DRAIN = false, HOOK = false;
    bf16_t* C;
    __device__ __forceinline__ void operator()(const f32x4 (&acc)[2][2][4][2], const Unit& u, int wr, int wc, int fr, int fq) const {
        const int row0 = u.pm * 256 + wr * 64 + fr, col0 = u.pn * 256 + wc * 32 + 8 * fq;
        GAS unsigned char* rowp = (GAS unsigned char*)C + (size_t)row0 * 2048 + col0;
#pragma unroll
        for (int ai = 0; ai < 2; ++ai)
#pragma unroll
            for (int m = 0; m < 4; ++m) {
#pragma unroll
                for (int bj = 0; bj < 2; ++bj) { const f32x4 v0 = acc[ai][bj][m][0], v1 = acc[ai][bj][m][1];
                    u32x2 w; w.x = pk4_fp8(v0[0], v0[1], v0[2], v0[3]); w.y = pk4_fp8(v1[0], v1[1], v1[2], v1[3]);
                    *(GAS u32x2*)(rowp + bj * 128) = w; }
                rowp += (size_t)EPI_STEP(m) * 2048;
                asm volatile("" : "+v"(rowp));
            }
    }
};
struct EpiScoreBf16 {
    static constexpr bool PERM = true, AFTER_DRAIN = false, HOOK = false;
    bf16_t* C;
    __device__ __forceinline__ void operator()(const f32x4 (&acc)[2][2][4][2], const Unit& u, int wr, int wc, int fr, int fq) const {
        GAS bf16_t* rowp = (GAS bf16_t*)(C + (size_t)(u.pm * 256 + wr * 64 + (fr & 7)) * 2048 + u.pn * 256 + wc * 64 + ((fr >> 3) * 4 + fq) * 8);
#pragma unroll
        for (int ai = 0; ai < 2; ++ai)
#pragma unroll
            for (int m = 0; m < 4; ++m) { u32x4 w[2];
#pragma unroll
                for (int bj = 0; bj < 2; ++bj) { const f32x4 v0 = acc[ai][bj][m][0], v1 = acc[ai][bj][m][1];
                    w[bj].x = pk2s(v0[0], v0[1]); w[bj].y = pk2s(v0[2], v0[3]); w[bj].z = pk2s(v1[0], v1[1]); w[bj].w = pk2s(v1[2], v1[3]); }
                store_rows8(rowp, (size_t)8 * 2048, w[0], w[1]);
                if (PROBE_DUP == 22) store_rows8(rowp + ((size_t)(WS_PA - WS_PQKV) / 2), (size_t)8 * 2048, w[0], w[1]);
                rowp += (size_t)EPI_STEP(m) * 2048;
                asm volatile("" : "+v"(rowp));
            }
    }
};
struct Ctx {
    LAS unsigned char* lds;
    int tid, lane, wave, G, bx;
    float* out; unsigned char* ws;
};
constexpr int PTR_OFF = TOP_OFF + 512;
__device__ __forceinline__ const float* inptr(const Ctx& C, int i) {
    const LAS unsigned* p = (const LAS unsigned*)(C.lds + PTR_OFF) + 2 * i;
    const unsigned lo = (unsigned)__builtin_amdgcn_readfirstlane((int)p[0]), hi = (unsigned)__builtin_amdgcn_readfirstlane((int)p[1]);
    return (const float*)(const GAS float*)(((unsigned long long)hi << 32) | lo);
}

__device__ __forceinline__ void transpose_item(const float* W, const float* g, int K, int N, bf16_t* WT, LAS float* scr, int item, int lane, int ldw = 0, int koff = 0, int ncols = 0) {
    if (ldw == 0) ldw = K;
    const int nblk = (ncols ? ncols : N) / 32, kb = item / nblk, nb = item % nblk, k0 = 64 * kb, n0 = 32 * nb;
#pragma unroll 8
    for (int i = 0; i < 32; ++i) { const int kk = 2 * i + (lane >> 5); float w = W[(size_t)(k0 + kk) * N + n0 + (lane & 31)]; if (g) w *= g[k0 + kk]; scr[kk * 33 + (lane & 31)] = w; }
    LDS_WAIT();
    const int c = lane & 7;
#pragma unroll
    for (int j = 0; j < 4; ++j) { const int n = (lane >> 3) + 8 * j; const LAS float* s = scr + (8 * c) * 33 + n;
        u32x4 o; o.x = pk2(s[0 * 33], s[1 * 33]); o.y = pk2(s[2 * 33], s[3 * 33]); o.z = pk2(s[4 * 33], s[5 * 33]); o.w = pk2(s[6 * 33], s[7 * 33]);
        *(u32x4*)(WT + (size_t)(n0 + n) * ldw + koff + k0 + 8 * c) = o; }
    LDS_WAIT();
}
__device__ __forceinline__ void transpose_item8(const float* W, const float* g, int K, int N, unsigned char* WT, LAS float* scr, int item, int lane, int ncols, float scale) {
    const int nblk = ncols / 32, kb = item / nblk, nb = item % nblk, k0 = 64 * kb, n0 = 32 * nb;
#pragma unroll 8
    for (int i = 0; i < 32; ++i) { const int kk = 2 * i + (lane >> 5); float w = W[(size_t)(k0 + kk) * N + n0 + (lane & 31)] * scale; if (g) w *= g[k0 + kk]; scr[kk * 33 + (lane & 31)] = fminf(fmaxf(w, -448.f), 448.f); }
    LDS_WAIT();
    const int n = lane >> 1;
#pragma unroll
    for (int j = 0; j < 2; ++j) { const int c = (lane & 1) * 2 + j; const LAS float* s = scr + (16 * c) * 33 + n; u32x4 o;
#pragma unroll
        for (int q = 0; q < 4; ++q) { int pk = 0; pk = __builtin_amdgcn_cvt_pk_fp8_f32(s[(4 * q) * 33], s[(4 * q + 1) * 33], pk, false); pk = __builtin_amdgcn_cvt_pk_fp8_f32(s[(4 * q + 2) * 33], s[(4 * q + 3) * 33], pk, true); o[q] = (unsigned)pk; }
        *(u32x4*)(WT + (size_t)(n0 + n) * K + k0 + 16 * c) = o; }
    LDS_WAIT();
}
__device__ __forceinline__ void cvt_rows(const Ctx& C, const float* src, const float* g, bf16_t* dst, size_t nelem) {
    const size_t n8 = nelem / 8, stride = (size_t)C.G * NTHR;
    for (size_t i = (size_t)C.bx * NTHR + C.tid; i < n8; i += stride) {
        f32x4 a = *(const f32x4*)(src + i * 8), b = *(const f32x4*)(src + i * 8 + 4);
        if (g) { const int d = (int)((i * 8) & 2047); const f32x4 ga = *(const f32x4*)(g + d), gb = *(const f32x4*)(g + d + 4); a = a * ga; b = b * gb; }
        u32x4 w; w.x = pk2(a[0], a[1]); w.y = pk2(a[2], a[3]); w.z = pk2(b[0], b[1]); w.w = pk2(b[2], b[3]);
        *(u32x4*)(dst + i * 8) = w;
    }
}

__device__ __forceinline__ void cvt_rows_fp8(const Ctx& C, const float* src, const float* g, unsigned char* dst, size_t nelem, float scale) {
    const size_t n16 = nelem / 16, stride = (size_t)C.G * NTHR;
    for (size_t i = (size_t)C.bx * NTHR + C.tid; i < n16; i += stride) {
        u32x4 w;
#pragma unroll
        for (int q = 0; q < 4; ++q) {
            f32x4 a = *(const f32x4*)(src + i * 16 + q * 4);
            if (g) { const int d = (int)((i * 16 + q * 4) & 2047); a = a * *(const f32x4*)(g + d); }
            a = a * scale;
#pragma unroll
            for (int j = 0; j < 4; ++j) a[j] = fminf(fmaxf(a[j], -448.f), 448.f);
            int pk = 0; pk = __builtin_amdgcn_cvt_pk_fp8_f32(a[0], a[1], pk, false); pk = __builtin_amdgcn_cvt_pk_fp8_f32(a[2], a[3], pk, true);
            w[q] = (unsigned)pk;
        }
        *(u32x4*)(dst + i * 16) = w;
    }
}

__device__ __forceinline__ void cvt_rows_fp4(const Ctx& C, const float* src, const float* g, unsigned char* dst, size_t nelem, float scale) {
    const size_t n32 = nelem / 32, stride = (size_t)C.G * NTHR;
    size_t i = (size_t)C.bx * NTHR + C.tid;
    f32x4 nx[8];
    if (i < n32) {
#pragma unroll
        for (int q = 0; q < 8; ++q) nx[q] = *(const f32x4*)(src + i * 32 + q * 4); }
    for (; i < n32; i += stride) {
        f32x4 cu[8];
#pragma unroll
        for (int q = 0; q < 8; ++q) cu[q] = nx[q];
        const size_t in = i + stride;
        if (in < n32) {
#pragma unroll
            for (int q = 0; q < 8; ++q) nx[q] = *(const f32x4*)(src + in * 32 + q * 4); }
        u32x4 w;
#pragma unroll
        for (int q = 0; q < 4; ++q) { unsigned pk = 0u;
            f32x4 a = cu[2 * q], b2 = cu[2 * q + 1];
            if (g) { const int d = (int)((i * 32 + q * 8) & 2047); a = a * *(const f32x4*)(g + d); b2 = b2 * *(const f32x4*)(g + d + 4); }
            a = a * scale; b2 = b2 * scale;
            pk = __builtin_amdgcn_cvt_scalef32_pk_fp4_f32(pk, a[0], a[1], 1.0f, 0); pk = __builtin_amdgcn_cvt_scalef32_pk_fp4_f32(pk, a[2], a[3], 1.0f, 1);
            pk = __builtin_amdgcn_cvt_scalef32_pk_fp4_f32(pk, b2[0], b2[1], 1.0f, 2); pk = __builtin_amdgcn_cvt_scalef32_pk_fp4_f32(pk, b2[2], b2[3], 1.0f, 3);
            w[q] = pk; }
        *(u32x4*)(dst + i * 16) = w;
    }
}
__device__ __forceinline__ void cvt_layer_weights(const Ctx& C, int l) {
    LAS float* scr = (LAS float*)(C.lds + C.wave * 16384);
    const int gw = C.bx * NWAVES + C.wave, NGW = C.G * NWAVES;
    const float* w_in = inptr(C, 3) + (size_t)l * D * INW; const float* gmix = inptr(C, 2) + (size_t)l * D;
    const float* wa = inptr(C, 9) + (size_t)l * 1024 * D; const float* wb = inptr(C, 10) + (size_t)l * 1024 * D; const float* wc = inptr(C, 11) + (size_t)l * 512 * D;
    const float* wo = inptr(C, 12) + (size_t)l * D * D;
    bf16_t* WIN = (bf16_t*)(C.ws + WS_WIN); bf16_t* WA = (bf16_t*)(C.ws + WS_WA); bf16_t* WB = (bf16_t*)(C.ws + WS_WB); bf16_t* WC = (bf16_t*)(C.ws + WS_WC);
    bf16_t* WOUT = (bf16_t*)(C.ws + WS_WOUT);
    constexpr int NBF = G1_NBF, NG8 = INW - G1_NBF;
    constexpr int I_IN = (D / 64) * (NBF / 32), I_G8 = (D / 64) * (NG8 / 32), I_A = (1024 / 64) * (D / 32), I_C = (512 / 64) * (D / 32), I_O = (D / 64) * (D / 32);
    constexpr int NITEMS = I_IN + I_G8 + 2 * I_A + I_C + I_O;
    struct TrD { const float* W; const float* g; unsigned char* WT; int N, nblk, ldw, koff, fp8; };
    constexpr int T_IN = (D / 64) * (NBF / 256), T_G8 = (D / 64) * (NG8 / 256), T_A = (1024 / 64) * (D / 256), T_C = (512 / 64) * (D / 256), T_O = (D / 64) * (D / 256);
    constexpr int NTILES = T_IN + T_G8 + 2 * T_A + T_C + T_O;
#define TR_DESC(dd, it_) do { int r_ = (it_); \
        if (r_ < T_IN) { dd = TrD{w_in, gmix, (unsigned char*)WIN, INW, NBF / 256, D, 0, 0}; } else { r_ -= T_IN; \
        if (r_ < T_G8) { dd = TrD{w_in + NBF, gmix, C.ws + WS_WIN8, INW, NG8 / 256, D, 0, 1}; } else { r_ -= T_G8; \
        if (r_ < T_A) { dd = TrD{wa, nullptr, (unsigned char*)WA, D, D / 256, 2560, 0, BR8}; } else { r_ -= T_A; \
        if (r_ < T_A) { dd = TrD{wb, nullptr, (unsigned char*)WA, D, D / 256, 2560, 1024, BR8}; } else { r_ -= T_A; \
        if (r_ < T_C) { dd = TrD{wc, nullptr, (unsigned char*)WA, D, D / 256, 2560, 2048, BR8}; } else { r_ -= T_C; \
        dd = TrD{wo, nullptr, (unsigned char*)WOUT, D, D / 256, D, 0, 0}; } } } } } ritem = r_; } while (0)
#define TR_LOAD(dd, ri, v) do { const int kb_ = (ri) / dd.nblk, nb_ = (ri) - kb_ * dd.nblk, k0_ = 64 * kb_, n0_ = 256 * nb_; \
        _Pragma("unroll") for (int i = 0; i < 8; ++i) { const int kk = (C.tid >> 6) + 8 * i; f32x4 w = *(const f32x4*)(dd.W + (size_t)(k0_ + kk) * dd.N + n0_ + 4 * (C.tid & 63)); if (dd.g) w = w * dd.g[k0_ + kk]; v[i] = w; } } while (0)
    LAS float* tile = (LAS float*)C.lds;
    auto tr_store = [&](const TrD& dd, int ri, const f32x4 (&v)[8]) {
        const int kb = ri / dd.nblk, nb = ri - kb * dd.nblk, k0 = 64 * kb, n0 = 256 * nb;
        __syncthreads();
#pragma unroll
        for (int i = 0; i < 8; ++i) { const int kk = (C.tid >> 6) + 8 * i; LAS float* tp = tile + kk * 257 + 4 * (C.tid & 63);
#pragma unroll
            for (int j = 0; j < 4; ++j) tp[j] = dd.fp8 ? fminf(fmaxf(v[i][j] * 1024.f, -448.f), 448.f) : v[i][j]; }
        __syncthreads();
        if (dd.fp8) { const int c = C.tid & 3;
#pragma unroll
            for (int j = 0; j < 2; ++j) { const int n = (C.tid >> 2) + 128 * j; const LAS float* sq = tile + (16 * c) * 257 + n; u32x4 o;
#pragma unroll
                for (int q = 0; q < 4; ++q) { int pk = 0; pk = __builtin_amdgcn_cvt_pk_fp8_f32(sq[(4 * q) * 257], sq[(4 * q + 1) * 257], pk, false); pk = __builtin_amdgcn_cvt_pk_fp8_f32(sq[(4 * q + 2) * 257], sq[(4 * q + 3) * 257], pk, true); o[q] = (unsigned)pk; }
                *(u32x4*)(dd.WT + (size_t)(n0 + n) * dd.ldw + dd.koff + k0 + 16 * c) = o; } }
        else { const int c = C.tid & 7;
#pragma unroll
            for (int j = 0; j < 4; ++j) { const int n = (C.tid >> 3) + 64 * j; const LAS float* sq = tile + (8 * c) * 257 + n;
                u32x4 o; o.x = pk2(sq[0 * 257], sq[1 * 257]); o.y = pk2(sq[2 * 257], sq[3 * 257]); o.z = pk2(sq[4 * 257], sq[5 * 257]); o.w = pk2(sq[6 * 257], sq[7 * 257]);
                *(u32x4*)((bf16_t*)dd.WT + (size_t)(n0 + n) * dd.ldw + dd.koff + k0 + 8 * c) = o; } }
    };
    {
        f32x4 va[8], vb[8]; TrD da, db; int ritem = 0, ra = 0, rb = 0;
        int it = C.bx;
        if (it < NTILES) { TR_DESC(da, it); ra = ritem; TR_LOAD(da, ra, va); }
        while (it < NTILES) {
            const int it1 = it + C.G;
            if (it1 < NTILES) { TR_DESC(db, it1); rb = ritem; TR_LOAD(db, rb, vb); }
            tr_store(da, ra, va);
            if (it1 >= NTILES) break;
            const int it2 = it1 + C.G;
            if (it2 < NTILES) { TR_DESC(da, it2); ra = ritem; TR_LOAD(da, ra, va); }
            tr_store(db, rb, vb);
            it = it2;
        }
        __syncthreads();
    }
#undef TR_DESC
#undef TR_LOAD
    const size_t gt = (size_t)C.bx * NTHR + C.tid, gs = (size_t)C.G * NTHR;
    {
        const float* wq = inptr(C, 14) + (size_t)l * D * D; const float* k1 = inptr(C, 15) + (size_t)l * 128 * 128; const float* k2 = inptr(C, 16) + (size_t)l * 128 * 128;
        const float* gf = inptr(C, 13) + (size_t)l * D; bf16_t* WSC = (bf16_t*)(C.ws + WS_WSC);
        const int q = C.lane >> 4, r16 = C.lane & 15;
        for (int item = gw; item < 2048; item += NGW) {
            const int nb = item >> 7, mt = (item >> 4) & 7, kc = item & 15;
            const float* kr = ((nb & 1) ? k2 : k1) + (size_t)(mt * 16 + r16) * 128 + 4 * q;
            f32x4 bfr[8];
#pragma unroll
            for (int s = 0; s < 8; ++s) bfr[s] = *(const f32x4*)(kr + 16 * s);
            f32x4 an[8];
            { const float* ar0 = wq + (size_t)((kc * 8) * 16 + r16) * D + nb * 128 + 4 * q;
#pragma unroll
              for (int s = 0; s < 8; ++s) an[s] = *(const f32x4*)(ar0 + 16 * s); }
            for (int t = 0; t < 8; ++t) { const int k0 = (kc * 8 + t) * 16;
                f32x4 av[8];
#pragma unroll
                for (int s = 0; s < 8; ++s) av[s] = an[s];
                if (t < 7) { const float* arn = wq + (size_t)(k0 + 16 + r16) * D + nb * 128 + 4 * q;
#pragma unroll
                    for (int s = 0; s < 8; ++s) an[s] = *(const f32x4*)(arn + 16 * s); }
                f32x4 acc = {0.f, 0.f, 0.f, 0.f};
#pragma unroll
                for (int s = 0; s < 8; ++s) {
#pragma unroll
                    for (int e2 = 0; e2 < 4; ++e2) acc = __builtin_amdgcn_mfma_f32_16x16x4f32(av[s][e2], bfr[s][e2], acc, 0, 0, 0); }
                const f32x4 gv = *(const f32x4*)(gf + k0 + 4 * q);
                u32x2 w; w.x = pk2(acc[0] * gv[0], acc[1] * gv[1]); w.y = pk2(acc[2] * gv[2], acc[3] * gv[3]);
                *(u32x2*)(WSC + (size_t)(nb * 128 + mt * 16 + r16) * D + k0 + 4 * q) = w; }
        }
    }
    {
        const float* ws_ = inptr(C, 5) + (size_t)l * 8 * 128 * 128; bf16_t* WM = (bf16_t*)(C.ws + WS_WM);
        for (size_t i = gt; i < (size_t)8 * 128 * 128; i += gs) { const int s = (int)(i & 127), t = (int)((i >> 7) & 127); WM[i] = (bf16_t)f2bf(s <= t ? ws_[i] : 0.f); }
    }
    {
        const float* wp = inptr(C, 7) + (size_t)l * 4 * 256 * 256; const float* sc = inptr(C, 8) + (size_t)l * 1024; bf16_t* WP = (bf16_t*)(C.ws + WS_WP);
        for (size_t i = gt; i < (size_t)4 * 256 * 256; i += gs) { const int c = (int)(i & 255), e = (int)((i >> 8) & 255), g = (int)(i >> 16); WP[i] = (bf16_t)f2bf(wp[((size_t)g * 256 + c) * 256 + e] * sc[g * 256 + e]); }
    }
}
__device__ __forceinline__ void prologue(const Ctx& C) {
    for (int l = 0; l < (BG_TABLES ? ((BG_TABLES0 && C.G == 256) ? 0 : 1) : DEPTH); ++l) {
#if PEER_FP4
        cvt_rows_fp4(C, inptr(C, 17) + (size_t)l * NEXP * D, inptr(C, 13) + (size_t)l * D, C.ws + WS_U + (size_t)l * NEXP * (D / 2), (size_t)NEXP * D, SCALE_U4);
        cvt_rows_fp4(C, inptr(C, 18) + (size_t)l * NEXP * D, nullptr, C.ws + WS_V + (size_t)l * NEXP * (D / 2), (size_t)NEXP * D, SCALE_V4);
#else
        cvt_rows_fp8(C, inptr(C, 17) + (size_t)l * NEXP * D, inptr(C, 13) + (size_t)l * D, C.ws + WS_U + (size_t)l * NEXP * D, (size_t)NEXP * D, 1024.f);
        cvt_rows_fp8(C, inptr(C, 18) + (size_t)l * NEXP * D, nullptr, C.ws + WS_V + (size_t)l * NEXP * D, (size_t)NEXP * D, 64.f);
#endif
    }
    cvt_layer_weights(C, 0);
    const int gw = C.bx * NWAVES + C.wave, NGW = C.G * NWAVES;
    const float* x = inptr(C, 0); bf16_t* XB = (bf16_t*)(C.ws + WS_XB); float* RS = (float*)(C.ws + WS_RSTD);
    f32x4 nv[8];
    { const f32x4* xr = (const f32x4*)(x + (size_t)min(gw, T - 1) * D) + C.lane;
#pragma unroll
      for (int j = 0; j < 8; ++j) nv[j] = xr[64 * j]; }
    for (int m = gw; m < T; m += NGW) {
        f32x4 v[8]; float s = 0.f;
#pragma unroll
        for (int j = 0; j < 8; ++j) { v[j] = nv[j]; s += (v[j][0] * v[j][0] + v[j][1] * v[j][1]) + (v[j][2] * v[j][2] + v[j][3] * v[j][3]); }
        { const f32x4* xr = (const f32x4*)(x + (size_t)min(m + NGW, T - 1) * D) + C.lane;
#pragma unroll
          for (int j = 0; j < 8; ++j) nv[j] = xr[64 * j]; }
        s = wave_sum(s);
        u32x2* o = (u32x2*)(XB + (size_t)m * D) + C.lane; unsigned* o8 = (unsigned*)(C.ws + WS_XB8 + (size_t)m * D) + C.lane;
#pragma unroll
        for (int j = 0; j < 8; ++j) { u32x2 w; w.x = pk2(v[j][0], v[j][1]); w.y = pk2(v[j][2], v[j][3]); o[64 * j] = w;
            int pk = 0; pk = __builtin_amdgcn_cvt_pk_fp8_f32(fminf(fmaxf(v[j][0], -448.f), 448.f), fminf(fmaxf(v[j][1], -448.f), 448.f), pk, false);
            pk = __builtin_amdgcn_cvt_pk_fp8_f32(fminf(fmaxf(v[j][2], -448.f), 448.f), fminf(fmaxf(v[j][3], -448.f), 448.f), pk, true); o8[64 * j] = (unsigned)pk; }
        if (C.lane == 0) RS[m] = rsqrtf(s * (1.0f / D) + EPS);
    }
}

__device__ __forceinline__ void att_naive(const Ctx& C) {
    const bf16_t* P = (const bf16_t*)(C.ws + WS_PQKV); bf16_t* OG = (bf16_t*)(C.ws + WS_OG); float* LSE = (float*)(C.ws + WS_LSE); const float* rel = inptr(C, 1);
    LAS float* pl = (LAS float*)(C.lds + C.wave * 1024);
    const int gw = C.bx * NWAVES + C.wave, NGW = C.G * NWAVES, lane = C.lane;
    for (int item = gw; item < 12 * T; item += NGW) {
        const int gh = item / T, token = item - gh * T, g = gh >> 2, h = gh & 3;
        const int d = g == 0 ? 1 : (g == 1 ? 4 : 16);
        const int tl = token & (SEQ - 1);
        const int jmax = min(128, tl / d);
        const bf16_t* qrow = P + (size_t)token * 4608 + gh * 128;
        float lg[3]; bool okk[3];
#pragma unroll
        for (int s = 0; s < 3; ++s) {
            const int j = lane + 64 * s; const bool ok = (j <= jmax); const int jj = ok ? j : 0;
            const bf16_t* krow = P + (size_t)(token - jj * d) * 4608 + 1536 + gh * 128;
            float acc = 0.f;
#pragma unroll 4
            for (int c = 0; c < 16; ++c) acc += dot8(*(const u32x4*)(qrow + c * 8), *(const u32x4*)(krow + c * 8));
            const float bias = rel[(int)kBucket[g * 129 + jj] * 12 + gh];
            lg[s] = ok ? acc + bias : -1e30f; okk[s] = ok;
        }
        const float mx = wave_max(fmaxf(lg[0], fmaxf(lg[1], lg[2])));
        const float e0 = okk[0] ? __expf(lg[0] - mx) : 0.f, e1 = okk[1] ? __expf(lg[1] - mx) : 0.f, e2 = okk[2] ? __expf(lg[2] - mx) : 0.f;
        const float ssum = wave_sum(e0 + e1 + e2);
        pl[lane] = e0; pl[lane + 64] = e1; if (lane == 0) pl[128] = e2;
        LDS_WAIT();
        float o0 = 0.f, o1 = 0.f;
        const bf16_t* vb = P + (size_t)token * 4608 + 3072 + gh * 128 + 2 * lane;
        for (int j = 0; j <= jmax; ++j) { const float p = pl[j]; const unsigned vv = *(const unsigned*)(vb - (size_t)j * d * 4608); o0 += p * bflo(vv); o1 += p * bfhi(vv); }
        const float inv = 1.0f / ssum;
        *(unsigned*)(OG + ((size_t)g * T + token) * 512 + h * 128 + 2 * lane) = pk2(o0 * inv, o1 * inv);
        if (lane == 0) LSE[((size_t)g * T + token) * 4 + h] = mx + __logf(ssum);
        LDS_WAIT();
    }
}
__device__ __forceinline__ void vss_rows(const Ctx& C) {
    const GAS bf16_t* PA = (const GAS bf16_t*)(C.ws + WS_PA); GAS float* VS = (GAS float*)(C.ws + WS_RSTD + 131072);
    const int gw = C.bx * NWAVES + C.wave, NGW = C.G * NWAVES;
    u32x4 n0, n1;
    { const GAS u32x4* r = (const GAS u32x4*)(PA + (size_t)min(gw, T - 1) * 2048 + 1024) + C.lane; n0 = r[0]; n1 = r[64]; }
    for (int m = gw; m < T; m += NGW) {
        const u32x4 w0 = n0, w1 = n1;
        { const GAS u32x4* r = (const GAS u32x4*)(PA + (size_t)min(m + NGW, T - 1) * 2048 + 1024) + C.lane; n0 = r[0]; n1 = r[64]; }
        const float s = wave_sum(dot8(w0, w0) + dot8(w1, w1));
        if (C.lane == 0) VS[m] = rsqrtf(s * (1.0f / 1024.0f) + EPS);
    }
}
__device__ __forceinline__ void mixa_naive(const Ctx& C, int l) {
    const bf16_t* PA = (const bf16_t*)(C.ws + WS_PA); const float* VS = (const float*)(C.ws + WS_RSTD + 131072); const bf16_t* WM = (const bf16_t*)(C.ws + WS_WM);
    bf16_t* YA = (bf16_t*)(C.ws + WS_YA); const float* ang = inptr(C, 4) + (size_t)l * 1024; const float* bs = inptr(C, 6) + (size_t)l * 1024;
    const int gw = C.bx * NWAVES + C.wave, NGW = C.G * NWAVES, lane = C.lane;
    for (int item = gw; item < 8 * T; item += NGW) {
        const int h = item / T, token = item - h * T, t = token & 127, c0 = token - t;
        float s0 = 0.f, s1 = 0.f;
        const bf16_t* wrow = WM + ((size_t)h * 128 + t) * 128;
        for (int s = 0; s <= t; ++s) { const float w = bf2f(wrow[s]) * VS[c0 + s]; const unsigned vv = *(const unsigned*)(PA + (size_t)(c0 + s) * 2048 + 1024 + h * 128 + 2 * lane); s0 += w * bflo(vv); s1 += w * bfhi(vv); }
        const float b = bs[h * 128 + t];
        const float S0 = s0 * ang[h * 128 + 2 * lane] + b, S1 = s1 * ang[h * 128 + 2 * lane + 1] + b;
        const unsigned uu = *(const unsigned*)(PA + (size_t)token * 2048 + h * 128 + 2 * lane);
        *(unsigned*)(YA + (size_t)token * 2560 + h * 128 + 2 * lane) = pk2(bflo(uu) * S0, bfhi(uu) * S1);
    }
}
__device__ __forceinline__ void mixb_naive(const Ctx& C) {
    const bf16_t* PB = (const bf16_t*)(C.ws + WS_PB); const bf16_t* WP = (const bf16_t*)(C.ws + WS_WP); bf16_t* YB = (bf16_t*)(C.ws + WS_YA);
    const int half = C.tid >> 8, c = C.tid & 255; LAS float* dsh = (LAS float*)(C.lds + half * 1024);
    for (int base = C.bx * 2; base < 4 * T; base += C.G * 2) {
        const int it = base + half, gb = it & 3, token = it >> 2, tl = token & (SEQ - 1);
        const int w = 2 << gb, cnt = min(w, tl + 1), col = gb * 256 + c;
        float sum = 0.f;
        for (int j = 0; j < cnt; ++j) sum += bf2f(PB[(size_t)(token - j) * 1024 + col]);
        dsh[c] = sum / (float)cnt - bf2f(PB[(size_t)token * 1024 + col]);
        __syncthreads();
        const bf16_t* wr = WP + ((size_t)gb * 256 + c) * 256; float y = 0.f;
#pragma unroll 4
        for (int k = 0; k < 256; k += 8) { const u32x4 wv = *(const u32x4*)(wr + k);
            y += dsh[k] * bflo(wv.x) + dsh[k + 1] * bfhi(wv.x) + dsh[k + 2] * bflo(wv.y) + dsh[k + 3] * bfhi(wv.y) + dsh[k + 4] * bflo(wv.z) + dsh[k + 5] * bfhi(wv.z) + dsh[k + 6] * bflo(wv.w) + dsh[k + 7] * bfhi(wv.w); }
        YB[(size_t)token * 2560 + 1024 + col] = (bf16_t)f2bf(y);
        __syncthreads();
    }
}
struct BgRow { f32x4 x[8]; };
__device__ __forceinline__ void bg_load(BgRow& r, const GAS float* row, int lane) {
    asm volatile("" : "+v"(lane));
#pragma unroll
    for (int q = 0; q < 8; ++q) r.x[q] = *(const GAS f32x4*)(row + 32 * lane + 4 * q); }
template <bool GAIN> __device__ __forceinline__ void bg_store(const BgRow& r, const GAS float* gain, GAS unsigned char* dst, int lane) {
    asm volatile("" : "+v"(lane));
    u32x4 w;
#pragma unroll
    for (int q = 0; q < 4; ++q) { unsigned pk = 0u; f32x4 a = r.x[2 * q], b2 = r.x[2 * q + 1];
        if (GAIN) { a = a * *(const GAS f32x4*)(gain + 32 * lane + 8 * q) * SCALE_U4; b2 = b2 * *(const GAS f32x4*)(gain + 32 * lane + 8 * q + 4) * SCALE_U4; } else { a = a * SCALE_V4; b2 = b2 * SCALE_V4; }
        pk = __builtin_amdgcn_cvt_scalef32_pk_fp4_f32(pk, a[0], a[1], 1.0f, 0); pk = __builtin_amdgcn_cvt_scalef32_pk_fp4_f32(pk, a[2], a[3], 1.0f, 1);
        pk = __builtin_amdgcn_cvt_scalef32_pk_fp4_f32(pk, b2[0], b2[1], 1.0f, 2); pk = __builtin_amdgcn_cvt_scalef32_pk_fp4_f32(pk, b2[2], b2[3], 1.0f, 3); w[q] = pk; }
    *(GAS u32x4*)(dst + 16 * lane) = w; }
__device__ __forceinline__ void combine_groups(const Ctx& C, bool bg = false) {
    const GAS float* bgsrc = (const GAS float*)inptr(C, 17); const GAS float* bggain = (const GAS float*)inptr(C, 13); GAS unsigned char* bgdst = (GAS unsigned char*)(C.ws + WS_U); BgRow bgr; int bgj = 0;
    const GAS bf16_t* OG = (const GAS bf16_t*)(C.ws + WS_OG); const GAS float* LSE = (const GAS float*)(C.ws + WS_LSE); GAS bf16_t* YC = (GAS bf16_t*)(C.ws + WS_YA);
    const int gw = C.bx * NWAVES + C.wave, NGW = C.G * NWAVES, lane = C.lane, h = lane >> 4;
    float nl0 = 0.f, nl1 = 0.f, nl2 = 0.f; u32x4 na = {0u, 0u, 0u, 0u}, nb = na, nc = na;
#define CMB_LOAD(m_) do { const int mm_ = min((m_), T - 1); nl0 = LSE[((size_t)0 * T + mm_) * 4 + h]; nl1 = LSE[((size_t)1 * T + mm_) * 4 + h]; nl2 = LSE[((size_t)2 * T + mm_) * 4 + h]; \
        na = *((const GAS u32x4*)(OG + ((size_t)0 * T + mm_) * 512) + lane); nb = *((const GAS u32x4*)(OG + ((size_t)1 * T + mm_) * 512) + lane); nc = *((const GAS u32x4*)(OG + ((size_t)2 * T + mm_) * 512) + lane); } while (0)
    CMB_LOAD(gw);
    for (int m = gw; m < T; m += NGW) {
        const float l0 = nl0, l1 = nl1, l2 = nl2; const u32x4 a = na, b = nb, c = nc;
        CMB_LOAD(m + NGW);
        const int bgrow = 8192 + bgj * NGW + gw; const bool bgon = bg && bgj < 4; ++bgj;
        if (bgon) bg_load(bgr, bgsrc + (size_t)bgrow * D, lane);
        const float mx = fmaxf(l0, fmaxf(l1, l2)); float w0 = __expf(l0 - mx), w1 = __expf(l1 - mx), w2 = __expf(l2 - mx); const float inv = 1.0f / (w0 + w1 + w2); w0 *= inv; w1 *= inv; w2 *= inv;
        if (BR8) { w0 *= Y8S; w1 *= Y8S; w2 *= Y8S; u32x2 o;
            o.x = pk4_fp8(w0 * bflo(a.x) + w1 * bflo(b.x) + w2 * bflo(c.x), w0 * bfhi(a.x) + w1 * bfhi(b.x) + w2 * bfhi(c.x), w0 * bflo(a.y) + w1 * bflo(b.y) + w2 * bflo(c.y), w0 * bfhi(a.y) + w1 * bfhi(b.y) + w2 * bfhi(c.y));
            o.y = pk4_fp8(w0 * bflo(a.z) + w1 * bflo(b.z) + w2 * bflo(c.z), w0 * bfhi(a.z) + w1 * bfhi(b.z) + w2 * bfhi(c.z), w0 * bflo(a.w) + w1 * bflo(b.w) + w2 * bflo(c.w), w0 * bfhi(a.w) + w1 * bfhi(b.w) + w2 * bfhi(c.w));
            *((GAS u32x2*)((GAS unsigned char*)YC + (size_t)m * 2560 + 2048) + lane) = o; }
        else { u32x4 o;
        o.x = pk2(w0 * bflo(a.x) + w1 * bflo(b.x) + w2 * bflo(c.x), w0 * bfhi(a.x) + w1 * bfhi(b.x) + w2 * bfhi(c.x));
        o.y = pk2(w0 * bflo(a.y) + w1 * bflo(b.y) + w2 * bflo(c.y), w0 * bfhi(a.y) + w1 * bfhi(b.y) + w2 * bfhi(c.y));
        o.z = pk2(w0 * bflo(a.z) + w1 * bflo(b.z) + w2 * bflo(c.z), w0 * bfhi(a.z) + w1 * bfhi(b.z) + w2 * bfhi(c.z));
        o.w = pk2(w0 * bflo(a.w) + w1 * bflo(b.w) + w2 * bflo(c.w), w0 * bfhi(a.w) + w1 * bfhi(b.w) + w2 * bfhi(c.w));
        *((GAS u32x4*)(YC + (size_t)m * 2560 + 2048) + lane) = o; }
        if (bgon) bg_store<true>(bgr, bggain, bgdst + (size_t)bgrow * (D / 2), lane);
    }
#undef CMB_LOAD
}
__device__ __forceinline__ void peer_naive(const Ctx& C, int l, bool last) {
    LAS float* xs = (LAS float*)(C.lds); LAS float* sc = (LAS float*)(C.lds + 8192);
    LAS float* v1s = (LAS float*)(C.lds + 16384); LAS int* i1s = (LAS int*)(C.lds + 16896); LAS float* v2s = (LAS float*)(C.lds + 17408); LAS int* i2s = (LAS int*)(C.lds + 17920);
    LAS int* ex = (LAS int*)(C.lds + 18432); LAS float* gt = (LAS float*)(C.lds + 18944); LAS float* hs = (LAS float*)(C.lds + 19456); LAS float* red = (LAS float*)(C.lds + 19968);
    LAS float* selv = (LAS float*)(C.lds + 20480); LAS int* sele = (LAS int*)(C.lds + 20992);
    const float* SC = (const float*)(C.ws + WS_PQKV); const bf16_t* U = (const bf16_t*)(C.ws + WS_U) + (size_t)l * NEXP * D; const bf16_t* V = (const bf16_t*)(C.ws + WS_V) + (size_t)l * NEXP * D;
    bf16_t* XB = (bf16_t*)(C.ws + WS_XB); float* RS = (float*)(C.ws + WS_RSTD); const float* fg = inptr(C, 19);
    const int tid = C.tid, lane = C.lane, wave = C.wave, h = wave;
    for (int token = C.bx; token < T; token += C.G) {
        const f32x4 xv = *((const f32x4*)(C.out + (size_t)token * D) + tid);
        *((LAS f32x4*)xs + tid) = xv; *((LAS f32x4*)sc + tid) = *((const f32x4*)(SC + (size_t)token * D) + tid);
        float ss = wave_sum((xv[0] * xv[0] + xv[1] * xv[1]) + (xv[2] * xv[2] + xv[3] * xv[3]));
        if (lane == 0) red[wave] = ss;
        __syncthreads();
        ss = 0.f;
#pragma unroll
        for (int i = 0; i < 8; ++i) ss += red[i];
        const float rstd = rsqrtf(ss * (1.0f / D) + EPS);
#pragma unroll
        for (int half = 0; half < 2; ++half) { const LAS float* src = sc + h * 256 + half * 128; LAS float* vd = half ? v2s : v1s; LAS int* id = half ? i2s : i1s;
#pragma unroll
            for (int q = 0; q < 2; ++q) { const int j = lane + 64 * q; const float v = src[j]; int rank = 0;
                for (int i = 0; i < 128; ++i) { const float u = src[i]; rank += (u > v || (u == v && i < j)) ? 1 : 0; }
                if (rank < 16) { vd[h * 16 + rank] = v; id[h * 16 + rank] = j; } } }
        __syncthreads();
#pragma unroll
        for (int q = 0; q < 4; ++q) { const int pos = lane + 64 * q; const float cv = v1s[h * 16 + (pos >> 4)] + v2s[h * 16 + (pos & 15)]; int rank = 0;
            for (int i = 0; i < 256; ++i) { const float u = v1s[h * 16 + (i >> 4)] + v2s[h * 16 + (i & 15)]; rank += (u > cv || (u == cv && i < pos)) ? 1 : 0; }
            if (rank < 16) { selv[h * 16 + rank] = cv; sele[h * 16 + rank] = i1s[h * 16 + (pos >> 4)] * 128 + i2s[h * 16 + (pos & 15)]; } }
        __syncthreads();
        { const float v = selv[h * 16 + (lane & 15)] * rstd; float mx = v;
#pragma unroll
          for (int o = 1; o < 16; o <<= 1) mx = fmaxf(mx, __shfl_xor(mx, o));
          const float e = __expf(v - mx); float sm = e;
#pragma unroll
          for (int o = 1; o < 16; o <<= 1) sm += __shfl_xor(sm, o);
          if (lane < 16) { gt[h * 16 + lane] = e / sm; ex[h * 16 + lane] = sele[h * 16 + lane]; } }
        __syncthreads();
        { float xr[32];
#pragma unroll
          for (int i = 0; i < 4; ++i) { const f32x4 a = *(const LAS f32x4*)(xs + i * 512 + lane * 8), b = *(const LAS f32x4*)(xs + i * 512 + lane * 8 + 4);
              xr[i * 8 + 0] = a[0]; xr[i * 8 + 1] = a[1]; xr[i * 8 + 2] = a[2]; xr[i * 8 + 3] = a[3]; xr[i * 8 + 4] = b[0]; xr[i * 8 + 5] = b[1]; xr[i * 8 + 6] = b[2]; xr[i * 8 + 7] = b[3]; }
          for (int kk = 0; kk < 16; ++kk) { const int k = wave * 16 + kk; const bf16_t* urow = U + (size_t)ex[k] * D; float acc = 0.f;
#pragma unroll
              for (int i = 0; i < 4; ++i) { const u32x4 uv = *(const u32x4*)(urow + i * 512 + lane * 8);
                  acc += xr[i * 8 + 0] * bflo(uv.x) + xr[i * 8 + 1] * bfhi(uv.x) + xr[i * 8 + 2] * bflo(uv.y) + xr[i * 8 + 3] * bfhi(uv.y)
                       + xr[i * 8 + 4] * bflo(uv.z) + xr[i * 8 + 5] * bfhi(uv.z) + xr[i * 8 + 6] * bflo(uv.w) + xr[i * 8 + 7] * bfhi(uv.w); }
              acc = wave_sum(acc);
              if (lane == 0) hs[k] = gelu_erf(acc * rstd) * gt[k]; } }
        __syncthreads();
        float y0 = 0.f, y1 = 0.f, y2 = 0.f, y3 = 0.f;
#pragma unroll 8
        for (int k = 0; k < 128; ++k) { const float hk = hs[k]; const u32x2 vv = *(const u32x2*)(V + (size_t)ex[k] * D + tid * 4);
            y0 += hk * bflo(vv.x); y1 += hk * bfhi(vv.x); y2 += hk * bflo(vv.y); y3 += hk * bfhi(vv.y); }
        f32x4 xn; xn[0] = xv[0] + y0; xn[1] = xv[1] + y1; xn[2] = xv[2] + y2; xn[3] = xv[3] + y3;
        float s2 = wave_sum((xn[0] * xn[0] + xn[1] * xn[1]) + (xn[2] * xn[2] + xn[3] * xn[3]));
        if (lane == 0) red[8 + wave] = s2;
        __syncthreads();
        s2 = 0.f;
#pragma unroll
        for (int i = 0; i < 8; ++i) s2 += red[8 + i];
        const float rstd2 = rsqrtf(s2 * (1.0f / D) + EPS);
        if (last) { const f32x4 g = *((const f32x4*)fg + tid); f32x4 o; o[0] = xn[0] * rstd2 * g[0]; o[1] = xn[1] * rstd2 * g[1]; o[2] = xn[2] * rstd2 * g[2]; o[3] = xn[3] * rstd2 * g[3];
            *((f32x4*)(C.out + (size_t)token * D) + tid) = o; }
        else { *((f32x4*)(C.out + (size_t)token * D) + tid) = xn; u32x2 w; w.x = pk2(xn[0], xn[1]); w.y = pk2(xn[2], xn[3]); *((u32x2*)(XB + (size_t)token * D) + tid) = w;
            if (tid == 0) RS[token] = rstd2; }
        __syncthreads();
    }
}


typedef short s16x4 __attribute__((ext_vector_type(4)));
using pg8::bf16x8;
__device__ __forceinline__ s16x4 tr_read(const LAS unsigned char* p) { return __builtin_bit_cast(s16x4, __builtin_amdgcn_ds_read_tr16_b64_v4i16((LAS s16x4*)p)); }
__device__ __forceinline__ bf16x8 cat8(const s16x4 lo, const s16x4 hi) { return __builtin_shufflevector(lo, hi, 0, 1, 2, 3, 4, 5, 6, 7); }
#define MFMA16(a, b, c) __builtin_amdgcn_mfma_f32_16x16x32_bf16((a), (b), (c), 0, 0, 0)
constexpr int VSTR = 288;
constexpr int DSTR = 528;

struct AttUnit { int g, h, d, n, gh, spk0; size_t tok0; };
__device__ __forceinline__ AttUnit att_unit(int u) {
    AttUnit a; a.g = u >> 9; const int rem = u & 511; a.h = rem & 3; const int idx = rem >> 2;
    const int dsh = 2 * a.g, nbs = 4 - dsh; a.d = 1 << dsh;
    const int sb = idx >> nbs; a.n = idx & ((1 << nbs) - 1);
    const int bb = sb >> dsh, r = sb & (a.d - 1); a.gh = a.g * 4 + a.h;
    a.tok0 = (size_t)bb * SEQ + r;
    a.spk0 = (a.n - 1) * 128;
    return a;
}
__device__ __forceinline__ void att_mfma(const Ctx& C, bool bg = false) {
    const GAS float* bgsrc = (const GAS float*)inptr(C, 18); GAS unsigned char* bgdst = (GAS unsigned char*)(C.ws + WS_V); BgRow bgr;
    const GAS unsigned char* P = (const GAS unsigned char*)(C.ws + WS_PQKV); GAS bf16_t* OG = (GAS bf16_t*)(C.ws + WS_OG); GAS float* LSE = (GAS float*)(C.ws + WS_LSE); const GAS float* rel = (const GAS float*)inptr(C, 1);
    LAS unsigned char* vt = C.lds; LAS float* bias = (LAS float*)(C.lds + 256 * VSTR);
    constexpr int KOFF = 74752;
    const int lane = C.lane, wave = C.wave, g4 = lane >> 4, r16 = lane & 15;
    const int chunk = C.tid & 15, row0 = C.tid >> 4;
#define ATT_KDMA(A) do { _Pragma("unroll") for (int j = 0; j < 4; ++j) { const int row = 32 * wave + 8 * j + (lane >> 3), ksp = max((A).spk0 + row, 0), cc = (lane & 7) ^ ((row >> 1) & 7); \
        __builtin_amdgcn_global_load_lds((const GAS unsigned*)(P + ((A).tok0 + (size_t)ksp * (A).d) * 4608 + 1536 + (A).gh * 128 + cc * 16), (LAS unsigned*)(C.lds + KOFF + (32 * wave + 8 * j) * 128), 16, 0, 0); } } while (0)
    u32x2 vv[8]; float bv = 0.f; long qn[4];
#define ATT_PREFETCH(A) do { \
        _Pragma("unroll") for (int i = 0; i < 8; ++i) { const int ksp = (A).spk0 + row0 + 32 * i; vv[i] = *(const GAS u32x2*)(P + ((A).tok0 + (size_t)max(ksp, 0) * (A).d) * 4608 + 3072 + (A).gh * 128 + chunk * 8); } \
        bv = (C.tid < 129) ? rel[(int)kBucket[(A).g * 129 + C.tid] * 12 + (A).gh] : 0.f; \
        { const size_t tq_ = (A).tok0 + (size_t)((A).n * 128 + 16 * wave + r16) * (A).d; \
          _Pragma("unroll") for (int ks = 0; ks < 4; ++ks) qn[ks] = *(const GAS long*)(P + tq_ * 4608 + (A).gh * 128 + 32 * ks + 8 * g4); } } while (0)
    int u = C.bx;
    AttUnit cur = att_unit(u < 1536 ? u : 0);
    if (u < 1536) { __syncthreads(); ATT_KDMA(cur); ATT_PREFETCH(cur); }
    for (; u < 1536; u += C.G) {
        const int g = cur.g, h = cur.h, d = cur.d, n = cur.n, gh = cur.gh, spk0 = cur.spk0; const size_t tok0 = cur.tok0;
        VM_WAIT();
        __syncthreads();
#pragma unroll
        for (int i = 0; i < 8; ++i) { const int ki = row0 + 32 * i; u32x2 v8 = vv[i]; if (spk0 + ki < 0) v8 = (u32x2){0u, 0u};
            const f32x2 a = __builtin_amdgcn_cvt_pk_f32_fp8((int)v8.x, false), b2 = __builtin_amdgcn_cvt_pk_f32_fp8((int)v8.x, true), c2 = __builtin_amdgcn_cvt_pk_f32_fp8((int)v8.y, false), d2 = __builtin_amdgcn_cvt_pk_f32_fp8((int)v8.y, true);
            u32x4 v; v.x = pk2(a.x, a.y); v.y = pk2(b2.x, b2.y); v.z = pk2(c2.x, c2.y); v.w = pk2(d2.x, d2.y);
            *(LAS u32x4*)(vt + ki * VSTR + chunk * 16) = v; }
        if (C.tid < 129) bias[C.tid] = bv;
        long qf[4];
#pragma unroll
        for (int ks = 0; ks < 4; ++ks) qf[ks] = qn[ks];
        __syncthreads();
        const int un = u + C.G;
        if (un < 1536) { cur = att_unit(un); ATT_PREFETCH(cur); }
        const int bgrow = (u / C.G) * (C.G * NWAVES) + C.bx * NWAVES + wave;
        __builtin_amdgcn_sched_barrier(0);
        const int qi = 16 * wave + r16; const size_t tq = tok0 + (size_t)(n * 128 + qi) * d;
        const int ki0 = min(16 * wave, 96);
        f32x4 st[10];
        {
            const LAS unsigned char* kb = C.lds + KOFF + (ki0 + r16) * 128 + (g4 & 1) * 8; const int sw = (r16 >> 1) & 7;
#pragma unroll
            for (int kt = 0; kt < 10; ++kt) { f32x4 acc = {0.f, 0.f, 0.f, 0.f};
#pragma unroll
                for (int ks = 0; ks < 4; ++ks) acc = __builtin_amdgcn_mfma_f32_16x16x32_fp8_fp8(*(const LAS long*)(kb + kt * 2048 + (((2 * ks + (g4 >> 1)) ^ sw) * 16)), qf[ks], acc, 0, 0, 0);
                st[kt] = acc; }
        }
        __syncthreads();
        if (un < 1536) ATT_KDMA(cur);
        if (bg) bg_load(bgr, bgsrc + (size_t)bgrow * D, lane);
        __builtin_amdgcn_sched_barrier(0);
        float mx = -1e30f;
#pragma unroll
        for (int kt = 0; kt < 10; ++kt)
#pragma unroll
            for (int i = 0; i < 4; ++i) { const int ki = ki0 + 16 * kt + 4 * g4 + i, off = 128 + qi - ki; const bool ok = (off >= 0) && (off <= 128) && (spk0 + ki >= 0);
                float v = st[kt][i] * 0.08838834764831845f + bias[ok ? off : 0]; v = ok ? v : -1e30f; st[kt][i] = v; mx = fmaxf(mx, v); }
        mx = fmaxf(mx, __shfl_xor(mx, 16)); mx = fmaxf(mx, __shfl_xor(mx, 32));
        float sum = 0.f;
#pragma unroll
        for (int kt = 0; kt < 10; ++kt)
#pragma unroll
            for (int i = 0; i < 4; ++i) { const float ee = (st[kt][i] > -1e29f) ? __expf(st[kt][i] - mx) : 0.f; st[kt][i] = ee; sum += ee; }
        sum += __shfl_xor(sum, 16); sum += __shfl_xor(sum, 32);
        f32x4 o[8];
#pragma unroll
        for (int mt = 0; mt < 8; ++mt) o[mt] = (f32x4){0.f, 0.f, 0.f, 0.f};
#pragma unroll
        for (int s = 0; s < 5; ++s) {
            u32x4 pw; pw.x = pk2(st[2 * s][0], st[2 * s][1]); pw.y = pk2(st[2 * s][2], st[2 * s][3]); pw.z = pk2(st[2 * s + 1][0], st[2 * s + 1][1]); pw.w = pk2(st[2 * s + 1][2], st[2 * s + 1][3]);
            const bf16x8 pf = __builtin_bit_cast(bf16x8, pw);
            const LAS unsigned char* a0 = vt + (ki0 + 32 * s + 4 * g4 + (r16 >> 2)) * VSTR + (4 * (r16 & 3)) * 2;
#pragma unroll
            for (int mt = 0; mt < 8; ++mt) { const s16x4 lo = tr_read(a0 + 32 * mt), hi = tr_read(a0 + 32 * mt + 16 * VSTR); o[mt] = MFMA16(cat8(lo, hi), pf, o[mt]); }
        }
        const float inv = 1.0f / sum;
        GAS bf16_t* op = OG + ((size_t)g * T + tq) * 512 + h * 128 + 4 * g4;
#pragma unroll
        for (int mt = 0; mt < 8; ++mt) { u32x2 w; w.x = pk2(o[mt][0] * inv, o[mt][1] * inv); w.y = pk2(o[mt][2] * inv, o[mt][3] * inv); *(GAS u32x2*)(op + 16 * mt) = w; }
        if (g4 == 0) LSE[((size_t)g * T + tq) * 4 + h] = mx + __logf(sum);
        if (bg) bg_store<false>(bgr, nullptr, bgdst + (size_t)bgrow * (D / 2), lane);
    }
#undef ATT_PREFETCH
#undef ATT_KDMA
}
__device__ __forceinline__ void mixa_mfma(const Ctx& C, int l, bool bg = false) {
    const GAS float* bgsrc = (const GAS float*)inptr(C, 17); const GAS float* bggain = (const GAS float*)inptr(C, 13); GAS unsigned char* bgdst = (GAS unsigned char*)(C.ws + WS_U); BgRow bgr;
    const GAS bf16_t* PA = (const GAS bf16_t*)(C.ws + WS_PA); const GAS float* VS = (const GAS float*)(C.ws + WS_RSTD + 131072); const GAS bf16_t* WM = (const GAS bf16_t*)(C.ws + WS_WM);
    GAS bf16_t* YA = (GAS bf16_t*)(C.ws + WS_YA); const GAS float* ang = (const GAS float*)(inptr(C, 4) + (size_t)l * 1024); const GAS float* bs = (const GAS float*)(inptr(C, 6) + (size_t)l * 1024);
    LAS unsigned char* vt = C.lds;
    const int lane = C.lane, wave = C.wave, g4 = lane >> 4, r16 = lane & 15;
    for (int u = C.bx; u < 1024; u += C.G) {
        const int h = u & 7; const size_t c0 = (size_t)(u >> 3) * 128;
        __syncthreads();
        {   const int chunk = C.tid & 15, row0 = C.tid >> 4;
            const f32x4 ga = *(const GAS f32x4*)(ang + h * 128 + chunk * 8), gb = *(const GAS f32x4*)(ang + h * 128 + chunk * 8 + 4);
#pragma unroll
            for (int i = 0; i < 4; ++i) { const int row = row0 + 32 * i; const u32x4 v = *(const GAS u32x4*)(PA + (c0 + row) * 2048 + 1024 + h * 128 + chunk * 8); const float rs = VS[c0 + row];
                u32x4 w; w.x = pk2(bflo(v.x) * rs * ga[0], bfhi(v.x) * rs * ga[1]); w.y = pk2(bflo(v.y) * rs * ga[2], bfhi(v.y) * rs * ga[3]);
                w.z = pk2(bflo(v.z) * rs * gb[0], bfhi(v.z) * rs * gb[1]); w.w = pk2(bflo(v.w) * rs * gb[2], bfhi(v.w) * rs * gb[3]);
                *(LAS u32x4*)(vt + row * VSTR + chunk * 16) = w; }
        }
        __syncthreads();
        const int bgrow = (u / C.G) * (C.G * NWAVES) + C.bx * NWAVES + wave;
        if (bg) bg_load(bgr, bgsrc + (size_t)bgrow * D, lane);
        const int t = 16 * wave + r16;
        f32x4 acc[8];
#pragma unroll
        for (int mt = 0; mt < 8; ++mt) acc[mt] = (f32x4){0.f, 0.f, 0.f, 0.f};
        const int nks = (wave >> 1) + 1;
        const size_t token = c0 + t;
        bf16x8 wf[4]; u32x2 uu[8];
#pragma unroll
        for (int ks = 0; ks < 4; ++ks) wf[ks] = *(const GAS bf16x8*)(WM + ((size_t)h * 128 + t) * 128 + 32 * ks + 8 * g4);
#pragma unroll
        for (int mt = 0; mt < 8; ++mt) uu[mt] = *(const GAS u32x2*)(PA + token * 2048 + h * 128 + 16 * mt + 4 * g4);
        const float bsv = bs[h * 128 + t];
        __builtin_amdgcn_sched_barrier(0);
#pragma unroll
        for (int ks = 0; ks < 4; ++ks) if (ks < nks) {
            const LAS unsigned char* a0 = vt + (32 * ks + 8 * g4 + (r16 >> 2)) * VSTR + (4 * (r16 & 3)) * 2;
#pragma unroll
            for (int mt = 0; mt < 8; ++mt) { const s16x4 lo = tr_read(a0 + 32 * mt), hi = tr_read(a0 + 32 * mt + 4 * VSTR); acc[mt] = MFMA16(cat8(lo, hi), wf[ks], acc[mt]); }
        }
#pragma unroll
        for (int mt = 0; mt < 8; ++mt) { const int dd = 16 * mt + 4 * g4;
            if (BR8) *(GAS unsigned*)((GAS unsigned char*)YA + token * 2560 + h * 128 + dd) = pk4_fp8(Y8S * bflo(uu[mt].x) * (acc[mt][0] + bsv), Y8S * bfhi(uu[mt].x) * (acc[mt][1] + bsv), Y8S * bflo(uu[mt].y) * (acc[mt][2] + bsv), Y8S * bfhi(uu[mt].y) * (acc[mt][3] + bsv));
            else { u32x2 w; w.x = pk2(bflo(uu[mt].x) * (acc[mt][0] + bsv), bfhi(uu[mt].x) * (acc[mt][1] + bsv)); w.y = pk2(bflo(uu[mt].y) * (acc[mt][2] + bsv), bfhi(uu[mt].y) * (acc[mt][3] + bsv));
            *(GAS u32x2*)(YA + token * 2560 + h * 128 + dd) = w; } }
        if (bg) bg_store<true>(bgr, bggain, bgdst + (size_t)bgrow * (D / 2), lane);
    }
}
__device__ __forceinline__ void mixb_mfma(const Ctx& C, bool bg = false) {
    const GAS float* bgsrc = (const GAS float*)inptr(C, 18); GAS unsigned char* bgdst = (GAS unsigned char*)(C.ws + WS_V); BgRow bgr;
    const GAS bf16_t* PB = (const GAS bf16_t*)(C.ws + WS_PB); const GAS bf16_t* WP = (const GAS bf16_t*)(C.ws + WS_WP); GAS bf16_t* YB = (GAS bf16_t*)(C.ws + WS_YA);
    LAS unsigned char* dt = C.lds;
    const int lane = C.lane, wave = C.wave, g4 = lane >> 4, r16 = lane & 15;
    for (int u = C.bx; u < 512; u += C.G) {
        const int gb = u & 3, t0 = (u >> 2) * 128, w = 2 << gb;
        __syncthreads();
        {
            const int cp = C.tid & 127, seg = C.tid >> 7, rbeg = 32 * seg, tl0 = (t0 & (SEQ - 1)) + rbeg;
            const GAS bf16_t* pc = PB + (size_t)(t0 + rbeg) * 1024 + gb * 256 + 2 * cp;
            unsigned pv[48];
#pragma unroll
            for (int j = 1; j <= 16; ++j) pv[16 - j] = (tl0 - j >= 0) ? *(const GAS unsigned*)(pc - (size_t)j * 1024) : 0u;
#pragma unroll
            for (int rr = 0; rr < 32; ++rr) pv[16 + rr] = *(const GAS unsigned*)(pc + (size_t)rr * 1024);
            __builtin_amdgcn_sched_barrier(0);
#define MIXB_WINDOW(W) do { float s0 = 0.f, s1 = 0.f; \
                _Pragma("unroll") for (int j = 1; j <= (W); ++j) { s0 += bflo(pv[16 - j]); s1 += bfhi(pv[16 - j]); } \
                _Pragma("unroll") for (int rr = 0; rr < 32; ++rr) { const int tl = tl0 + rr; const unsigned cur = pv[16 + rr], old = pv[16 + rr - (W)]; \
                    s0 += bflo(cur) - bflo(old); s1 += bfhi(cur) - bfhi(old); \
                    const float inv = 1.0f / (float)min((W), tl + 1); \
                    *(LAS unsigned*)(dt + (rbeg + rr) * DSTR + cp * 4) = pk2(s0 * inv - bflo(cur), s1 * inv - bfhi(cur)); } } while (0)
            if (gb == 0) MIXB_WINDOW(2); else if (gb == 1) MIXB_WINDOW(4); else if (gb == 2) MIXB_WINDOW(8); else MIXB_WINDOW(16);
#undef MIXB_WINDOW
        }
        __syncthreads();
        const int bgrow = 12288 + (u / C.G) * (C.G * NWAVES) + C.bx * NWAVES + wave;
        if (bg) bg_load(bgr, bgsrc + (size_t)bgrow * D, lane);
        f32x4 acc[2][8];
#pragma unroll
        for (int mt = 0; mt < 2; ++mt)
#pragma unroll
            for (int nt = 0; nt < 8; ++nt) acc[mt][nt] = (f32x4){0.f, 0.f, 0.f, 0.f};
        bf16x8 af[8][2];
#pragma unroll
        for (int ks = 0; ks < 8; ++ks) { af[ks][0] = *(const GAS bf16x8*)(WP + ((size_t)gb * 256 + 32 * wave + r16) * 256 + 32 * ks + 8 * g4); af[ks][1] = *(const GAS bf16x8*)(WP + ((size_t)gb * 256 + 32 * wave + 16 + r16) * 256 + 32 * ks + 8 * g4); }
        __builtin_amdgcn_sched_barrier(0);
#pragma unroll
        for (int ks = 0; ks < 8; ++ks) {
#pragma unroll
            for (int nt = 0; nt < 8; ++nt) { const bf16x8 bfr = *(const LAS bf16x8*)(dt + (16 * nt + r16) * DSTR + (32 * ks + 8 * g4) * 2); acc[0][nt] = MFMA16(af[ks][0], bfr, acc[0][nt]); acc[1][nt] = MFMA16(af[ks][1], bfr, acc[1][nt]); }
        }
#pragma unroll
        for (int mt = 0; mt < 2; ++mt)
#pragma unroll
            for (int nt = 0; nt < 8; ++nt) {
                if (BR8) *(GAS unsigned*)((GAS unsigned char*)YB + (size_t)(t0 + 16 * nt + r16) * 2560 + 1024 + gb * 256 + 32 * wave + 16 * mt + 4 * g4) = pk4_fp8(Y8S * acc[mt][nt][0], Y8S * acc[mt][nt][1], Y8S * acc[mt][nt][2], Y8S * acc[mt][nt][3]);
                else { u32x2 wv; wv.x = pk2s(acc[mt][nt][0], acc[mt][nt][1]); wv.y = pk2s(acc[mt][nt][2], acc[mt][nt][3]);
                *(GAS u32x2*)(YB + (size_t)(t0 + 16 * nt + r16) * 2560 + 1024 + gb * 256 + 32 * wave + 16 * mt + 4 * g4) = wv; } }
        if (bg) bg_store<false>(bgr, nullptr, bgdst + (size_t)bgrow * (D / 2), lane);
    }
}

template <int CTRL> __device__ __forceinline__ unsigned dpp_u(unsigned v) { return (unsigned)__builtin_amdgcn_update_dpp(0, (int)v, CTRL, 0xF, 0xF, false); }
template <int CTRL> __device__ __forceinline__ float dpp_f(float v) { return __int_as_float(__builtin_amdgcn_update_dpp(0, __float_as_int(v), CTRL, 0xF, 0xF, false)); }
__device__ __forceinline__ unsigned row_max_u32(unsigned v) { v = max(v, dpp_u<0xB1>(v)); v = max(v, dpp_u<0x4E>(v)); v = max(v, dpp_u<0x141>(v)); v = max(v, dpp_u<0x140>(v)); return v; }
__device__ __forceinline__ float row_max_f32(float v) { v = fmaxf(v, dpp_f<0xB1>(v)); v = fmaxf(v, dpp_f<0x4E>(v)); v = fmaxf(v, dpp_f<0x141>(v)); v = fmaxf(v, dpp_f<0x140>(v)); return v; }
__device__ __forceinline__ float row_sum_f32(float v) { v += dpp_f<0xB1>(v); v += dpp_f<0x4E>(v); v += dpp_f<0x141>(v); v += dpp_f<0x140>(v); return v; }
__device__ __forceinline__ unsigned mono_key(float v) { const unsigned u = __float_as_uint(v); return u ^ ((unsigned)((int)u >> 31) | 0x80000000u); }
__device__ __forceinline__ unsigned row_top16(unsigned (&k)[8], int r) {
#define CE_(i, j) do { const unsigned hi_ = max(k[i], k[j]), lo_ = min(k[i], k[j]); k[i] = hi_; k[j] = lo_; } while (0)
    CE_(0, 1); CE_(2, 3); CE_(4, 5); CE_(6, 7);
    CE_(0, 2); CE_(1, 3); CE_(4, 6); CE_(5, 7);
    CE_(1, 2); CE_(5, 6);
    CE_(0, 4); CE_(1, 5); CE_(2, 6); CE_(3, 7);
    CE_(2, 4); CE_(3, 5);
    CE_(1, 2); CE_(3, 4); CE_(5, 6);
#undef CE_
    unsigned sel = 0u;
#pragma unroll
    for (int t = 0; t < 16; ++t) {
        const unsigned m = row_max_u32(k[0]);
        const bool win = (k[0] == m);
#pragma unroll
        for (int i = 0; i < 7; ++i) k[i] = win ? k[i + 1] : k[i];
        k[7] = win ? 0u : k[7];
        sel = (r == t) ? m : sel;
    }
    return sel;
}
__device__ __forceinline__ float unmono_key(unsigned k) { return __uint_as_float((k & 0x80000000u) ? (k ^ 0x80000000u) : ~k); }
__device__ __forceinline__ void peer_topk_dpp(const Ctx& C, int lbg = -1) {
    const GAS bf16_t* SC = (const GAS bf16_t*)(C.ws + WS_PQKV); GAS int* EXG = (GAS int*)(C.ws + WS_EXG); GAS float* CVG = (GAS float*)(C.ws + WS_CVG);
    const int lane = C.lane, r = lane & 15, rho = lane >> 4;
    const bool bg = BG_TABLES && lbg >= 0;
    const GAS float* tu = nullptr; const GAS float* tv = nullptr; GAS unsigned char* du = nullptr; GAS unsigned char* dv = nullptr; f32x4 gq[8], bx_[8]; int R = C.bx * NWAVES + C.wave;
    if (bg) { tu = (const GAS float*)(inptr(C, 17) + (size_t)lbg * NEXP * D); tv = (const GAS float*)(inptr(C, 18) + (size_t)lbg * NEXP * D);
        du = (GAS unsigned char*)(C.ws + WS_U + (size_t)lbg * NEXP * (D / 2)); dv = (GAS unsigned char*)(C.ws + WS_V + (size_t)lbg * NEXP * (D / 2));
        const GAS float* gf = (const GAS float*)(inptr(C, 13) + (size_t)lbg * D) + 32 * lane;
#pragma unroll
        for (int q = 0; q < 8; ++q) gq[q] = *(const GAS f32x4*)(gf + 4 * q) * SCALE_U4; }
#define BG_LOAD() do { if (bg && R < 2 * NEXP) { const GAS float* s_ = (R < NEXP ? tu + (size_t)R * D : tv + (size_t)(R - NEXP) * D) + 32 * lane; \
        _Pragma("unroll") for (int q = 0; q < 8; ++q) bx_[q] = *(const GAS f32x4*)(s_ + 4 * q); } } while (0)
#define BG_STORE() do { if (bg && R < 2 * NEXP) { const bool isu_ = R < NEXP; u32x4 w_; \
        _Pragma("unroll") for (int q = 0; q < 4; ++q) { unsigned pk = 0u; f32x4 a = bx_[2 * q], b2 = bx_[2 * q + 1]; \
            if (isu_) { a = a * gq[2 * q]; b2 = b2 * gq[2 * q + 1]; } else { a = a * SCALE_V4; b2 = b2 * SCALE_V4; } \
            pk = __builtin_amdgcn_cvt_scalef32_pk_fp4_f32(pk, a[0], a[1], 1.0f, 0); pk = __builtin_amdgcn_cvt_scalef32_pk_fp4_f32(pk, a[2], a[3], 1.0f, 1); \
            pk = __builtin_amdgcn_cvt_scalef32_pk_fp4_f32(pk, b2[0], b2[1], 1.0f, 2); pk = __builtin_amdgcn_cvt_scalef32_pk_fp4_f32(pk, b2[2], b2[3], 1.0f, 3); w_[q] = pk; } \
        *(GAS u32x4*)((isu_ ? du + (size_t)R * (D / 2) : dv + (size_t)(R - NEXP) * (D / 2)) + 16 * lane) = w_; } R += C.G * NWAVES; } while (0)
    LAS float* selv = (LAS float*)(C.lds + C.wave * 512); LAS int* sele = (LAS int*)(C.lds + C.wave * 512 + 256);
    const int cnt = (r == 0) ? 16 : (r == 1) ? 8 : (r == 2) ? 5 : (r == 3) ? 4 : (r == 4) ? 3 : (r < 8) ? 2 : 1;
    const int NGW = C.G * NWAVES;
    float nx1[8], nx2[8];
    { const int tl = C.wave >> 1, token = C.bx * NWAVES + (tl & 7) + (tl >> 3) * NGW, head = (C.wave & 1) * 4 + rho; const GAS bf16_t* sp = SC + (size_t)min(token, T - 1) * D + head * 256;
#pragma unroll
      for (int i = 0; i < 8; ++i) { nx1[i] = bf2f(sp[r + 16 * i]); nx2[i] = bf2f(sp[128 + r + 16 * i]); } }
    for (int q = C.wave; ; q += NWAVES) {
        const int tl = q >> 1, token = C.bx * NWAVES + (tl & 7) + (tl >> 3) * NGW;
        if (token >= T) break;
        BG_LOAD();
        const int head = (q & 1) * 4 + rho;
        unsigned k1[8], k2[8];
#pragma unroll
        for (int i = 0; i < 8; ++i) { k1[i] = (mono_key(nx1[i]) & ~127u) | (unsigned)(127 - (r + 16 * i)); k2[i] = (mono_key(nx2[i]) & ~127u) | (unsigned)(127 - (r + 16 * i)); }
        { const int qn = q + NWAVES, tln = qn >> 1, tokn = C.bx * NWAVES + (tln & 7) + (tln >> 3) * NGW, headn = (qn & 1) * 4 + rho; const GAS bf16_t* spn = SC + (size_t)min(tokn, T - 1) * D + headn * 256;
#pragma unroll
          for (int i = 0; i < 8; ++i) { nx1[i] = bf2f(spn[r + 16 * i]); nx2[i] = bf2f(spn[128 + r + 16 * i]); } }
        const unsigned s1 = row_top16(k1, r), s2 = row_top16(k2, r);
        const int idx1 = 127 - (int)(s1 & 127u), idx2 = 127 - (int)(s2 & 127u);
        const float v1 = unmono_key(s1 & ~127u), v2 = unmono_key(s2 & ~127u);
        int p = 0;
        float v2p = __int_as_float(__builtin_amdgcn_ds_bpermute((lane & 48) * 4, __float_as_int(v2)));
        int i2p = __builtin_amdgcn_ds_bpermute((lane & 48) * 4, idx2);
#pragma unroll
        for (int t = 0; t < 16; ++t) {
            const float c = v1 + v2p;
            unsigned ck = (mono_key(c) & ~15u) | (unsigned)(15 - r); ck = (p < cnt) ? ck : 0u;
            const unsigned m = row_max_u32(ck);
            const bool win = (ck == m);
            if (win) { selv[rho * 16 + t] = c; sele[rho * 16 + t] = idx1 * 128 + i2p; }
            p += win ? 1 : 0;
            const int a = ((lane & 48) + min(p, 15)) * 4;
            v2p = __int_as_float(__builtin_amdgcn_ds_bpermute(a, __float_as_int(v2))); i2p = __builtin_amdgcn_ds_bpermute(a, idx2);
        }
        LDS_WAIT();
        const float cv = selv[lane]; const int ev = sele[lane];
        EXG[(size_t)token * 128 + head * 16 + r] = ev; CVG[(size_t)token * 128 + head * 16 + r] = cv;
        LDS_WAIT();
        BG_STORE();
    }
    while (bg && R < 2 * NEXP) { BG_LOAD(); BG_STORE(); }
#undef BG_LOAD
#undef BG_STORE
}
__device__ __forceinline__ float transpose_reduce16(const float (&s)[16], int lane) {
    const bool b3 = lane & 8, b2 = lane & 4, b1 = lane & 2, b0 = lane & 1;
    float a[8], b[4], c[2];
#pragma unroll
    for (int q = 0; q < 8; ++q) { const float keep = b3 ? s[q + 8] : s[q], send = b3 ? s[q] : s[q + 8]; a[q] = keep + dpp_f<0x128>(send); }
#pragma unroll
    for (int q = 0; q < 4; ++q) { const float keep = b2 ? a[q + 4] : a[q], send = b2 ? a[q] : a[q + 4]; b[q] = keep + dpp_f<0x141>(send); }
#pragma unroll
    for (int q = 0; q < 2; ++q) { const float keep = b1 ? b[q + 2] : b[q], send = b1 ? b[q] : b[q + 2]; c[q] = keep + dpp_f<0x4E>(send); }
    const float keep = b0 ? c[1] : c[0], send = b0 ? c[0] : c[1];
    float rsum = keep + dpp_f<0xB1>(send);
    rsum += __shfl_xor(rsum, 16); rsum += __shfl_xor(rsum, 32);
    return rsum;
}
__device__ __forceinline__ void peer_gather(const Ctx& C, int l, bool last, bool dry = false) {
    const unsigned char* U8 = C.ws + WS_U + (size_t)l * NEXP * D; const unsigned char* V8 = C.ws + WS_V + (size_t)l * NEXP * D;
    const int* EXG = (const int*)(C.ws + WS_EXG); const float* CVG = (const float*)(C.ws + WS_CVG);
    bf16_t* XB = (bf16_t*)(C.ws + WS_XB); float* RS = (float*)(C.ws + WS_RSTD);
    const int lane = C.lane;
    LAS float* hl = (LAS float*)(C.lds + 8192 + C.wave * 1024); LAS int* el = (LAS int*)(C.lds + 8192 + C.wave * 1024 + 512);
    const int gw = C.bx * NWAVES + C.wave, NGW = C.G * NWAVES;
    for (int token = gw; token < T; token += NGW) {
        f32x4 xq[8]; float ss = 0.f;
        const float* xrow = C.out + (size_t)token * D;
#pragma unroll
        for (int i = 0; i < 2; ++i)
#pragma unroll
            for (int q = 0; q < 4; ++q) { const f32x4 v = *(const f32x4*)(xrow + i * 1024 + lane * 16 + q * 4); xq[i * 4 + q] = v; ss += (v[0] * v[0] + v[1] * v[1]) + (v[2] * v[2] + v[3] * v[3]); }
        const float rstd = rsqrtf(wave_sum(ss) * (1.0f / D) + EPS);
        {
            const int e0 = EXG[(size_t)token * 128 + lane], e1 = EXG[(size_t)token * 128 + 64 + lane];
            const float z0 = CVG[(size_t)token * 128 + lane] * rstd, z1 = CVG[(size_t)token * 128 + 64 + lane] * rstd;
            const float p0 = __expf(z0 - row_max_f32(z0)), p1 = __expf(z1 - row_max_f32(z1));
            const float g0 = p0 / row_sum_f32(p0), g1 = p1 / row_sum_f32(p1);
            el[lane] = e0; el[64 + lane] = e1; hl[lane] = g0; hl[64 + lane] = g1;
        }
        LDS_WAIT();
        for (int b = 0; b < 8; ++b) {
            float s[16];
#pragma unroll
            for (int sb = 0; sb < 2; ++sb) {
                u32x4 ld[16];
#pragma unroll
                for (int j = 0; j < 8; ++j) { const int e = __builtin_amdgcn_readfirstlane(el[b * 16 + sb * 8 + j]); const unsigned char* rowp = U8 + (size_t)e * D + lane * 16;
                    ld[j * 2] = *(const u32x4*)rowp; ld[j * 2 + 1] = *(const u32x4*)(rowp + 1024); }
#pragma unroll
                for (int j = 0; j < 8; ++j) { f32x2 acc = {0.f, 0.f};
#pragma unroll
                    for (int i = 0; i < 2; ++i)
#pragma unroll
                        for (int q = 0; q < 4; ++q) { const int w = (int)ld[j * 2 + i][q]; const f32x4 xv = xq[i * 4 + q];
                            acc = __builtin_amdgcn_cvt_pk_f32_fp8(w, false) * (f32x2){xv[0], xv[1]} + acc; acc = __builtin_amdgcn_cvt_pk_f32_fp8(w, true) * (f32x2){xv[2], xv[3]} + acc; }
                    s[sb * 8 + j] = acc.x + acc.y; }
            }
            const float tot = transpose_reduce16(s, lane);
            const float a = tot * rstd * (1.0f / 1024.0f);
            const float h = gelu_erf(a) * hl[b * 16 + (lane & 15)] * (1.0f / 64.0f);
            LDS_WAIT();
            if (lane < 16) hl[b * 16 + lane] = h;
        }
        LDS_WAIT();
        f32x2 ya[16];
#pragma unroll
        for (int i = 0; i < 16; ++i) ya[i] = (f32x2){0.f, 0.f};
        for (int kb = 0; kb < 16; ++kb) {
            u32x4 ld[16];
#pragma unroll
            for (int j = 0; j < 8; ++j) { const int e = __builtin_amdgcn_readfirstlane(el[kb * 8 + j]); const unsigned char* rowp = V8 + (size_t)e * D + lane * 16;
                ld[j * 2] = *(const u32x4*)rowp; ld[j * 2 + 1] = *(const u32x4*)(rowp + 1024); }
#pragma unroll
            for (int j = 0; j < 8; ++j) { const float hk = hl[kb * 8 + j]; const f32x2 hh = {hk, hk};
#pragma unroll
                for (int i = 0; i < 2; ++i)
#pragma unroll
                    for (int q = 0; q < 4; ++q) { const int w = (int)ld[j * 2 + i][q];
                        ya[(i * 4 + q) * 2] = __builtin_amdgcn_cvt_pk_f32_fp8(w, false) * hh + ya[(i * 4 + q) * 2]; ya[(i * 4 + q) * 2 + 1] = __builtin_amdgcn_cvt_pk_f32_fp8(w, true) * hh + ya[(i * 4 + q) * 2 + 1]; } }
        }
        float s2 = 0.f;
#pragma unroll
        for (int i = 0; i < 8; ++i) { xq[i][0] += ya[i * 2].x; xq[i][1] += ya[i * 2].y; xq[i][2] += ya[i * 2 + 1].x; xq[i][3] += ya[i * 2 + 1].y;
            s2 += (xq[i][0] * xq[i][0] + xq[i][1] * xq[i][1]) + (xq[i][2] * xq[i][2] + xq[i][3] * xq[i][3]); }
        const float rstd2 = rsqrtf(wave_sum(s2) * (1.0f / D) + EPS);
        float* orow = C.out + (size_t)token * D;
        if (dry) { if (rstd2 == 12345.678f) RS[token] = rstd2; }
        else if (last) { const float* fg = inptr(C, 19);
#pragma unroll
            for (int i = 0; i < 2; ++i)
#pragma unroll
                for (int q = 0; q < 4; ++q) { const int d = i * 1024 + lane * 16 + q * 4; const f32x4 g = *(const f32x4*)(fg + d); f32x4 o = xq[i * 4 + q] * rstd2; o = o * g; *(f32x4*)(orow + d) = o; } }
        else {
#pragma unroll
            for (int i = 0; i < 2; ++i)
#pragma unroll
                for (int q = 0; q < 4; ++q) { const int d = i * 1024 + lane * 16 + q * 4; const f32x4 v = xq[i * 4 + q]; *(f32x4*)(orow + d) = v;
                    u32x2 w; w.x = pk2(v[0], v[1]); w.y = pk2(v[2], v[3]); *(u32x2*)(XB + (size_t)token * D + d) = w; }
            if (lane == 0) RS[token] = rstd2; }
        LDS_WAIT();
    }
}


template <int CTRL> __device__ __forceinline__ float xsel_add(bool sel, float lo, float hi) { const float keep = sel ? hi : lo, send = sel ? lo : hi; return keep + dpp_f<CTRL>(send); }
__device__ __forceinline__ float treduce8(const float (&v)[8], int lane) {
    const bool b2 = lane & 4, b1 = lane & 2, b0 = lane & 1;
    float a[4], c[2];
#pragma unroll
    for (int q = 0; q < 4; ++q) a[q] = xsel_add<0x141>(b2, v[q], v[q + 4]);
#pragma unroll
    for (int q = 0; q < 2; ++q) c[q] = xsel_add<0x4E>(b1, a[q], a[q + 2]);
    return xsel_add<0xB1>(b0, c[0], c[1]);
}
__device__ __forceinline__ float xsel_add_shfl(bool sel, float lo, float hi, int m) { const float keep = sel ? hi : lo, send = sel ? lo : hi; return keep + __shfl_xor(send, m); }
__device__ __forceinline__ void peer_sweep(const Ctx& C, int l, bool last, bool dry = false) {
    #if PEER_FP4
    const GAS unsigned char* U8 = (const GAS unsigned char*)(C.ws + WS_U + (size_t)l * NEXP * (D / 2)); const GAS unsigned char* V8 = (const GAS unsigned char*)(C.ws + WS_V + (size_t)l * NEXP * (D / 2));
    typedef u32x2 ldv_t; constexpr int PIECE = 64, ROWSH = 10; constexpr float INV_SU = 1.0f / SCALE_U4, INV_SV = 1.0f / SCALE_V4;
#define PEER_CVT(w, k) __builtin_amdgcn_cvt_scalef32_pk_f32_fp4((w), 1.0f, (k))
#define PEER_DOT(LDV, XV, a2) do { \
        a2 = PEER_CVT(LDV.x, 0) * (f32x2){XV[0][0], XV[0][1]} + a2; a2 = PEER_CVT(LDV.x, 1) * (f32x2){XV[0][2], XV[0][3]} + a2; a2 = PEER_CVT(LDV.x, 2) * (f32x2){XV[1][0], XV[1][1]} + a2; a2 = PEER_CVT(LDV.x, 3) * (f32x2){XV[1][2], XV[1][3]} + a2; \
        a2 = PEER_CVT(LDV.y, 0) * (f32x2){XV[2][0], XV[2][1]} + a2; a2 = PEER_CVT(LDV.y, 1) * (f32x2){XV[2][2], XV[2][3]} + a2; a2 = PEER_CVT(LDV.y, 2) * (f32x2){XV[3][0], XV[3][1]} + a2; a2 = PEER_CVT(LDV.y, 3) * (f32x2){XV[3][2], XV[3][3]} + a2; } while (0)
#define PEER_AXPY(LDV, hh, ya) do { \
        ya[0] = PEER_CVT(LDV.x, 0) * hh + ya[0]; ya[1] = PEER_CVT(LDV.x, 1) * hh + ya[1]; ya[2] = PEER_CVT(LDV.x, 2) * hh + ya[2]; ya[3] = PEER_CVT(LDV.x, 3) * hh + ya[3]; \
        ya[4] = PEER_CVT(LDV.y, 0) * hh + ya[4]; ya[5] = PEER_CVT(LDV.y, 1) * hh + ya[5]; ya[6] = PEER_CVT(LDV.y, 2) * hh + ya[6]; ya[7] = PEER_CVT(LDV.y, 3) * hh + ya[7]; } while (0)
#else
    const GAS unsigned char* U8 = (const GAS unsigned char*)(C.ws + WS_U + (size_t)l * NEXP * D); const GAS unsigned char* V8 = (const GAS unsigned char*)(C.ws + WS_V + (size_t)l * NEXP * D);
    typedef u32x4 ldv_t; constexpr int PIECE = 128, ROWSH = 11; constexpr float INV_SU = 1.0f / 1024.0f, INV_SV = 1.0f / 64.0f;
#define PEER_DOT(LDV, XV, a2) do { \
        a2 = __builtin_amdgcn_cvt_pk_f32_fp8((int)LDV.x, false) * (f32x2){XV[0][0], XV[0][1]} + a2; a2 = __builtin_amdgcn_cvt_pk_f32_fp8((int)LDV.x, true) * (f32x2){XV[0][2], XV[0][3]} + a2; \
        a2 = __builtin_amdgcn_cvt_pk_f32_fp8((int)LDV.y, false) * (f32x2){XV[1][0], XV[1][1]} + a2; a2 = __builtin_amdgcn_cvt_pk_f32_fp8((int)LDV.y, true) * (f32x2){XV[1][2], XV[1][3]} + a2; \
        a2 = __builtin_amdgcn_cvt_pk_f32_fp8((int)LDV.z, false) * (f32x2){XV[2][0], XV[2][1]} + a2; a2 = __builtin_amdgcn_cvt_pk_f32_fp8((int)LDV.z, true) * (f32x2){XV[2][2], XV[2][3]} + a2; \
        a2 = __builtin_amdgcn_cvt_pk_f32_fp8((int)LDV.w, false) * (f32x2){XV[3][0], XV[3][1]} + a2; a2 = __builtin_amdgcn_cvt_pk_f32_fp8((int)LDV.w, true) * (f32x2){XV[3][2], XV[3][3]} + a2; } while (0)
#define PEER_AXPY(LDV, hh, ya) do { \
        ya[0] = __builtin_amdgcn_cvt_pk_f32_fp8((int)LDV.x, false) * hh + ya[0]; ya[1] = __builtin_amdgcn_cvt_pk_f32_fp8((int)LDV.x, true) * hh + ya[1]; \
        ya[2] = __builtin_amdgcn_cvt_pk_f32_fp8((int)LDV.y, false) * hh + ya[2]; ya[3] = __builtin_amdgcn_cvt_pk_f32_fp8((int)LDV.y, true) * hh + ya[3]; \
        ya[4] = __builtin_amdgcn_cvt_pk_f32_fp8((int)LDV.z, false) * hh + ya[4]; ya[5] = __builtin_amdgcn_cvt_pk_f32_fp8((int)LDV.z, true) * hh + ya[5]; \
        ya[6] = __builtin_amdgcn_cvt_pk_f32_fp8((int)LDV.w, false) * hh + ya[6]; ya[7] = __builtin_amdgcn_cvt_pk_f32_fp8((int)LDV.w, true) * hh + ya[7]; } while (0)
#endif
    const GAS int* EXG = (const GAS int*)(C.ws + WS_EXG); const GAS float* CVG = (const GAS float*)(C.ws + WS_CVG);
    GAS bf16_t* XB = (GAS bf16_t*)(C.ws + WS_XB); GAS unsigned char* XB8 = (GAS unsigned char*)(C.ws + WS_XB8); GAS float* RS = (GAS float*)(C.ws + WS_RSTD); GAS float* OUT = (GAS float*)C.out;
    const int lane = C.lane, j8 = lane & 7, gidx = lane >> 3;
    LAS unsigned char* wl = C.lds + C.wave * 14464;
    LAS float* acc = (LAS float*)wl;
    LAS int* el = (LAS int*)(wl + 4096);
    LAS float* gl = (LAS float*)(wl + 8192);
    LAS float* ssl = (LAS float*)(wl + 12288);
    LAS float* rsl = (LAS float*)(wl + 14336);
    const int gw = C.bx * NWAVES + C.wave, NGW = C.G * NWAVES;
    for (int tbase = gw; tbase < T; tbase += 8 * NGW) {
        const int ntk = min(8, (T - tbase + NGW - 1) / NGW);
        for (int tk = 0; tk < ntk; ++tk) { const int token = tbase + tk * NGW; const GAS float* xrow = OUT + (size_t)token * D; float ss = 0.f;
#pragma unroll
            for (int q = 0; q < 8; ++q) { const f32x4 v = *(const GAS f32x4*)(xrow + q * 256 + lane * 4); ss += (v[0] * v[0] + v[1] * v[1]) + (v[2] * v[2] + v[3] * v[3]); }
            const float rstd = rsqrtf(wave_sum(ss) * (1.0f / D) + EPS);
            const int e0 = EXG[(size_t)token * 128 + lane], e1 = EXG[(size_t)token * 128 + 64 + lane];
            const float z0 = CVG[(size_t)token * 128 + lane] * rstd, z1 = CVG[(size_t)token * 128 + 64 + lane] * rstd;
            const float p0 = __expf(z0 - row_max_f32(z0)), p1 = __expf(z1 - row_max_f32(z1));
            el[tk * 128 + lane] = e0; el[tk * 128 + 64 + lane] = e1; gl[tk * 128 + lane] = p0 / row_sum_f32(p0); gl[tk * 128 + 64 + lane] = p1 / row_sum_f32(p1);
            acc[tk * 128 + lane] = 0.f; acc[tk * 128 + 64 + lane] = 0.f; ssl[tk * 64 + lane] = 0.f; if (lane == 0) rsl[tk] = rstd; }
        LDS_WAIT();
        {
            const int nit = 16 * ntk;
#define A_ISSUE(LD, XV, it) do { const int s_ = is_, tk_ = itk_; if ((it) < nit - 1) { if (++itk_ == ntk) { itk_ = 0; ++is_; } } \
                const GAS unsigned char* ub_ = U8 + s_ * PIECE + j8 * (PIECE / 8); const GAS float* xr_ = OUT + (size_t)(tbase + tk_ * NGW) * D + s_ * 128 + j8 * 16; \
                _Pragma("unroll") for (int i = 0; i < 16; ++i) { const unsigned e_ = (unsigned)el[tk_ * 128 + 8 * i + gidx]; LD[i] = *(const GAS ldv_t*)(ub_ + ((size_t)e_ << ROWSH)); } \
                XV[0] = *(const GAS f32x4*)xr_; XV[1] = *(const GAS f32x4*)(xr_ + 4); XV[2] = *(const GAS f32x4*)(xr_ + 8); XV[3] = *(const GAS f32x4*)(xr_ + 12); } while (0)
#define A_COMPUTE(LD, XV, it) do { if ((it) < nit) { const int tk_ = ctk_; if (++ctk_ == ntk) { ctk_ = 0; ++cs_; } float pa[8], pb[8]; \
                _Pragma("unroll") for (int i = 0; i < 16; ++i) { f32x2 a2 = {0.f, 0.f}; \
                    PEER_DOT(LD[i], XV, a2); \
                    if (i < 8) pa[i] = a2.x + a2.y; else pb[i - 8] = a2.x + a2.y; } \
                const float r0_ = treduce8(pa, lane), r1_ = treduce8(pb, lane); \
                LAS float* ap_ = acc + tk_ * 128 + 8 * j8 + gidx; ap_[0] += r0_; ap_[64] += r1_; } } while (0)
            ldv_t ldA[16], ldB[16]; f32x4 xA[4], xB[4]; int is_ = 0, itk_ = 0, cs_ = 0, ctk_ = 0;
            A_ISSUE(ldA, xA, 0);
            for (int it = 0; it < nit; it += 2) {
                A_ISSUE(ldB, xB, it + 1); A_COMPUTE(ldA, xA, it);
                A_ISSUE(ldA, xA, it + 2); A_COMPUTE(ldB, xB, it + 1);
            }
#undef A_ISSUE
#undef A_COMPUTE
        }
        LDS_WAIT();
        for (int tk = 0; tk < ntk; ++tk) { const float rstd = rsl[tk];
#pragma unroll
            for (int m = 0; m < 2; ++m) { const int k = tk * 128 + m * 64 + lane; acc[k] = gelu_erf(acc[k] * rstd * INV_SU) * gl[k] * INV_SV; } }
        LDS_WAIT();
        {
            const int nit = 16 * ntk;
#define Y_ISSUE(LD, XV, it) do { const int s_ = is_, tk_ = itk_; if ((it) < nit - 1) { if (++itk_ == ntk) { itk_ = 0; ++is_; } } \
                const GAS unsigned char* vb_ = V8 + s_ * PIECE + j8 * (PIECE / 8); \
                _Pragma("unroll") for (int i = 0; i < 16; ++i) { const unsigned e_ = (unsigned)el[tk_ * 128 + 8 * i + gidx]; LD[i] = *(const GAS ldv_t*)(vb_ + ((size_t)e_ << ROWSH)); } \
                XV = *(const GAS f32x2*)(OUT + (size_t)(tbase + tk_ * NGW) * D + s_ * 128 + j8 * 16 + 2 * gidx); } while (0)
#define Y_COMPUTE(LD, XV, it) do { if ((it) < nit) { const int s_ = cs_, tk_ = ctk_; if (++ctk_ == ntk) { ctk_ = 0; ++cs_; } const size_t xo_ = (size_t)(tbase + tk_ * NGW) * D + s_ * 128 + j8 * 16 + 2 * gidx; \
                f32x2 ya[8]; _Pragma("unroll") for (int q = 0; q < 8; ++q) ya[q] = (f32x2){0.f, 0.f}; \
                _Pragma("unroll") for (int i = 0; i < 16; ++i) { const float hk = acc[tk_ * 128 + 8 * i + gidx]; const f32x2 hh = {hk, hk}; \
                    PEER_AXPY(LD[i], hh, ya); } \
                const bool b5 = lane & 32, b4 = lane & 16, b3 = lane & 8; float y8[8], y4[4], y2[2]; \
                _Pragma("unroll") for (int q = 0; q < 4; ++q) { y8[2 * q] = xsel_add_shfl(b5, ya[q].x, ya[q + 4].x, 32); y8[2 * q + 1] = xsel_add_shfl(b5, ya[q].y, ya[q + 4].y, 32); } \
                _Pragma("unroll") for (int q = 0; q < 4; ++q) y4[q] = xsel_add_shfl(b4, y8[q], y8[q + 4], 16); \
                _Pragma("unroll") for (int q = 0; q < 2; ++q) y2[q] = xsel_add<0x128>(b3, y4[q], y4[q + 2]); \
                f32x2 xn; xn.x = XV.x + y2[0]; xn.y = XV.y + y2[1]; \
                if (!dry) { *(GAS f32x2*)(OUT + xo_) = xn; if (!last) { *(GAS unsigned*)(XB + xo_) = pk2(xn.x, xn.y); *(GAS unsigned short*)(XB8 + xo_) = (unsigned short)__builtin_amdgcn_cvt_pk_fp8_f32(fminf(fmaxf(xn.x, -448.f), 448.f), fminf(fmaxf(xn.y, -448.f), 448.f), 0, false); } } \
                ssl[tk_ * 64 + lane] += xn.x * xn.x + xn.y * xn.y; } } while (0)
            ldv_t ldA[16], ldB[16]; f32x2 xA, xB; int is_ = 0, itk_ = 0, cs_ = 0, ctk_ = 0;
            Y_ISSUE(ldA, xA, 0);
            for (int it = 0; it < nit; it += 2) {
                Y_ISSUE(ldB, xB, it + 1); Y_COMPUTE(ldA, xA, it);
                Y_ISSUE(ldA, xA, it + 2); Y_COMPUTE(ldB, xB, it + 1);
            }
#undef Y_ISSUE
#undef Y_COMPUTE
        }
        LDS_WAIT();
        for (int tk = 0; tk < ntk; ++tk) { const int token = tbase + tk * NGW;
            const float rstd2 = rsqrtf(wave_sum(ssl[tk * 64 + lane]) * (1.0f / D) + EPS);
            if (dry) { if (rstd2 == 12345.678f) RS[token] = rstd2; }
            else if (!last) { if (lane == 0) RS[token] = rstd2; }
            else { VM_WAIT(); const GAS float* fg = (const GAS float*)inptr(C, 19); GAS float* orow = OUT + (size_t)token * D;
#pragma unroll
                for (int q = 0; q < 8; ++q) { const f32x4 v = *(const GAS f32x4*)(orow + q * 256 + lane * 4), g = *(const GAS f32x4*)(fg + q * 256 + lane * 4); f32x4 o = v * rstd2; o = o * g; *(GAS f32x4*)(orow + q * 256 + lane * 4) = o; } } }
        LDS_WAIT();
    }
}

#undef PEER_DOT
#undef PEER_AXPY

#define F4CVT(w, k) __builtin_amdgcn_cvt_scalef32_pk_f32_fp4((w), 1.0f, (k))
__device__ __forceinline__ void peer_sweep4(const Ctx& C, int l, bool last, bool dry = false) {
    const GAS unsigned char* U4 = (const GAS unsigned char*)(C.ws + WS_U + (size_t)l * NEXP * (D / 2)); const GAS unsigned char* V4 = (const GAS unsigned char*)(C.ws + WS_V + (size_t)l * NEXP * (D / 2));
    const GAS int* EXG = (const GAS int*)(C.ws + WS_EXG); const GAS float* CVG = (const GAS float*)(C.ws + WS_CVG);
    GAS bf16_t* XB = (GAS bf16_t*)(C.ws + WS_XB); GAS unsigned char* XB8 = (GAS unsigned char*)(C.ws + WS_XB8); GAS float* RS = (GAS float*)(C.ws + WS_RSTD); GAS float* OUT = (GAS float*)C.out;
    const int lane = C.lane, j8 = lane & 7, gidx = lane >> 3;
    LAS unsigned char* wl = C.lds + C.wave * 19584;
    LAS float* acc = (LAS float*)wl; LAS int* el = (LAS int*)(wl + 4096); LAS float* gl = (LAS float*)(wl + 8192); LAS unsigned char* vtile = wl + 8192; LAS float* ssl = (LAS float*)(wl + 16384); LAS float* rsl = (LAS float*)(wl + 18432);
    LAS unsigned char* hp = wl + 18496; LAS float* hsc = (LAS float*)(wl + 19520);
    const int gw = C.bx * NWAVES + C.wave, NGW = C.G * NWAVES;
    constexpr float INV_SU = 1.0f / SCALE_U4, INV_SV = 1.0f / SCALE_V4;
    for (int tbase = gw; tbase < T; tbase += 8 * NGW) {
        const int ntk = min(8, (T - tbase + NGW - 1) / NGW);
        {
            u32x2 nxw[8]; int ne0, ne1; float nc0, nc1;
#define SETUP_LOAD(tk_) do { const int tkn_ = min((tk_), ntk - 1); const int tokn_ = tbase + tkn_ * NGW; \
                _Pragma("unroll") for (int q = 0; q < 8; ++q) nxw[q] = *(const GAS u32x2*)(XB + (size_t)tokn_ * D + q * 256 + lane * 4); \
                ne0 = EXG[(size_t)tokn_ * 128 + lane]; ne1 = EXG[(size_t)tokn_ * 128 + 64 + lane]; nc0 = CVG[(size_t)tokn_ * 128 + lane]; nc1 = CVG[(size_t)tokn_ * 128 + 64 + lane]; } while (0)
            SETUP_LOAD(0);
            for (int tk = 0; tk < ntk; ++tk) { const int token = tbase + tk * NGW; float ss = 0.f; f32x4 xr8[8];
#pragma unroll
                for (int q = 0; q < 8; ++q) { const u32x2 wv = nxw[q]; const f32x4 v = {bflo(wv.x), bfhi(wv.x), bflo(wv.y), bfhi(wv.y)}; xr8[q] = v; ss += (v[0] * v[0] + v[1] * v[1]) + (v[2] * v[2] + v[3] * v[3]); }
                const int e0 = ne0, e1 = ne1; const float c0 = nc0, c1 = nc1;
                SETUP_LOAD(tk + 1);
                const float rstd = rsqrtf(wave_sum(ss) * (1.0f / D) + EPS);
                {
                    const float st = 2.0f * rstd; GAS unsigned short* xh = (GAS unsigned short*)(C.ws + WS_XH4 + (size_t)token * (D / 2)) + lane; GAS unsigned short* xl = (GAS unsigned short*)(C.ws + WS_XL4 + (size_t)token * (D / 2)) + lane;
#pragma unroll
                    for (int q = 0; q < 8; ++q) { const f32x4 xs = xr8[q] * st; unsigned ph = 0u, pl = 0u;
                        ph = __builtin_amdgcn_cvt_scalef32_pk_fp4_f32(ph, xs[0], xs[1], 1.0f, 0); ph = __builtin_amdgcn_cvt_scalef32_pk_fp4_f32(ph, xs[2], xs[3], 1.0f, 1);
                        const f32x2 d0 = __builtin_amdgcn_cvt_scalef32_pk_f32_fp4(ph, 1.0f, 0), d1 = __builtin_amdgcn_cvt_scalef32_pk_f32_fp4(ph, 1.0f, 1);
                        pl = __builtin_amdgcn_cvt_scalef32_pk_fp4_f32(pl, 8.f * (xs[0] - d0.x), 8.f * (xs[1] - d0.y), 1.0f, 0); pl = __builtin_amdgcn_cvt_scalef32_pk_fp4_f32(pl, 8.f * (xs[2] - d1.x), 8.f * (xs[3] - d1.y), 1.0f, 1);
                        xh[q * 64] = (unsigned short)ph; xl[q * 64] = (unsigned short)pl; } }
                const float z0 = c0 * rstd, z1 = c1 * rstd;
                const float p0 = __expf(z0 - row_max_f32(z0)), p1 = __expf(z1 - row_max_f32(z1));
                el[tk * 128 + lane] = e0; el[tk * 128 + 64 + lane] = e1; gl[tk * 128 + lane] = p0 / row_sum_f32(p0); gl[tk * 128 + 64 + lane] = p1 / row_sum_f32(p1);
                acc[tk * 128 + lane] = 0.f; acc[tk * 128 + 64 + lane] = 0.f; ssl[tk * 64 + lane] = 0.f; if (lane == 0) rsl[tk] = rstd; }
#undef SETUP_LOAD
        }
        LDS_WAIT(); VM_WAIT();
        {
            const int nit = 8 * ntk, m16 = lane & 15, kc = lane >> 4;
            int is_ = 0, itk_ = 0, ctk_ = 0;
            const GAS unsigned char* XB8r = (const GAS unsigned char*)(C.ws + WS_XB8);
#define A4_ISSUE(LD, H, XV, WITHX) do { const GAS unsigned char* ub_ = U4 + is_ * 128 + (m16 & 1) * 64 + kc * 16; \
                _Pragma("unroll") for (int i = 0; i < 8; ++i) { const unsigned e_ = (unsigned)el[itk_ * 128 + 8 * (8 * (H) + i) + (m16 >> 1)]; LD[i] = *(const GAS u32x4*)(ub_ + ((size_t)e_ << 10)); } \
                if (WITHX) { const size_t xo_ = (size_t)(tbase + itk_ * NGW) * (D / 2) + is_ * 128 + (m16 & 1) * 64 + kc * 16; XV[0] = *(const GAS u32x4*)(XB8r + (WS_XH4 - WS_XB8) + xo_); XV[1] = *(const GAS u32x4*)(XB8r + (WS_XL4 - WS_XB8) + xo_); } } while (0)
#define A4_ADVANCE(it) do { if ((it) < nit - 1) { if (++itk_ == ntk) { itk_ = 0; ++is_; } } } while (0)
#define A4_COMPUTE(LD, XV, H) do { const pg8::pg8_v4i h4_ = __builtin_bit_cast(pg8::pg8_v4i, XV[0]), q4_ = __builtin_bit_cast(pg8::pg8_v4i, XV[1]); \
                const pg8::pg8_v8i xh_ = __builtin_shufflevector(h4_, h4_, 0, 1, 2, 3, 4, 5, 6, 7), xl_ = __builtin_shufflevector(q4_, q4_, 0, 1, 2, 3, 4, 5, 6, 7); \
                _Pragma("unroll") for (int i = 0; i < 8; ++i) { const pg8::pg8_v4i l4_ = __builtin_bit_cast(pg8::pg8_v4i, LD[i]); const pg8::pg8_v8i ua_ = __builtin_shufflevector(l4_, l4_, 0, 1, 2, 3, 4, 5, 6, 7); \
                    f32x4 r_ = __builtin_amdgcn_mfma_scale_f32_16x16x128_f8f6f4(ua_, xl_, (f32x4){0.f, 0.f, 0.f, 0.f}, 4, 4, 0, 0, 0, 0); r_ = r_ * 0.125f; \
                    r_ = __builtin_amdgcn_mfma_scale_f32_16x16x128_f8f6f4(ua_, xh_, r_, 4, 4, 0, 0, 0, 0); \
                    const float t1_ = dpp_f<0xB1>(r_[1]), t3_ = dpp_f<0xB1>(r_[3]); \
                    if (m16 == 0) { LAS f32x2* ap_ = (LAS f32x2*)(acc + ctk_ * 128 + 8 * (8 * (H) + i) + 2 * kc); f32x2 o_ = *ap_; o_.x += r_[0] + t1_; o_.y += r_[2] + t3_; *ap_ = o_; } } } while (0)
#define A4_FINISH() do { if (++ctk_ == ntk) ctk_ = 0; } while (0)
            u32x4 lda[8], ldb[8], x0[2], x1[2];
            A4_ISSUE(lda, 0, x0, true);
            for (int it = 0; it < nit; it += 2) {
                A4_ISSUE(ldb, 1, x0, false); A4_ADVANCE(it);      A4_COMPUTE(lda, x0, 0);
                A4_ISSUE(lda, 0, x1, true);                        A4_COMPUTE(ldb, x0, 1); A4_FINISH();
                A4_ISSUE(ldb, 1, x1, false); A4_ADVANCE(it + 1);  A4_COMPUTE(lda, x1, 0);
                A4_ISSUE(lda, 0, x0, true);                        A4_COMPUTE(ldb, x1, 1); A4_FINISH();
            }
#undef A4_ISSUE
#undef A4_ADVANCE
#undef A4_COMPUTE
#undef A4_FINISH
        }
        LDS_WAIT();
        for (int tk = 0; tk < ntk; ++tk) {
            const int k = tk * 128 + 2 * lane; const f32x2 av = *(LAS f32x2*)(acc + k), gv = *(LAS f32x2*)(gl + k);
            const float h0 = gelu_erf(av.x * (0.5f * INV_SU)) * gv.x * INV_SV, h1 = gelu_erf(av.y * (0.5f * INV_SU)) * gv.y * INV_SV;
            const float mx = wave_max(fmaxf(fabsf(h0), fabsf(h1))), s = mx > 0.f ? 6.0f / mx : 0.f, a0 = h0 * s, a1 = h1 * s;
            const unsigned ph = __builtin_amdgcn_cvt_scalef32_pk_fp4_f32(0u, a0, a1, 1.0f, 0); const f32x2 dh = __builtin_amdgcn_cvt_scalef32_pk_f32_fp4(ph, 1.0f, 0);
            const unsigned pl = __builtin_amdgcn_cvt_scalef32_pk_fp4_f32(0u, 8.f * (a0 - dh.x), 8.f * (a1 - dh.y), 1.0f, 0);
            hp[tk * 128 + lane] = (unsigned char)ph; hp[tk * 128 + 64 + lane] = (unsigned char)pl; if (lane == 0) hsc[tk] = mx * (1.0f / 6.0f); }
        LDS_WAIT();
        {
            const int nit = 8 * ntk;
            int is_ = 0, itk_ = 0, cs_ = 0, ctk_ = 0;
#define Y4_ISSUE(LD, H, XV, WITHX) do { const GAS unsigned char* vb_ = V4 + is_ * 128 + j8 * 16; \
                _Pragma("unroll") for (int i = 0; i < 8; ++i) { const unsigned e_ = (unsigned)el[itk_ * 128 + 8 * (8 * (H) + i) + gidx]; LD[i] = *(const GAS u32x4*)(vb_ + ((size_t)e_ << 10)); } \
                if (WITHX) { const GAS bf16_t* xp_ = XB + (size_t)(tbase + itk_ * NGW) * D + is_ * 256 + lane; \
                    _Pragma("unroll") for (int p = 0; p < 4; ++p) XV[p] = bf2f(xp_[64 * p]); } } while (0)
#define Y4_ADVANCE(it) do { if ((it) < nit - 1) { if (++itk_ == ntk) { itk_ = 0; ++is_; } } } while (0)
#define Y4_COMPUTE(LD, H) do { \
                _Pragma("unroll") for (int i = 0; i < 8; ++i) *(LAS u32x4*)(vtile + (8 * i + gidx) * 128 + ((j8 ^ ((4 * (i & 1) + (gidx >> 1)) & 7)) * 16)) = LD[i]; \
                const int m32_ = lane & 31, kg_ = lane >> 5, li_ = lane & 15, grp_ = (lane >> 4) & 1; \
                pg8::pg8_v4i ha_ = {0, 0, 0, 0}; if (m32_ < 2) ha_ = *(const LAS pg8::pg8_v4i*)(hp + ctk_ * 128 + m32_ * 64 + 32 * (H) + 16 * kg_); \
                const pg8::pg8_v8i ha8_ = __builtin_shufflevector(ha_, ha_, 0, 1, 2, 3, 4, 5, 6, 7); \
                LDS_WAIT(); \
                const LAS unsigned char* tb_ = vtile + (32 * kg_ + li_) * 128 + grp_ * 8; const int sw_ = li_ >> 1; \
                _Pragma("unroll") for (int bk = 0; bk < 8; ++bk) { \
                    const v2i_t t0_ = __builtin_amdgcn_ds_read_tr4_b64_v2i32((LAS v2i_t*)(tb_ + ((bk ^ sw_) * 16))), t1_ = __builtin_amdgcn_ds_read_tr4_b64_v2i32((LAS v2i_t*)(tb_ + 16 * 128 + ((bk ^ sw_) * 16))); \
                    const pg8::pg8_v8i vb8_ = {t0_.x, t0_.y, t1_.x, t1_.y, 0, 0, 0, 0}; \
                    const f32x16 d_ = __builtin_amdgcn_mfma_scale_f32_32x32x64_f8f6f4(ha8_, vb8_, (f32x16){0.f, 0.f, 0.f, 0.f, 0.f, 0.f, 0.f, 0.f, 0.f, 0.f, 0.f, 0.f, 0.f, 0.f, 0.f, 0.f}, 4, 4, 0, 0, 0, 0); \
                    yb[bk] += d_[0] + d_[1] * 0.125f; } \
                LDS_WAIT(); } while (0)
#define Y4_FINISH(XV, it) do { if ((it) < nit) { const size_t xo_ = (size_t)(tbase + ctk_ * NGW) * D + cs_ * 256 + lane; const float hs_ = hsc[ctk_]; float sq_ = 0.f; \
                _Pragma("unroll") for (int p = 0; p < 4; ++p) { const float up_ = __shfl(yb[2 * p + 1], lane & 31); const float xn = XV[p] + (lane < 32 ? yb[2 * p] : up_) * hs_; \
                    if (!dry) { XB[xo_ + 64 * p] = (bf16_t)pk2(xn, 0.f);     \
                        if (!last) { const int pk = __builtin_amdgcn_cvt_pk_fp8_f32(fminf(fmaxf(xn, -448.f), 448.f), 0.f, 0, false); XB8[xo_ + 64 * p] = (unsigned char)pk; } } \
                    sq_ += xn * xn; } \
                ssl[ctk_ * 64 + lane] += sq_; } \
                _Pragma("unroll") for (int q = 0; q < 8; ++q) yb[q] = 0.f; \
                if (++ctk_ == ntk) { ctk_ = 0; ++cs_; } } while (0)
            u32x4 lda[8], ldb[8]; f32x4 x0, x1; float yb[8];
#pragma unroll
            for (int q = 0; q < 8; ++q) yb[q] = 0.f;
            Y4_ISSUE(lda, 0, x0, true);
            for (int it = 0; it < nit; it += 2) {
                Y4_ISSUE(ldb, 1, x0, false); Y4_ADVANCE(it);      Y4_COMPUTE(lda, 0);
                Y4_ISSUE(lda, 0, x1, true);                        Y4_COMPUTE(ldb, 1); Y4_FINISH(x0, it);
                Y4_ISSUE(ldb, 1, x1, false); Y4_ADVANCE(it + 1);  Y4_COMPUTE(lda, 0);
                Y4_ISSUE(lda, 0, x0, true);                        Y4_COMPUTE(ldb, 1); Y4_FINISH(x1, it + 1);
            }
#undef Y4_ISSUE
#undef Y4_ADVANCE
#undef Y4_COMPUTE
#undef Y4_FINISH
        }
        LDS_WAIT();
        if (!last || dry) {
            for (int tk = 0; tk < ntk; ++tk) { const float rstd2 = rsqrtf(wave_sum(ssl[tk * 64 + lane]) * (1.0f / D) + EPS);
                if (dry) { if (rstd2 == 12345.678f) RS[tbase + tk * NGW] = rstd2; } else if (lane == 0) RS[tbase + tk * NGW] = rstd2; } }
        else {
            VM_WAIT(); const GAS float* fg = (const GAS float*)inptr(C, 19);
            f32x4 gq[8]; u32x2 nr[8];
#pragma unroll
            for (int q = 0; q < 8; ++q) { gq[q] = *(const GAS f32x4*)(fg + q * 256 + lane * 4); nr[q] = *(const GAS u32x2*)(XB + (size_t)tbase * D + q * 256 + lane * 4); }
            for (int tk = 0; tk < ntk; ++tk) { GAS float* orow = OUT + (size_t)(tbase + tk * NGW) * D; f32x4 cr[8];
#pragma unroll
                for (int q = 0; q < 8; ++q) cr[q] = (f32x4){bflo(nr[q].x), bfhi(nr[q].x), bflo(nr[q].y), bfhi(nr[q].y)};
                { const GAS bf16_t* nrow = XB + (size_t)(tbase + min(tk + 1, ntk - 1) * NGW) * D;
#pragma unroll
                  for (int q = 0; q < 8; ++q) nr[q] = *(const GAS u32x2*)(nrow + q * 256 + lane * 4); }
                const float rstd2 = rsqrtf(wave_sum(ssl[tk * 64 + lane]) * (1.0f / D) + EPS);
#pragma unroll
                for (int q = 0; q < 8; ++q) { f32x4 o = cr[q] * rstd2; o = o * gq[q]; *(GAS f32x4*)(orow + q * 256 + lane * 4) = o; } } }
        LDS_WAIT();
    }
}
#undef F4CVT

constexpr int NPHASE = 1 + 8 * DEPTH - 1;
struct Args { const float* in[20]; float* out; unsigned char* ws; int ph_lo, ph_hi; };

__global__ void __launch_bounds__(NTHR, 2) fwd(Args args) {
    extern __shared__ __attribute__((aligned(16))) unsigned char lds_raw[];
    Ctx C;
    C.lds = (LAS unsigned char*)lds_raw; C.tid = threadIdx.x; C.lane = C.tid & 63; C.wave = __builtin_amdgcn_readfirstlane(C.tid >> 6); C.G = gridDim.x; C.bx = blockIdx.x;
    C.out = args.out; C.ws = args.ws;
    PG8_LAS unsigned char* lds = (PG8_LAS unsigned char*)lds_raw;
    volatile LAS unsigned* MISC = (volatile LAS unsigned*)(lds + MISC_OFF);
    for (int u = C.tid; u < (LDS_BYTES - TOP_OFF) / 4; u += NTHR) ((LAS unsigned*)(lds + TOP_OFF))[u] = 0u;
    __syncthreads();
    if (C.tid < 20) { const unsigned long long pv = (unsigned long long)args.in[C.tid]; LAS unsigned* p = (LAS unsigned*)(lds + PTR_OFF) + 2 * C.tid; p[0] = (unsigned)pv; p[1] = (unsigned)(pv >> 32); }
    __syncthreads();
    const int lo = args.ph_lo, hi = args.ph_hi;
    unsigned* barw = (unsigned*)(C.ws + WS_CTL) + CW_BAR;
    XcdBarrier bar; bar.bar = barw; bar.x = 0; bar.st = nullptr;
    if (hi - lo > 1) bar = xcd_barrier_post(barw, MISC + 8);
#ifndef PH_MASK
#define PH_MASK 0xFF
#endif
#define PHEN(i) (((PH_MASK) >> (i)) & 1)
#define IN(k) (lo <= (k) && (k) < hi)
#define SEAM(k) do { if (IN(k) && IN((k) + 1)) { xcd_barrier(bar); if (PROBE_DUP == 12) xcd_barrier(bar); } } while (0)

#define PHASE_CTX() Ctx P; P.lds = C.lds; P.out = C.out; P.ws = C.ws; P.G = C.G; P.bx = C.bx; P.tid = C.tid; \
    asm volatile("" : "+s"(P.out), "+s"(P.ws), "+s"(P.G), "+s"(P.bx), "+v"(P.tid)); \
    P.out = (float*)(GAS float*)P.out; P.ws = (unsigned char*)(GAS unsigned char*)P.ws; P.lane = P.tid & 63; P.wave = __builtin_amdgcn_readfirstlane(P.tid >> 6)
    if (PHEN(0) && IN(0)) { { PHASE_CTX(); prologue(P); } if (PROBE_DUP == 3) { __syncthreads(); PHASE_CTX(); prologue(P); } SEAM(0); }
    for (int l = 0; l < DEPTH; ++l) {
        const int base = 1 + 8 * l;
        if (PHEN(1) && IN(base + 0)) {
            { PHASE_CTX();
              constexpr int NG8 = INW - G1_NBF, U8 = (T / 256) * (NG8 / 256);
              pg8::Gemm g{(const bf16_t*)(P.ws + WS_XB8), (const bf16_t*)(P.ws + WS_WIN8), T, NG8, D / 2}; SplitOrder S; S.init(T, NG8, P.G, P.bx);
              { const int rem = 1920 % P.G;
                if (G1_NBF == 7680 && P.G == 256 && rem == 128) { S.cut = 128; S.nA = 5; S.nB = 7; }
                else if (G1_NBF == 3072 && P.G == 256) { S.cut = 128; S.nA = 9; S.nB = 12; }
                else { S.cut = 0; S.nA = 0; S.nB = (U8 + P.G - 1) / P.G; } }
              static_assert(G1_NBF == 3072, "EpiG1B: the fp8 call holds exactly the q/k/v and gate columns");
              EpiG1B E{P.ws + WS_PQKV, P.ws + WS_PG, (const float*)(P.ws + WS_RSTD), G1_NBF / 256, 1.0f / 1024.0f};
              pg8::gemm_phase<EpiG1B, SplitOrder, false, true>(lds, g, S, E, nullptr);
              if (PROBE_DUP == 2 || PROBE_DUP == 13) { __syncthreads(); pg8::gemm_phase<EpiG1B, SplitOrder, false, true>(lds, g, S, E, nullptr); } }
            __syncthreads();
            if (G1_NBF > 0) { PHASE_CTX();
              pg8::Gemm g{(const bf16_t*)(P.ws + WS_XB), (const bf16_t*)(P.ws + WS_WIN), T, G1_NBF, D}; SplitOrder S; S.init(T, G1_NBF, P.G, P.bx);
              if (G1_NBF == 3072 && P.G == 256) { S.cut = 128; S.nA = 4; S.nB = 2; } else { S.cut = 0; S.nA = 0; S.nB = ((T / 256) * (G1_NBF / 256) + P.G - 1) / P.G; }
              EpiG1 E{(bf16_t*)(P.ws + WS_PA), (bf16_t*)(P.ws + WS_PB), (bf16_t*)(P.ws + WS_PQKV), (bf16_t*)(P.ws + WS_PG), (const float*)(P.ws + WS_RSTD), 0, 1.0f};
              pg8::gemm_phase<EpiG1, SplitOrder, false>(lds, g, S, E, nullptr);
              if (PROBE_DUP == 2) { __syncthreads(); pg8::gemm_phase<EpiG1, SplitOrder, false>(lds, g, S, E, nullptr); } }
            SEAM(base + 0);
        }
        if (PHEN(2) && IN(base + 1)) {
#ifdef ATT_NAIVE
            PHASE_CTX(); att_naive(P); vss_rows(P);
#else
            { PHASE_CTX(); att_mfma(P, BG_TABLES && BG_TABLES0 && l == 0 && P.G == 256); } { PHASE_CTX(); vss_rows(P); }
            if (PROBE_DUP == 5) { { PHASE_CTX(); att_mfma(P); } { PHASE_CTX(); vss_rows(P); } }
#endif
            SEAM(base + 1); }
        if (PHEN(3) && IN(base + 2)) {
#ifdef MIXA_NAIVE
            { PHASE_CTX(); mixa_naive(P, l); }
#else
            { PHASE_CTX(); mixa_mfma(P, l, BG_TABLES && BG_TABLES0 && l == 0 && P.G == 256); }
#endif
#ifdef MIXB_NAIVE
            { PHASE_CTX(); mixb_naive(P); }
#else
            { PHASE_CTX(); mixb_mfma(P, BG_TABLES && BG_TABLES0 && l == 0 && P.G == 256); }
#endif
            { PHASE_CTX(); combine_groups(P, BG_TABLES && BG_TABLES0 && l == 0 && P.G == 256); }
            if (PROBE_DUP == 6) { { PHASE_CTX(); mixa_mfma(P, l); } { PHASE_CTX(); mixb_mfma(P); } { PHASE_CTX(); combine_groups(P); } }
            SEAM(base + 2); }
        if (PHEN(4) && IN(base + 3)) {
            PHASE_CTX();
            pg8::Gemm g{(const bf16_t*)(P.ws + WS_YA), (const bf16_t*)(P.ws + WS_WA), T, D, BR8 ? 1280 : 2560}; pg8::StaticOrder S; S.init(T, D, P.G, P.bx);
            EpiBranchF<BR8> E{(bf16_t*)(P.ws + WS_PA), (const unsigned char*)(P.ws + WS_PG)};
            pg8::gemm_phase<EpiBranchF<BR8>, pg8::StaticOrder, false, BR8 != 0>(lds, g, S, E, nullptr);
            if (PROBE_DUP == 7) { __syncthreads(); pg8::gemm_phase<EpiBranchF<BR8>, pg8::StaticOrder, false, BR8 != 0>(lds, g, S, E, nullptr); }
            SEAM(base + 3);
        }
        if (PHEN(5) && IN(base + 4)) {
            PHASE_CTX();
            pg8::Gemm g{(const bf16_t*)(P.ws + WS_PA), (const bf16_t*)(P.ws + WS_WOUT), T, D, D}; pg8::StaticOrder S; S.init(T, D, P.G, P.bx);
            const float* xin0 = inptr(P, 0);
            if (l == 0) { EpiWout<0> E{xin0, P.out, (bf16_t*)(P.ws + WS_XB), P.ws + WS_XB8}; pg8::gemm_phase<EpiWout<0>, pg8::StaticOrder, false>(lds, g, S, E, nullptr);
                if (PROBE_DUP == 10) { __syncthreads(); pg8::gemm_phase<EpiWout<0>, pg8::StaticOrder, false>(lds, g, S, E, nullptr); } }
            else { EpiWout<1> E{xin0, P.out, (bf16_t*)(P.ws + WS_XB), P.ws + WS_XB8}; pg8::gemm_phase<EpiWout<1>, pg8::StaticOrder, false>(lds, g, S, E, nullptr); }
            SEAM(base + 4);
        }
        if (PHEN(6) && IN(base + 5)) {
            PHASE_CTX();
            pg8::Gemm g{(const bf16_t*)(P.ws + WS_XB), (const bf16_t*)(P.ws + WS_WSC), T, D, D}; pg8::StaticOrder S; S.init(T, D, P.G, P.bx);
            EpiScoreBf16 E{(bf16_t*)(P.ws + WS_PQKV)};
            pg8::gemm_phase<EpiScoreBf16, pg8::StaticOrder, false>(lds, g, S, E, nullptr);
            if (PROBE_DUP == 8) { __syncthreads(); pg8::gemm_phase<EpiScoreBf16, pg8::StaticOrder, false>(lds, g, S, E, nullptr); }
            if (PROBE_DUP == 15) { __syncthreads(); pg8::Gemm g2{(const bf16_t*)(P.ws + WS_XB), (const bf16_t*)(P.ws + WS_WSC), T, 2 * D, D / 2}; pg8::StaticOrder S2; S2.init(T, 2 * D, P.G, P.bx); EpiScoreBf16 E2{(bf16_t*)(P.ws + WS_PA)}; pg8::gemm_phase<EpiScoreBf16, pg8::StaticOrder, false>(lds, g2, S2, E2, nullptr); }
            if (PROBE_DUP == 16) { __syncthreads(); pg8::Gemm g2{(const bf16_t*)(P.ws + WS_XB), (const bf16_t*)(P.ws + WS_WSC), T, 2 * D, D / 2}; pg8::StaticOrder S2; S2.init(T, 2 * D, P.G, P.bx); EpiNull E2; pg8::gemm_phase<EpiNull, pg8::StaticOrder, false>(lds, g2, S2, E2, nullptr); }
            if (PROBE_DUP == 17) { __syncthreads(); pg8::Gemm g2{(const bf16_t*)(P.ws + WS_XB), (const bf16_t*)(P.ws + WS_WSC), T, 2 * D, D / 2}; pg8::StaticOrder S2; S2.init(T, 2 * D, P.G, P.bx); EpiHalf E2{(bf16_t*)(P.ws + WS_PA)}; pg8::gemm_phase<EpiHalf, pg8::StaticOrder, false>(lds, g2, S2, E2, nullptr); }
            if (PROBE_DUP == 18) { __syncthreads(); pg8::Gemm g2{(const bf16_t*)(P.ws + WS_XB), (const bf16_t*)(P.ws + WS_WSC), T, 2 * D, D / 2}; pg8::StaticOrder S2; S2.init(T, 2 * D, P.G, P.bx); EpiLocal E2{(bf16_t*)(P.ws + WS_PA)}; pg8::gemm_phase<EpiLocal, pg8::StaticOrder, false>(lds, g2, S2, E2, nullptr); }
            if (PROBE_DUP == 19) { __syncthreads(); pg8::Gemm g2{(const bf16_t*)(P.ws + WS_XB), (const bf16_t*)(P.ws + WS_WSC), T, 2 * D, D / 2}; pg8::StaticOrder S2; S2.init(T, 2 * D, P.G, P.bx); EpiContig E2{(bf16_t*)(P.ws + WS_PA)}; pg8::gemm_phase<EpiContig, pg8::StaticOrder, false>(lds, g2, S2, E2, nullptr); }
            if (PROBE_DUP == 20) { __syncthreads(); pg8::Gemm g2{(const bf16_t*)(P.ws + WS_XB), (const bf16_t*)(P.ws + WS_WSC), T, 2 * D, D / 2}; pg8::StaticOrder S2; S2.init(T, 2 * D, P.G, P.bx); EpiNT E2{(bf16_t*)(P.ws + WS_PA)}; pg8::gemm_phase<EpiNT, pg8::StaticOrder, false>(lds, g2, S2, E2, nullptr); }
            if (PROBE_DUP == 21) { __syncthreads(); pg8::Gemm g2{(const bf16_t*)(P.ws + WS_XB), (const bf16_t*)(P.ws + WS_WSC), T, 2 * D, D / 2}; pg8::StaticOrder S2; S2.init(T, 2 * D, P.G, P.bx); EpiRows8 E2{(bf16_t*)(P.ws + WS_PA)}; pg8::gemm_phase<EpiRows8, pg8::StaticOrder, false>(lds, g2, S2, E2, nullptr); }
            if (PROBE_DUP == 14) { __syncthreads(); pg8::Gemm g2{(const bf16_t*)(P.ws + WS_XB), (const bf16_t*)(P.ws + WS_WSC), T, D, D / 2}; EpiScoreBf16 E2{(bf16_t*)(P.ws + WS_PA)}; pg8::gemm_phase<EpiScoreBf16, pg8::StaticOrder, false>(lds, g2, S, E2, nullptr); }
            SEAM(base + 5);
        }
        if (PHEN(7) && IN(base + 6)) { { PHASE_CTX(); peer_topk_dpp(P, l + 1 < DEPTH ? l + 1 : -1); } if (PROBE_DUP == 4) { PHASE_CTX(); peer_topk_dpp(P); } VM_WAIT(); __syncthreads(); if (PROBE_DUP == 1) { PHASE_CTX(); peer_gather(P, l, l == DEPTH - 1, true); }
#ifdef PEER_ROWS
            { PHASE_CTX(); peer_gather(P, l, l == DEPTH - 1); }
#else
            if (PROBE_DUP == 11) { PHASE_CTX(); peer_sweep(P, l, l == DEPTH - 1, true); }
#if PEER_FP4
            if (PROBE_DUP == 11) { PHASE_CTX(); peer_sweep4(P, l, l == DEPTH - 1, true); }
            { PHASE_CTX(); peer_sweep4(P, l, l == DEPTH - 1); }
#else
            { PHASE_CTX(); peer_sweep(P, l, l == DEPTH - 1); }
#endif
#endif
            if (l + 1 < DEPTH) SEAM(base + 6); }
        if (PHEN(0) && l + 1 < DEPTH && IN(base + 7)) { { PHASE_CTX(); cvt_layer_weights(P, l + 1); } if (PROBE_DUP == 9) { __syncthreads(); PHASE_CTX(); cvt_layer_weights(P, l + 1); } SEAM(base + 7); }
    }
#undef IN
#undef SEAM
}
}

#ifndef MK_ONE_LAUNCH
#define MK_ONE_LAUNCH 1
#endif
extern "C" void kernel_launch(void* const* d_in, const int* in_sizes, int n_in, void* d_out, int out_size, void* d_ws, size_t ws_size, hipStream_t stream) {
    using namespace mk;
    static int grid = 0;
    if (grid == 0) {
        if (n_in != 20 || in_sizes[0] != T * D || out_size != T * D || ws_size < WS_END) { fprintf(stderr, "kernel_launch: unexpected shapes (n_in %d, in0 %d, out %d, ws %zu < %zu); nothing launched\n", n_in, n_in > 0 ? in_sizes[0] : -1, out_size, ws_size, (size_t)WS_END); grid = -1; return; }
        int dev = 0, cus = 0, per_cu = 0;
        if (hipGetDevice(&dev) != hipSuccess || hipDeviceGetAttribute(&cus, hipDeviceAttributeMultiprocessorCount, dev) != hipSuccess) { fprintf(stderr, "kernel_launch: device query failed\n"); grid = -1; return; }
        if (hipFuncSetAttribute((const void*)fwd, hipFuncAttributeMaxDynamicSharedMemorySize, LDS_BYTES) != hipSuccess) { fprintf(stderr, "kernel_launch: hipFuncSetAttribute failed\n"); grid = -1; return; }
        if (hipOccupancyMaxActiveBlocksPerMultiprocessor(&per_cu, (const void*)fwd, NTHR, LDS_BYTES) != hipSuccess || per_cu < 1) fprintf(stderr, "kernel_launch: note: occupancy query reports %d workgroups per CU\n", per_cu);
        (void)hipGetLastError();
        grid = cus;
    }
    if (grid < 0) return;
    if (hipMemsetAsync((char*)d_ws + WS_CTL, 0, CTL_ZERO_BYTES, stream) != hipSuccess) { fprintf(stderr, "kernel_launch: memset failed\n"); return; }
    Args a{};
    for (int i = 0; i < 20; ++i) a.in[i] = (const float*)d_in[i];
    a.out = (float*)d_out; a.ws = (unsigned char*)d_ws;
#if MK_ONE_LAUNCH
    a.ph_lo = 0; a.ph_hi = NPHASE;
    hipLaunchKernelGGL(fwd, dim3(grid), dim3(NTHR), LDS_BYTES, stream, a);
#else
    for (int p = 0; p < NPHASE; ++p) { a.ph_lo = p; a.ph_hi = p + 1; hipLaunchKernelGGL(fwd, dim3(grid), dim3(NTHR), LDS_BYTES, stream, a); }
#endif
    const hipError_t le = hipPeekAtLastError();
    if (le != hipSuccess) fprintf(stderr, "kernel_launch: launch failed: %s\n", hipGetErrorName(le));
}
```

```cpp
#include <hip/hip_runtime.h>
#include <cstdio>
#include <cstdint>
namespace pg8 {
#define PG8_LAS __attribute__((address_space(3)))
typedef unsigned short bf16_t;
typedef short bf16x8 __attribute__((ext_vector_type(8)));
typedef float f32x4 __attribute__((ext_vector_type(4)));
typedef unsigned u32x4 __attribute__((ext_vector_type(4)));
constexpr int BM = 256, BK = 64, HALF = 128, HTB = HALF * BK * 2  , STAGE_BYTES = 8 * HTB, NXCD = 8, WGM = 8;

__host__ __device__ __forceinline__ int lds_byte(int r, int c) { const int st = (r >> 4) * 2 + (c >> 5), rr = r & 15, cc = c & 31, ob = rr * 64 + cc * 2; return st * 1024 + (ob ^ (((ob >> 9) & 1) << 5)); }
__host__ __device__ __forceinline__ void stage_rc(int b, int& R, int& C) { const int st = b / 1024, sb = b % 1024, swz = sb ^ (((sb >> 9) & 1) << 5); R = (st >> 1) * 16 + swz / 64; C = (st & 1) * 32 + (swz % 64) / 2; }
__host__ __device__ __forceinline__ int perm32(int rho) { const int n = rho >> 4, i = rho & 15; return 8 * (i >> 2) + 4 * n + (i & 3); }
__host__ __device__ __forceinline__ int perm32b(int rho) { const int n = rho >> 4, i = rho & 15; return 16 * (i >> 2) + 4 * n + (i & 3); }

struct Unit { int pm, pn; };
struct Gemm { const bf16_t* A; const bf16_t* Bt; int M, N, K; };

struct StaticOrder {
    int nM, nN, nwg, G, c;
    __host__ __device__ void init(int M, int N, int G_, int c_) { nM = M / BM; nN = N / BM; nwg = nM * nN; G = G_; c = c_; }
    __host__ __device__ bool next(int i, Unit& u) const {
        const long L = (long)i * G + c; if (L >= nwg) return false;
        int wgid = (int)L; { const int q = nwg / NXCD, r = nwg % NXCD, xcd = wgid % NXCD, off = wgid / NXCD; wgid = (xcd < r ? xcd * (q + 1) : r * (q + 1) + (xcd - r) * q) + off; }
        const int nig = WGM * nN, gid = wgid / nig, fm = gid * WGM, gsz = (nM - fm) < WGM ? (nM - fm) : WGM;
        u.pm = fm + ((wgid % nig) % gsz); u.pn = (wgid % nig) / gsz; return true;
    }
    __device__ __forceinline__ void a_ready(const Unit&) const {}
    __device__ __forceinline__ void done(const Unit&) const {}
};
struct CountedOrder : StaticOrder {
    const unsigned* ready; unsigned need; unsigned* tmo;
    __device__ __forceinline__ void a_ready(const Unit& u) const {
        if (threadIdx.x < 64) {
            const unsigned long long t0 = __builtin_amdgcn_s_memrealtime(); unsigned polls = 0;
            while ((unsigned)__builtin_amdgcn_readfirstlane(__hip_atomic_load(ready + 64 * u.pm, __ATOMIC_RELAXED, __HIP_MEMORY_SCOPE_AGENT)) < need) {
                if ((++polls & 255u) == 0u && __builtin_amdgcn_readfirstlane(__hip_atomic_load(tmo, __ATOMIC_RELAXED, __HIP_MEMORY_SCOPE_AGENT)) != 0u) break;
                if (__builtin_amdgcn_s_memrealtime() - t0 > 2000000ull) {
                    if (threadIdx.x == 0) { unsigned expect = 0u; __hip_atomic_compare_exchange_strong(tmo + 1, &expect, 0x600u | (unsigned)(u.pm & 0xff), __ATOMIC_RELAXED, __ATOMIC_RELAXED, __HIP_MEMORY_SCOPE_AGENT); __hip_atomic_store(tmo, 1u, __ATOMIC_RELAXED, __HIP_MEMORY_SCOPE_AGENT); }
                    break; }
                __builtin_amdgcn_s_sleep(2); }
            __builtin_amdgcn_fence(__ATOMIC_ACQUIRE, "agent");
            asm volatile("s_waitcnt vmcnt(0)" ::: "memory");
        }
#if !defined(BROKEN_HOOK_NO_BARRIER)
        asm volatile("" ::: "memory"); __builtin_amdgcn_s_barrier(); asm volatile("" ::: "memory");
#endif
    }
};

__device__ __forceinline__ unsigned cvt_pk_bf16(float lo, float hi) { unsigned r; asm volatile("v_cvt_pk_bf16_f32 %0, %1, %2" : "=v"(r) : "v"(lo), "v"(hi)); return r; }
typedef float f32x2 __attribute__((ext_vector_type(2)));
__device__ __forceinline__ f32x2 gelu_pk(f32x2 v) {
    const f32x2 av = __builtin_elementwise_abs(v), d = av * 0.2316418882f + 1.0f;
    f32x2 t; t.x = __builtin_amdgcn_rcpf(d.x); t.y = __builtin_amdgcn_rcpf(d.y);
    f32x2 q = t * 0.5307027145f + (-0.7265760135f); q = q * t + 0.7107068705f; q = q * t + (-0.142248368f); q = q * t + 0.127414796f; q = q * t;
    const f32x2 s = (v * v) * (-0.72134752044f);
    f32x2 e; e.x = __builtin_amdgcn_exp2f(s.x); e.y = __builtin_amdgcn_exp2f(s.y);
    const f32x2 m = v * (q * e), r = v - m;
    f32x2 o; o.x = v.x < 0.f ? m.x : r.x; o.y = v.y < 0.f ? m.y : r.y; return o;
}

struct EpiF32 {
    static constexpr bool PERM = false, AFTER_DRAIN = false, HOOK = false;
    float* C; int ldc; const float* bias;
    __device__ __forceinline__ void operator()(const f32x4 (&acc)[2][2][4][2], const Unit& u, int wr, int wc, int fr, int fq) const {
        const int row0 = u.pm * BM + wr * 64 + fr, col0 = u.pn * BM + wc * 32 + 4 * fq;
        f32x4 bv[2][2];
#pragma unroll
        for (int bj = 0; bj < 2; ++bj)
#pragma unroll
            for (int n = 0; n < 2; ++n) bv[bj][n] = bias ? *(const f32x4*)(bias + col0 + bj * HALF + n * 16) : (f32x4){0.f, 0.f, 0.f, 0.f};
#pragma unroll
        for (int ai = 0; ai < 2; ++ai)
#pragma unroll
            for (int m = 0; m < 4; ++m) { float* rowp = C + (size_t)(row0 + ai * HALF + m * 16) * ldc + col0;
#pragma unroll
                for (int bj = 0; bj < 2; ++bj)
#pragma unroll
                    for (int n = 0; n < 2; ++n) *(f32x4*)(rowp + bj * HALF + n * 16) = acc[ai][bj][m][n] + bv[bj][n]; }
    }
};
template <int ACT  > struct EpiBf16 {
    static constexpr bool PERM = true, AFTER_DRAIN = false;
    bf16_t* O; int ldc; const float* bias; int split_cols; size_t split_stride;
    __device__ __forceinline__ void operator()(const f32x4 (&acc)[2][2][4][2], const Unit& u, int wr, int wc, int fr, int fq) const {
        const int row0 = u.pm * BM + wr * 64 + fr; int colt = u.pn * BM; bf16_t* base = O;
        if (split_cols) { const int t = colt / split_cols; base += (size_t)t * split_stride; colt -= t * split_cols; }
        const int col0 = colt + wc * 32 + 8 * fq, bcol0 = u.pn * BM + wc * 32 + 8 * fq;
        f32x4 bv[2][2];
#pragma unroll
        for (int bj = 0; bj < 2; ++bj)
#pragma unroll
            for (int n = 0; n < 2; ++n) bv[bj][n] = bias ? *(const f32x4*)(bias + bcol0 + bj * HALF + 4 * n) : (f32x4){0.f, 0.f, 0.f, 0.f};
#pragma unroll
        for (int ai = 0; ai < 2; ++ai)
#pragma unroll
            for (int m = 0; m < 4; ++m) { bf16_t* rowp = base + (size_t)(row0 + ai * HALF + m * 16) * ldc + col0;
#pragma unroll
                for (int bj = 0; bj < 2; ++bj) { f32x4 v0 = acc[ai][bj][m][0] + bv[bj][0], v1 = acc[ai][bj][m][1] + bv[bj][1];
                    if (ACT == 1) { f32x2 a = gelu_pk((f32x2){v0[0], v0[1]}), b = gelu_pk((f32x2){v0[2], v0[3]}), c = gelu_pk((f32x2){v1[0], v1[1]}), d = gelu_pk((f32x2){v1[2], v1[3]});
                        v0 = (f32x4){a.x, a.y, b.x, b.y}; v1 = (f32x4){c.x, c.y, d.x, d.y}; }
                    if (ACT == 2) {
#pragma unroll
                        for (int j = 0; j < 4; ++j) { v0[j] = 0.5f * v0[j] * (1.0f + erff(v0[j] * 0.70710678f)); v1[j] = 0.5f * v1[j] * (1.0f + erff(v1[j] * 0.70710678f)); } }
                    u32x4 w; w.x = cvt_pk_bf16(v0[0], v0[1]); w.y = cvt_pk_bf16(v0[2], v0[3]); w.z = cvt_pk_bf16(v1[0], v1[1]); w.w = cvt_pk_bf16(v1[2], v1[3]);
                    *(u32x4*)(rowp + bj * HALF) = w; } }
    }
};

struct PanelStats {
    unsigned* xbuf;
    unsigned* cnt;
    unsigned* tmo;
    int ntn; float eps;
    unsigned code;
    __device__ __forceinline__ bool run(const f32x4 (&v)[2][2][4][2], const Unit& u, int wr, int wc, int fr, int fq, PG8_LAS unsigned char* lds, int wid, int lane) const {
        typedef float f32x2v __attribute__((ext_vector_type(2)));
        PG8_LAS f32x2v* P = (PG8_LAS f32x2v*)lds;
        PG8_LAS f32x2v* S = (PG8_LAS f32x2v*)(lds + 8192);
        PG8_LAS unsigned* flag = (PG8_LAS unsigned*)(lds + 8192 + 2048);
#pragma unroll
        for (int ai = 0; ai < 2; ++ai)
#pragma unroll
            for (int m = 0; m < 4; ++m) {
                float s = 0.f;
#pragma unroll
                for (int bj = 0; bj < 2; ++bj)
#pragma unroll
                    for (int n = 0; n < 2; ++n) { const f32x4 x = v[ai][bj][m][n]; s += (x[0] + x[1]) + (x[2] + x[3]); }
                s += __shfl_xor(s, 16); s += __shfl_xor(s, 32);
                const float mw = s * (1.0f / 64.0f); float q = 0.f;
#pragma unroll
                for (int bj = 0; bj < 2; ++bj)
#pragma unroll
                    for (int n = 0; n < 2; ++n) { const f32x4 d = v[ai][bj][m][n] - mw; q += (d[0] * d[0] + d[1] * d[1]) + (d[2] * d[2] + d[3] * d[3]); }
                q += __shfl_xor(q, 16); q += __shfl_xor(q, 32);
                if (fq == 0) P[(ai * HALF + wr * 64 + m * 16 + fr) * 4 + wc] = (f32x2v){mw, q};
            }
        asm volatile("s_waitcnt lgkmcnt(0)" ::: "memory"); __builtin_amdgcn_s_barrier(); asm volatile("" ::: "memory");
#if defined(BROKEN_NO_WAIT)
        if (blockIdx.x >= 64) { const long long t0 = clock64(); while (clock64() - t0 < 60000) __builtin_amdgcn_s_sleep(8); }
#endif
        const int row = wid * 32 + (lane & 31);
        if (lane < 32) {
            const f32x2v a = P[row * 4 + 0], b = P[row * 4 + 1], c = P[row * 4 + 2], d = P[row * 4 + 3];
            const float mt = (a.x + b.x + c.x + d.x) * 0.25f;
            const float da = a.x - mt, db = b.x - mt, dc = c.x - mt, dd = d.x - mt;
            const float m2 = (a.y + b.y) + (c.y + d.y) + 64.0f * ((da * da + db * db) + (dc * dc + dd * dd));
            unsigned long long* slot = (unsigned long long*)xbuf + ((size_t)(u.pm * BM + row) * 4 + u.pn);
            __hip_atomic_store(slot, ((unsigned long long)__float_as_uint(m2) << 32) | __float_as_uint(mt), __ATOMIC_RELAXED, __HIP_MEMORY_SCOPE_AGENT);
        }
        asm volatile("s_waitcnt vmcnt(0)" ::: "memory");
        if (lane == 0) __hip_atomic_fetch_add(cnt + 64 * u.pm, 1u, __ATOMIC_RELAXED, __HIP_MEMORY_SCOPE_AGENT);
        if (wid == 0) {
            bool dead = false; const unsigned long long t0 = __builtin_amdgcn_s_memrealtime(); const unsigned want = 8u * (unsigned)ntn;
            for (;;) {
#if defined(BROKEN_NO_WAIT)
                break;
#endif
                if ((unsigned)__builtin_amdgcn_readfirstlane(__hip_atomic_load(cnt + 64 * u.pm, __ATOMIC_RELAXED, __HIP_MEMORY_SCOPE_AGENT)) >= want) break;
                if (__builtin_amdgcn_s_memrealtime() - t0 > 2000000ull) {
                    if (lane == 0) { unsigned expect = 0u; __hip_atomic_compare_exchange_strong(tmo + 1, &expect, code | (unsigned)(u.pm & 0xff), __ATOMIC_RELAXED, __ATOMIC_RELAXED, __HIP_MEMORY_SCOPE_AGENT);
                                     __hip_atomic_store(tmo, 1u, __ATOMIC_RELAXED, __HIP_MEMORY_SCOPE_AGENT); }
                    dead = true; break; }
                __builtin_amdgcn_s_sleep(2);
            }
            __builtin_amdgcn_fence(__ATOMIC_ACQUIRE, "agent");
            if (lane == 0) flag[0] = dead ? 1u : 0u;
        }
        asm volatile("s_waitcnt vmcnt(0) lgkmcnt(0)" ::: "memory"); __builtin_amdgcn_s_barrier(); asm volatile("" ::: "memory");
        const bool bad = flag[0] != 0u;
        if (lane < 32) {
            const unsigned long long* slot = (const unsigned long long*)xbuf + (size_t)(u.pm * BM + row) * 4; float mt[4], m2[4]; float ms = 0.f;
#pragma unroll
            for (int t = 0; t < 4; ++t) { if (t < ntn) { const unsigned long long w = __hip_atomic_load(slot + t, __ATOMIC_RELAXED, __HIP_MEMORY_SCOPE_AGENT); mt[t] = __uint_as_float((unsigned)w); m2[t] = __uint_as_float((unsigned)(w >> 32)); } else { mt[t] = 0.f; m2[t] = 0.f; } ms += mt[t]; }
            const float mean = ms / (float)ntn; float q = 0.f;
#pragma unroll
            for (int t = 0; t < 4; ++t) if (t < ntn) { const float dm = mt[t] - mean; q += m2[t] + 256.0f * dm * dm; }
            S[row] = (f32x2v){mean, 1.0f / sqrtf(q / (256.0f * (float)ntn) + eps)};
        }
        asm volatile("s_waitcnt lgkmcnt(0)" ::: "memory"); __builtin_amdgcn_s_barrier(); asm volatile("" ::: "memory");
        return bad;
    }
};
struct EpiLnRes {
    static constexpr bool PERM = false, AFTER_DRAIN = true;
    const float* base; float* out; int ldc; const float* bias; PanelStats st; unsigned poison;
    __device__ __forceinline__ void refuse(size_t i0, size_t stride, int M, int N) const { const float q = __builtin_nanf(""); for (size_t i = i0; i < (size_t)M * N; i += stride) out[(i / N) * ldc + i % N] = q;
        if (i0 == 0) { unsigned expect = 0u; __hip_atomic_compare_exchange_strong(st.tmo + 1, &expect, 0x7f0u, __ATOMIC_RELAXED, __ATOMIC_RELAXED, __HIP_MEMORY_SCOPE_AGENT); __hip_atomic_store(st.tmo, 1u, __ATOMIC_RELAXED, __HIP_MEMORY_SCOPE_AGENT); } }
    __device__ __forceinline__ void fused(f32x4 (&acc)[2][2][4][2], const Unit& u, int wr, int wc, int fr, int fq, PG8_LAS unsigned char* lds, int wid, int lane) const {
        typedef float f32x2v __attribute__((ext_vector_type(2)));
        const PG8_LAS f32x2v* S = (const PG8_LAS f32x2v*)(lds + 8192);
        const int col0 = u.pn * BM + wc * 32 + 4 * fq;
#pragma unroll
        for (int bj = 0; bj < 2; ++bj)
#pragma unroll
            for (int n = 0; n < 2; ++n) { const f32x4 bv = bias ? *(const f32x4*)(bias + col0 + bj * HALF + n * 16) : (f32x4){0.f, 0.f, 0.f, 0.f};
#pragma unroll
                for (int ai = 0; ai < 2; ++ai)
#pragma unroll
                    for (int m = 0; m < 4; ++m) acc[ai][bj][m][n] += bv; }
        const bool bad = st.run(acc, u, wr, wc, fr, fq, lds, wid, lane) || poison != 0u;
        const float qnan = __builtin_nanf("");
#pragma unroll
        for (int ai = 0; ai < 2; ++ai)
#pragma unroll
            for (int m = 0; m < 4; ++m) { const int r = ai * HALF + wr * 64 + m * 16 + fr; const f32x2v sr = S[r]; const size_t off = (size_t)(u.pm * BM + r) * ldc + col0;
#pragma unroll
                for (int bj = 0; bj < 2; ++bj)
#pragma unroll
                    for (int n = 0; n < 2; ++n) { const f32x4 bs = *(const f32x4*)(base + off + bj * HALF + n * 16); f32x4 o = bs + (acc[ai][bj][m][n] - sr.x) * sr.y;
                        if (bad) o = (f32x4){qnan, qnan, qnan, qnan}; *(f32x4*)(out + off + bj * HALF + n * 16) = o; }
                asm volatile("" ::: "memory"); }
    }
};
struct EpiLnResLn {
    static constexpr bool PERM = false, AFTER_DRAIN = true;
    const float* base; float* out; bf16_t* xn; int ldc; const float* bias; PanelStats st1, st2; unsigned poison;
    __device__ __forceinline__ void refuse(size_t i0, size_t stride, int M, int N) const { const float q = __builtin_nanf(""); for (size_t i = i0; i < (size_t)M * N; i += stride) { const size_t o = (i / N) * ldc + i % N; out[o] = q; xn[o] = (bf16_t)0x7fc0u; }
        if (i0 == 0) { unsigned expect = 0u; __hip_atomic_compare_exchange_strong(st1.tmo + 1, &expect, 0x7f0u, __ATOMIC_RELAXED, __ATOMIC_RELAXED, __HIP_MEMORY_SCOPE_AGENT); __hip_atomic_store(st1.tmo, 1u, __ATOMIC_RELAXED, __HIP_MEMORY_SCOPE_AGENT); } }
    __device__ __forceinline__ void fused(f32x4 (&acc)[2][2][4][2], const Unit& u, int wr, int wc, int fr, int fq, PG8_LAS unsigned char* lds, int wid, int lane) const {
        typedef float f32x2v __attribute__((ext_vector_type(2))); typedef unsigned u32x2v __attribute__((ext_vector_type(2)));
        const PG8_LAS f32x2v* S = (const PG8_LAS f32x2v*)(lds + 8192);
        const int col0 = u.pn * BM + wc * 32 + 4 * fq;
#pragma unroll
        for (int bj = 0; bj < 2; ++bj)
#pragma unroll
            for (int n = 0; n < 2; ++n) { const f32x4 bv = bias ? *(const f32x4*)(bias + col0 + bj * HALF + n * 16) : (f32x4){0.f, 0.f, 0.f, 0.f};
#pragma unroll
                for (int ai = 0; ai < 2; ++ai)
#pragma unroll
                    for (int m = 0; m < 4; ++m) acc[ai][bj][m][n] += bv; }
        bool bad = st1.run(acc, u, wr, wc, fr, fq, lds, wid, lane) || poison != 0u;
        const float qnan = __builtin_nanf("");
#pragma unroll
        for (int ai = 0; ai < 2; ++ai)
#pragma unroll
            for (int m = 0; m < 4; ++m) { const int r = ai * HALF + wr * 64 + m * 16 + fr; const f32x2v sr = S[r]; const size_t off = (size_t)(u.pm * BM + r) * ldc + col0;
#pragma unroll
                for (int bj = 0; bj < 2; ++bj)
#pragma unroll
                    for (int n = 0; n < 2; ++n) { const f32x4 bs = *(const f32x4*)(base + off + bj * HALF + n * 16); acc[ai][bj][m][n] = bs + (acc[ai][bj][m][n] - sr.x) * sr.y; }
                asm volatile("" : "+v"(acc[ai][0][m][0]), "+v"(acc[ai][0][m][1]), "+v"(acc[ai][1][m][0]), "+v"(acc[ai][1][m][1]));
                if (m & 1) asm volatile("" ::: "memory"); }
        const bool bad1 = bad;
        bad = st2.run(acc, u, wr, wc, fr, fq, lds, wid, lane) || bad;
#pragma unroll
        for (int ai = 0; ai < 2; ++ai)
#pragma unroll
            for (int m = 0; m < 4; ++m) { const int r = ai * HALF + wr * 64 + m * 16 + fr; const f32x2v sr = S[r]; const size_t off = (size_t)(u.pm * BM + r) * ldc + col0;
#pragma unroll
                for (int bj = 0; bj < 2; ++bj)
#pragma unroll
                    for (int n = 0; n < 2; ++n) { const f32x4 x1 = acc[ai][bj][m][n]; *(f32x4*)(out + off + bj * HALF + n * 16) = bad1 ? (f32x4){qnan, qnan, qnan, qnan} : x1;
                        const f32x4 o = (x1 - sr.x) * sr.y; u32x2v w; w.x = cvt_pk_bf16(o[0], o[1]); w.y = cvt_pk_bf16(o[2], o[3]);
                        if (bad) { w.x = 0x7fc07fc0u; w.y = 0x7fc07fc0u; } *(u32x2v*)(xn + off + bj * HALF + n * 16) = w; }
                asm volatile("" ::: "memory"); }
    }
};

typedef int pg8_v8i __attribute__((ext_vector_type(8)));
typedef int pg8_v4i __attribute__((ext_vector_type(4)));
__device__ __forceinline__ pg8_v8i cat32(const bf16x8 lo, const bf16x8 hi) { return __builtin_shufflevector(__builtin_bit_cast(pg8_v4i, lo), __builtin_bit_cast(pg8_v4i, hi), 0, 1, 2, 3, 4, 5, 6, 7); }
template <class Epi, class Sched, bool STAMP = false, bool FP8 = false>
__device__ __forceinline__ void gemm_phase(PG8_LAS unsigned char* lds, const Gemm g, const Sched& S, const Epi& E, unsigned long long* stamps) {
    int tid_opaque = threadIdx.x; asm volatile("" : "+v"(tid_opaque));
    const int tid = tid_opaque, wid = __builtin_amdgcn_readfirstlane(tid >> 6), lane = tid & 63, wr = wid >> 2, wc = wid & 3, fr = lane & 15, fq = lane >> 4;
    const int K = g.K, nt = K / BK;
    int ts_lo = 0, ts_hi = 0, nts = 0; const unsigned long long rt_entry = STAMP ? (unsigned long long)wall_clock64() : 0ull;
#define PG8_STAMP() do { if (STAMP && wid == 0 && nts < 64) { const unsigned long long _c = (unsigned long long)clock64(); \
        ts_lo = (lane == nts) ? (int)(unsigned)_c : ts_lo; ts_hi = (lane == nts) ? (int)(unsigned)(_c >> 32) : ts_hi; ++nts; } } while (0)
    PG8_STAMP();
    unsigned voffA[2], voffB[2];
#pragma unroll
    for (int i = 0; i < 2; ++i) { int R, C; stage_rc(tid * 16 + i * 8192, R, C); const int Rb = (int)Epi::PERM == 2 ? (64 * (R >> 5) + perm32b(R & 31)) : Epi::PERM ? (64 * (R >> 5) + perm32(R & 31)) : R;
        voffA[i] = (unsigned)(R * K + C) * 2u; voffB[i] = (unsigned)(Rb * K + C) * 2u; }
    const size_t kstep = (size_t)(BK * 2);
    const size_t hstep = (size_t)HALF * K * 2;
    const size_t tstep = 2 * hstep;
    const size_t hstepB = (int)Epi::PERM == 2 ? (size_t)8 * K * 2 : Epi::PERM ? (size_t)32 * K * 2 : hstep;
    const unsigned ldsw = (unsigned)wid * 1024u;
    const int aoff = lds_byte(wr * 64 + fr, fq * 8), boff = lds_byte(wc * 32 + fr, fq * 8);
#define PG8_SA(b, h) (((b) * 2 + (h)) * HTB)
#define PG8_SB(b, h) ((4 + (b) * 2 + (h)) * HTB)
#define PG8_STAGE(bufoff, gbase, voff) do { _Pragma("unroll") for (int _i = 0; _i < 2; ++_i) \
        __builtin_amdgcn_global_load_lds((const unsigned*)((const char*)(gbase) + (voff)[_i]), (PG8_LAS unsigned*)(lds + (bufoff) + ldsw + _i * 8192), 16, 0, 0); } while (0)
#define PG8_LDA(dst, b, h) do { _Pragma("unroll") for (int m = 0; m < 4; ++m) _Pragma("unroll") for (int k = 0; k < 2; ++k) dst[m][k] = *(const PG8_LAS bf16x8*)(lds + PG8_SA(b, h) + aoff + m * 2048 + k * 1024); } while (0)
#define PG8_LDB(dst, b, h) do { _Pragma("unroll") for (int n = 0; n < 2; ++n) _Pragma("unroll") for (int k = 0; k < 2; ++k) dst[n][k] = *(const PG8_LAS bf16x8*)(lds + PG8_SB(b, h) + boff + n * 2048 + k * 1024); } while (0)
#define PG8_MMA(ai, bj, At, Bt) do { __builtin_amdgcn_s_setprio(1); _Pragma("unroll") for (int m = 0; m < 4; ++m) _Pragma("unroll") for (int n = 0; n < 2; ++n) { \
        if constexpr (FP8) { const pg8_v8i b8_ = cat32(Bt[n][0], Bt[n][1]), a8_ = cat32(At[m][0], At[m][1]); asm volatile("v_mfma_f32_16x16x128_f8f6f4 %0, %1, %2, %0" : "+v"(acc[ai][bj][m][n]) : "v"(b8_), "v"(a8_)); }   \
        else { _Pragma("unroll") for (int k = 0; k < 2; ++k) acc[ai][bj][m][n] = __builtin_amdgcn_mfma_f32_16x16x32_bf16(Bt[n][k], At[m][k], acc[ai][bj][m][n], 0, 0, 0); } } \
        __builtin_amdgcn_s_setprio(0); } while (0)
#define PG8_WAIT_V(n) asm volatile("s_waitcnt vmcnt(" #n ")" ::: "memory")
#define PG8_WAIT_L(n) asm volatile("s_waitcnt lgkmcnt(" #n ")" ::: "memory")
#define PG8_BAR __builtin_amdgcn_s_barrier()
#define PG8_SCHED __builtin_amdgcn_sched_barrier(0)
    Unit cur, nxt; int ui = 0;
    if (!S.next(0, cur)) return;
    f32x4 acc[2][2][4][2];
#pragma unroll
    for (int a = 0; a < 2; ++a)
#pragma unroll
        for (int b = 0; b < 2; ++b)
#pragma unroll
            for (int m = 0; m < 4; ++m)
#pragma unroll
                for (int n = 0; n < 2; ++n) acc[a][b][m][n] = (f32x4){0.f, 0.f, 0.f, 0.f};
    bf16x8 At[4][2], B0[2][2], B1[2][2];
    const char* cA = (const char*)g.A + (size_t)cur.pm * tstep; const char* cB = (const char*)g.Bt + (size_t)cur.pn * tstep;
    const unsigned long long ga64_ = (unsigned long long)g.A, gb64_ = (unsigned long long)g.Bt;
    const char* gA_ = (const char*)(((unsigned long long)(unsigned)__builtin_amdgcn_readfirstlane((int)(unsigned)(ga64_ >> 32)) << 32) | (unsigned)__builtin_amdgcn_readfirstlane((int)(unsigned)ga64_));
    const char* gB_ = (const char*)(((unsigned long long)(unsigned)__builtin_amdgcn_readfirstlane((int)(unsigned)(gb64_ >> 32)) << 32) | (unsigned)__builtin_amdgcn_readfirstlane((int)(unsigned)gb64_));
    S.a_ready(cur);
    PG8_STAGE(PG8_SB(0, 0), cB, voffB); PG8_STAGE(PG8_SA(0, 0), cA, voffA); PG8_STAGE(PG8_SB(0, 1), cB + hstepB, voffB); PG8_STAGE(PG8_SA(0, 1), cA + hstep, voffA);
    if (wr == 1) PG8_BAR;
    PG8_WAIT_V(4); PG8_BAR;
    PG8_STAGE(PG8_SB(1, 0), cB + kstep, voffB); PG8_STAGE(PG8_SA(1, 0), cA + kstep, voffA); PG8_STAGE(PG8_SB(1, 1), cB + hstepB + kstep, voffB);
    PG8_WAIT_V(6); PG8_BAR;
    PG8_STAMP();
    for (;;) {
        const bool has_next = S.next(ui + 1, nxt);
        const char* nA = has_next ? gA_ + (size_t)nxt.pm * tstep : cA; const char* nB = has_next ? gB_ + (size_t)nxt.pn * tstep : cB;
        for (int t = 0; t < nt; t += 2) {
            if constexpr (Epi::HOOK) { if (t == Epi::H0 || t == Epi::H1) E.hook(acc, cur, t, wr, wc, fr, fq); }
            const bool last = (t == nt - 2);
            const char* a1 = cA + (size_t)(t + 1) * kstep;
            const char* a2 = last ? nA : cA + (size_t)(t + 2) * kstep; const char* b2 = last ? nB : cB + (size_t)(t + 2) * kstep;
            const char* a3 = a2 + kstep; const char* b3 = b2 + kstep;
            if (last && has_next) S.a_ready(nxt);
            PG8_LDB(B0, 0, 0); PG8_SCHED; PG8_LDA(At, 0, 0); PG8_STAGE(PG8_SA(1, 1), a1 + hstep, voffA);
            PG8_WAIT_L(8); PG8_BAR; PG8_WAIT_L(0); PG8_MMA(0, 0, At, B0); PG8_BAR; PG8_SCHED;
            PG8_LDB(B1, 0, 1); PG8_STAGE(PG8_SB(0, 0), b2, voffB);
            PG8_BAR; PG8_WAIT_L(0); PG8_MMA(0, 1, At, B1); PG8_BAR;
            PG8_LDA(At, 0, 1); PG8_STAGE(PG8_SA(0, 0), a2, voffA);
            PG8_BAR; PG8_WAIT_L(0); PG8_MMA(1, 0, At, B0); PG8_BAR; PG8_SCHED;
            PG8_STAGE(PG8_SB(0, 1), b2 + hstepB, voffB);
            PG8_WAIT_V(6); PG8_BAR; PG8_MMA(1, 1, At, B1); PG8_BAR;
            PG8_LDB(B0, 1, 0); PG8_SCHED; PG8_LDA(At, 1, 0); PG8_STAGE(PG8_SA(0, 1), a2 + hstep, voffA);
            PG8_WAIT_L(8); PG8_BAR; PG8_WAIT_L(0); PG8_MMA(0, 0, At, B0); PG8_BAR; PG8_SCHED;
            PG8_LDB(B1, 1, 1); PG8_STAGE(PG8_SB(1, 0), b3, voffB);
            PG8_BAR; PG8_WAIT_L(0); PG8_MMA(0, 1, At, B1); PG8_BAR;
            PG8_LDA(At, 1, 1); PG8_STAGE(PG8_SA(1, 0), a3, voffA);
            PG8_BAR; PG8_WAIT_L(0); PG8_MMA(1, 0, At, B0); PG8_BAR; PG8_SCHED;
            PG8_STAGE(PG8_SB(1, 1), b3 + hstepB, voffB);
            PG8_WAIT_V(6); PG8_BAR; PG8_MMA(1, 1, At, B1); PG8_BAR;
        }
        PG8_STAMP();
        if constexpr (!Epi::AFTER_DRAIN) { E(acc, cur, wr, wc, fr, fq); S.done(cur); }
        PG8_STAMP();
        if (!has_next) break;
#pragma unroll
        for (int a = 0; a < 2; ++a)
#pragma unroll
            for (int b = 0; b < 2; ++b)
#pragma unroll
                for (int m = 0; m < 4; ++m)
#pragma unroll
                    for (int n = 0; n < 2; ++n) acc[a][b][m][n] = (f32x4){0.f, 0.f, 0.f, 0.f};
        cur = nxt; cA = nA; cB = nB; ++ui;
    }
    PG8_WAIT_V(0);
    if (wr == 0) PG8_BAR;
    PG8_BAR;
    if constexpr (Epi::AFTER_DRAIN) { E.fused(acc, cur, wr, wc, fr, fq, lds, wid, lane); S.done(cur); }
    PG8_STAMP();
    if (STAMP && wid == 0) { stamps[lane] = lane < nts ? (((unsigned long long)(unsigned)ts_hi << 32) | (unsigned)ts_lo) : 0ull;
        if (lane == 62) stamps[62] = rt_entry; if (lane == 63) stamps[63] = (unsigned long long)wall_clock64(); }
#undef PG8_STAMP
#undef PG8_SA
#undef PG8_SB
#undef PG8_STAGE
#undef PG8_LDA
#undef PG8_LDB
#undef PG8_MMA
#undef PG8_WAIT_V
#undef PG8_WAIT_L
#undef PG8_BAR
#undef PG8_SCHED
}
}
#ifndef BG_TABLES0
#define BG_TABLES0 1
#endif
#ifndef BG_TABLES
#define BG_TABLES 1
#endif
#ifndef PROBE_DUP
#define PROBE_DUP 0
#endif
#ifndef BR8
#define BR8 0
#endif
#ifndef G1_NBF
#define G1_NBF 3072
#endif

namespace mk {
using pg8::bf16_t; using pg8::f32x4; using pg8::u32x4; using pg8::Unit; using pg8::f32x2;
#define LAS __attribute__((address_space(3)))
#define GAS __attribute__((address_space(1)))
typedef unsigned u32x2 __attribute__((ext_vector_type(2)));

constexpr int NWAVES = 8, NTHR = 512;
constexpr int T = 16384, D = 2048, SEQ = 2048, DEPTH = 2, INW = 13824, NEXP = 16384;
constexpr float EPS = 1e-6f;
constexpr size_t MiB = 1u << 20;
constexpr size_t WS_CTL = 0, CTL_ZERO_BYTES = 1 * MiB;
constexpr size_t WS_WIN = 1 * MiB;
constexpr size_t WS_WA = 55 * MiB;
constexpr size_t WS_WB = 59 * MiB;
constexpr size_t WS_WC = 63 * MiB;
constexpr size_t WS_WOUT = 65 * MiB;
constexpr size_t WS_WSC = 73 * MiB;
constexpr size_t WS_WM = 81 * MiB;
constexpr size_t WS_WP = 82 * MiB;
constexpr size_t WS_U = 83 * MiB;
constexpr size_t WS_V = 211 * MiB;
constexpr size_t WS_XB = 339 * MiB;
constexpr size_t WS_RSTD = 403 * MiB;
constexpr size_t WS_PA = 404 * MiB;
constexpr size_t WS_PB = 468 * MiB;
constexpr size_t WS_PQKV = 500 * MiB;
constexpr size_t WS_PG = 644 * MiB;
constexpr size_t WS_YA = 836 * MiB;
constexpr size_t WS_YB = 868 * MiB;
constexpr size_t WS_YC = 900 * MiB;
constexpr size_t WS_OG = 916 * MiB;
constexpr size_t WS_LSE = 964 * MiB;
constexpr size_t WS_XB8 = 147 * MiB;
constexpr size_t WS_WIN8 = 179 * MiB;
constexpr size_t WS_XH4 = 243 * MiB;
constexpr size_t WS_XL4 = 259 * MiB;
constexpr size_t WS_EXG = 965 * MiB;
constexpr size_t WS_CVG = 973 * MiB;
constexpr size_t WS_END = 981 * MiB;
constexpr int CW_BAR = 4096;
#ifndef PEER_FP4
#define PEER_FP4 1
#endif
constexpr float SCALE_U4 = 90.5f, SCALE_V4 = 5.657f;

constexpr int RING_BYTES = 131072, LDS_BYTES = 163840, TOP_OFF = LDS_BYTES - 1024, MISC_OFF = TOP_OFF + 320;

__constant__ unsigned char kBucket[3 * 129] = {
0,1,2,3,4,5,6,7,8,9,10,11,12,13,14,15,16,16,16,16,16,16,17,17,17,17,17,17,17,17,18,18,18,18,18,18,18,18,18,18,19,19,19,19,19,19,19,19,19,19,19,19,19,19,20,20,20,20,20,20,20,20,20,20,20,20,20,20,20,20,20,20,20,21,21,21,21,21,21,21,21,21,21,21,21,21,21,21,21,21,21,21,21,21,21,21,21,21,21,22,22,22,22,22,22,22,22,22,22,22,22,22,22,22,22,22,22,22,22,22,22,22,22,22,22,22,22,22,22,
0,4,8,12,16,16,17,17,18,18,19,19,19,19,20,20,20,20,20,21,21,21,21,21,21,22,22,22,22,22,22,22,22,22,23,23,23,23,23,23,23,23,23,23,23,23,24,24,24,24,24,24,24,24,24,24,24,24,24,24,24,24,25,25,25,25,25,25,25,25,25,25,25,25,25,25,25,25,25,25,25,25,25,26,26,26,26,26,26,26,26,26,26,26,26,26,26,26,26,26,26,26,26,26,26,26,26,26,26,26,26,26,26,27,27,27,27,27,27,27,27,27,27,27,27,27,27,27,27,
0,16,18,19,20,21,21,22,22,23,23,23,24,24,24,24,25,25,25,25,25,26,26,26,26,26,26,26,26,27,27,27,27,27,27,27,27,27,27,28,28,28,28,28,28,28,28,28,28,28,28,28,29,29,29,29,29,29,29,29,29,29,29,29,29,29,29,29,29,29,30,30,30,30,30,30,30,30,30,30,30,30,30,30,30,30,30,30,30,30,30,30,30,30,30,31,31,31,31,31,31,31,31,31,31,31,31,31,31,31,31,31,31,31,31,31,31,31,31,31,31,31,31,31,31,31,31,31,31};

__device__ __forceinline__ float bflo(unsigned w) { return __uint_as_float(w << 16); }
__device__ __forceinline__ float bfhi(unsigned w) { return __uint_as_float(w & 0xffff0000u); }
__device__ __forceinline__ float bf2f(bf16_t b) { return __uint_as_float(((unsigned)b) << 16); }
__device__ __forceinline__ unsigned f2bf(float f) { unsigned u = __float_as_uint(f); return (u + 0x7fffu + ((u >> 16) & 1u)) >> 16; }
typedef __bf16 bf16x2_t __attribute__((ext_vector_type(2)));
__device__ __forceinline__ unsigned pk2(float lo, float hi) { return __builtin_bit_cast(unsigned, __builtin_convertvector((f32x2){lo, hi}, bf16x2_t)); }
__device__ __forceinline__ unsigned pk2s(float lo, float hi) { return pk2(lo, hi); }
typedef int v2i_t __attribute__((ext_vector_type(2)));
typedef float f32x16 __attribute__((ext_vector_type(16)));
constexpr float Y8S = 8.0f;
__device__ __forceinline__ unsigned pk4_fp8(float a, float b, float c, float d) {
    int pk = 0;
    pk = __builtin_amdgcn_cvt_pk_fp8_f32(__builtin_amdgcn_fmed3f(a, -448.f, 448.f), __builtin_amdgcn_fmed3f(b, -448.f, 448.f), pk, false);
    pk = __builtin_amdgcn_cvt_pk_fp8_f32(__builtin_amdgcn_fmed3f(c, -448.f, 448.f), __builtin_amdgcn_fmed3f(d, -448.f, 448.f), pk, true);
    return (unsigned)pk;
}
__device__ __forceinline__ float wave_sum(float v) {
#pragma unroll
    for (int o = 1; o < 64; o <<= 1) v += __shfl_xor(v, o);
    return v;
}
__device__ __forceinline__ float wave_max(float v) {
#pragma unroll
    for (int o = 1; o < 64; o <<= 1) v = fmaxf(v, __shfl_xor(v, o));
    return v;
}
__device__ __forceinline__ float dot8(const u32x4 a, const u32x4 b) {
    return bflo(a.x) * bflo(b.x) + bfhi(a.x) * bfhi(b.x) + bflo(a.y) * bflo(b.y) + bfhi(a.y) * bfhi(b.y)
         + bflo(a.z) * bflo(b.z) + bfhi(a.z) * bfhi(b.z) + bflo(a.w) * bflo(b.w) + bfhi(a.w) * bfhi(b.w);
}
__device__ __forceinline__ float gelu_erf(float a) { return 0.5f * a * (1.0f + erff(a * 0.70710678118654752f)); }
#define LDS_WAIT() asm volatile("s_waitcnt lgkmcnt(0)" ::: "memory")
#define VM_WAIT() asm volatile("s_waitcnt vmcnt(0)" ::: "memory")

#define XB_TMO      128
#define XB_XCNT(j)  (256  + 64 * (j))
#define XB_XSUB(j)  (1280 + 64 * (j))
#define XB_XGEN(j)  (2304 + 64 * (j))
#define XB_TOP      3328
#define XB_TOPGEN   3392
#define XCD_BAR_WORDS 3456
#define XB_SPIN_CAP (1u << 18)
__device__ __forceinline__ unsigned xb_ld(unsigned* p)              { return __hip_atomic_load(p, __ATOMIC_RELAXED, __HIP_MEMORY_SCOPE_AGENT); }
__device__ __forceinline__ unsigned xb_add(unsigned* p, unsigned v) { return __hip_atomic_fetch_add(p, v, __ATOMIC_RELAXED, __HIP_MEMORY_SCOPE_AGENT); }
__device__ __forceinline__ unsigned xb_xcc_id() { return (unsigned)__builtin_amdgcn_s_getreg((3 << 11) | 20) & 0xFu; }
#define XB_SPIN(cond, bar) do { unsigned _sp = 0; while (cond) { __builtin_amdgcn_s_sleep(1); \
    if ((++_sp & 255u) == 0u) { if (xb_ld(&(bar)[XB_TMO])) break; if (_sp > XB_SPIN_CAP) { atomicAdd(&(bar)[XB_TMO], 1u); break; } } } } while (0)
struct XcdBarrier { unsigned* bar; unsigned x; volatile LAS unsigned* st; };
__device__ __forceinline__ XcdBarrier xcd_barrier_post(unsigned* bar, volatile LAS unsigned* st) {
    XcdBarrier b; b.bar = bar; b.x = xb_xcc_id(); b.st = st;
    if (threadIdx.x == 0) (void)xb_add(&bar[XB_XCNT(b.x)], 1u);
    return b;
}
__device__ __forceinline__ void xcd_barrier_complete(unsigned* bar, unsigned x, unsigned& nloc, unsigned& nx) {
    const unsigned G = gridDim.x * gridDim.y * gridDim.z;
    unsigned sum, cnt, mine, sp = 0u;
    for (;;) {
        sum = 0u; cnt = 0u; mine = 0u;
#pragma unroll
        for (unsigned j = 0; j < 16; ++j) { const unsigned c = xb_ld(&bar[XB_XCNT(j)]); sum += c; cnt += (c > 0u) ? 1u : 0u; mine = (j == x) ? c : mine; }
        if (sum == G) break;
        __builtin_amdgcn_s_sleep(1);
        if ((++sp & 255u) == 0u) { if (xb_ld(&bar[XB_TMO])) break; if (sp > XB_SPIN_CAP) { atomicAdd(&bar[XB_TMO], 1u); break; } }
    }
    nloc = mine > 0u ? mine : 1u; nx = cnt > 0u ? cnt : 1u;
}
__device__ __forceinline__ void xcd_barrier(const XcdBarrier& b) {
    asm volatile("s_waitcnt vmcnt(0)" ::: "memory");
    __syncthreads();
    if (threadIdx.x == 0) {
        unsigned* bar = b.bar;
        __builtin_amdgcn_s_waitcnt(0);
        unsigned nloc = b.st[0], nx = b.st[1];
        if (nloc == 0u) { xcd_barrier_complete(bar, b.x, nloc, nx); b.st[0] = nloc; b.st[1] = nx; }
        const unsigned old = xb_add(&bar[XB_XSUB(b.x)], 1u);
        const unsigned gen = old / nloc;
        if (old + 1u == (gen + 1u) * nloc) {
            __builtin_amdgcn_fence(__ATOMIC_RELEASE, "agent");
            asm volatile("s_waitcnt vmcnt(0)" ::: "memory");
            const unsigned og = xb_add(&bar[XB_TOP], 1u);
            const unsigned tg = og / nx;
            if (og + 1u == (tg + 1u) * nx) xb_add(&bar[XB_TOPGEN], 1u);
            else XB_SPIN(xb_ld(&bar[XB_TOPGEN]) == tg, bar);
            __builtin_amdgcn_fence(__ATOMIC_ACQUIRE, "agent");
            xb_add(&bar[XB_XGEN(b.x)], 1u);
            asm volatile("s_waitcnt vmcnt(0)" ::: "memory");
        } else {
            XB_SPIN(xb_ld(&bar[XB_XGEN(b.x)]) == gen, bar);
            __builtin_amdgcn_fence(__ATOMIC_ACQUIRE, "agent");
            asm volatile("s_waitcnt vmcnt(0)" ::: "memory");
        }
    }
    __syncthreads();
}

#define EPI_STEP(m) (((m) == 3) ? (128 - 48) : 16)
__device__ __forceinline__ unsigned dpp_hi8(unsigned keep, unsigned src) { return (unsigned)__builtin_amdgcn_update_dpp((int)keep, (int)src, 0x128, 0xF, 0xC, false); }
__device__ __forceinline__ unsigned dpp_lo8(unsigned keep, unsigned src) { return (unsigned)__builtin_amdgcn_update_dpp((int)keep, (int)src, 0x128, 0xF, 0x3, false); }
__device__ __forceinline__ void store_rows8(GAS bf16_t* p, size_t ld8, const u32x4 x0, const u32x4 x1) {
    u32x4 s0, s1;
#pragma unroll
    for (int j = 0; j < 4; ++j) { s0[j] = dpp_hi8(x0[j], x1[j]); s1[j] = dpp_lo8(x1[j], x0[j]); }
    *(GAS u32x4*)p = s0; *(GAS u32x4*)(p + ld8) = s1;
}
__device__ __forceinline__ void store_rows8_b8(GAS unsigned char* p, size_t ld8, const u32x2 x0, const u32x2 x1) {
    u32x2 s0, s1;
#pragma unroll
    for (int j = 0; j < 2; ++j) { s0[j] = dpp_hi8(x0[j], x1[j]); s1[j] = dpp_lo8(x1[j], x0[j]); }
    *(GAS u32x2*)p = s0; *(GAS u32x2*)(p + ld8) = s1;
}
struct EpiG1 {
    static constexpr bool PERM = true, AFTER_DRAIN = false, HOOK = false;
    bf16_t *PA, *PB, *PQKV, *PG; const float* rstd; int pn_off; float scale;
    template <int ACT> __device__ __forceinline__ void body(const f32x4 (&acc)[2][2][4][2], bf16_t* base, const int ldc, const int colt, const float sc, const int rowg, int wc, int fr, int fq) const {
        GAS bf16_t* rowp = (GAS bf16_t*)(base + (size_t)(rowg + (fr & 7)) * ldc + colt + wc * 64 + ((fr >> 3) * 4 + fq) * 8);
        GAS unsigned char* rowp8 = (GAS unsigned char*)base + (size_t)(rowg + fr) * ldc + colt + wc * 64 + 8 * fq;
        const GAS float* rp = (const GAS float*)(rstd + rowg + fr);
        float rv[8];
#pragma unroll
        for (int i = 0; i < 8; ++i) rv[i] = rp[(i >> 2) * 128 + (i & 3) * 16] * sc;
#pragma unroll
        for (int ai = 0; ai < 2; ++ai)
#pragma unroll
            for (int m = 0; m < 4; ++m) {
                const float r = rv[ai * 4 + m];
                u32x4 xw[2]; u32x2 xb[2];
#pragma unroll
                for (int bj = 0; bj < 2; ++bj) { f32x4 v0 = acc[ai][bj][m][0] * r, v1 = acc[ai][bj][m][1] * r;
                    if (ACT == 1) { f32x2 a = pg8::gelu_pk((f32x2){v0[0], v0[1]}), b = pg8::gelu_pk((f32x2){v0[2], v0[3]}), c = pg8::gelu_pk((f32x2){v1[0], v1[1]}), d = pg8::gelu_pk((f32x2){v1[2], v1[3]});
                        v0 = (f32x4){a.x, a.y, b.x, b.y}; v1 = (f32x4){c.x, c.y, d.x, d.y}; }
                    if (ACT == 2) {
#pragma unroll
                        for (int j = 0; j < 4; ++j) { v0[j] = __builtin_amdgcn_rcpf(1.0f + __expf(-v0[j])); v1[j] = __builtin_amdgcn_rcpf(1.0f + __expf(-v1[j])); }
                        xb[bj].x = (unsigned)(v0[0] * 255.f + 0.5f) | ((unsigned)(v0[1] * 255.f + 0.5f) << 8) | ((unsigned)(v0[2] * 255.f + 0.5f) << 16) | ((unsigned)(v0[3] * 255.f + 0.5f) << 24);
                        xb[bj].y = (unsigned)(v1[0] * 255.f + 0.5f) | ((unsigned)(v1[1] * 255.f + 0.5f) << 8) | ((unsigned)(v1[2] * 255.f + 0.5f) << 16) | ((unsigned)(v1[3] * 255.f + 0.5f) << 24); }
                    else { xw[bj].x = pk2(v0[0], v0[1]); xw[bj].y = pk2(v0[2], v0[3]); xw[bj].z = pk2(v1[0], v1[1]); xw[bj].w = pk2(v1[2], v1[3]); } }
                if (ACT == 2) { *(GAS u32x2*)rowp8 = xb[0]; *(GAS u32x2*)(rowp8 + 32) = xb[1]; rowp8 += (size_t)EPI_STEP(m) * ldc; asm volatile("" : "+v"(rowp8)); }
                else { store_rows8(rowp, (size_t)8 * ldc, xw[0], xw[1]); rowp += (size_t)EPI_STEP(m) * ldc; asm volatile("" : "+v"(rowp)); }
            }
    }
    __device__ __forceinline__ void operator()(const f32x4 (&acc)[2][2][4][2], const Unit& u, int wr, int wc, int fr, int fq) const {
        const int pn = u.pn + pn_off, rowg = u.pm * 256 + wr * 64;
        if (pn < 8) body<1>(acc, PA, 2048, pn * 256, scale, rowg, wc, fr, fq);
        else if (pn < 12) body<0>(acc, PB, 1024, (pn - 8) * 256, scale, rowg, wc, fr, fq);
        else if (pn < 30) body<0>(acc, PQKV, 4608, (pn - 12) * 256, pn < 18 ? scale * 0.08838834764831845f : scale, rowg, wc, fr, fq);
        else body<2>(acc, PG, 6144, (pn - 30) * 256, scale, rowg, wc, fr, fq);
    }
};
struct EpiG1B {
    static constexpr int PERM = 2; static constexpr bool AFTER_DRAIN = false, HOOK = false;
    unsigned char *PQKV8, *PG; const float* rstd; int pn_off; float scale;
    template <int ACT> __device__ __forceinline__ void body(const f32x4 (&acc)[2][2][4][2], unsigned char* base, const int ldc, const int colt, const int rowg, int wc, int fr, int fq) const {
        GAS unsigned char* rowp = (GAS unsigned char*)base + (size_t)(rowg + fr) * ldc + colt + wc * 64 + 16 * fq;
        const GAS float* rp = (const GAS float*)(rstd + rowg + fr);
        float rv[8];
#pragma unroll
        for (int i = 0; i < 8; ++i) rv[i] = rp[(i >> 2) * 128 + (i & 3) * 16] * scale;
#pragma unroll
        for (int ai = 0; ai < 2; ++ai)
#pragma unroll
            for (int m = 0; m < 4; ++m) {
                const float r = rv[ai * 4 + m];
                u32x4 w;
#pragma unroll
                for (int bj = 0; bj < 2; ++bj)
#pragma unroll
                    for (int n = 0; n < 2; ++n) { f32x4 v = acc[ai][bj][m][n] * r; unsigned pk;
                        if (ACT == 2) {
#pragma unroll
                            for (int j = 0; j < 4; ++j) v[j] = __builtin_amdgcn_rcpf(1.0f + __expf(-v[j]));
                            pk = (unsigned)(v[0] * 255.f + 0.5f) | ((unsigned)(v[1] * 255.f + 0.5f) << 8) | ((unsigned)(v[2] * 255.f + 0.5f) << 16) | ((unsigned)(v[3] * 255.f + 0.5f) << 24); }
                        else pk = pk4_fp8(v[0], v[1], v[2], v[3]);
                        w[bj * 2 + n] = pk; }
                *(GAS u32x4*)rowp = w;
                rowp += (size_t)EPI_STEP(m) * ldc;
                asm volatile("" : "+v"(rowp));
            }
    }
    __device__ __forceinline__ void operator()(const f32x4 (&acc)[2][2][4][2], const Unit& u, int wr, int wc, int fr, int fq) const {
        const int pn = u.pn + pn_off, rowg = u.pm * 256 + wr * 64;
        if (pn < 30) body<3>(acc, PQKV8, 4608, (pn - 12) * 256, rowg, wc, fr, fq);
        else body<2>(acc, PG, 6144, (pn - 30) * 256, rowg, wc, fr, fq);
    }
};
template <int FIRST> struct EpiBranch {
    static constexpr bool PERM = true, AFTER_DRAIN = false, HOOK = false;
    bf16_t* MG; const bf16_t* gate;
    __device__ __forceinline__ void operator()(const f32x4 (&acc)[2][2][4][2], const Unit& u, int wr, int wc, int fr, int fq) const {
        const int row0 = u.pm * 256 + wr * 64 + fr, col0 = u.pn * 256 + wc * 32 + 8 * fq;
        const GAS bf16_t* gp = (const GAS bf16_t*)(gate + (size_t)row0 * 6144 + col0); GAS bf16_t* mp = (GAS bf16_t*)(MG + (size_t)row0 * 2048 + col0);
#pragma unroll
        for (int ai = 0; ai < 2; ++ai) {
            u32x4 g[4][2], o[4][2];
#pragma unroll
            for (int m = 0; m < 4; ++m)
#pragma unroll
                for (int bj = 0; bj < 2; ++bj) { g[m][bj] = *(const GAS u32x4*)(gp + (size_t)m * 16 * 6144 + bj * 128); if (!FIRST) o[m][bj] = *(const GAS u32x4*)(mp + (size_t)m * 16 * 2048 + bj * 128); }
#pragma unroll
            for (int m = 0; m < 4; ++m)
#pragma unroll
                for (int bj = 0; bj < 2; ++bj) { const u32x4 gg = g[m][bj];
                    f32x4 v0 = acc[ai][bj][m][0], v1 = acc[ai][bj][m][1];
                    v0[0] *= bflo(gg.x); v0[1] *= bfhi(gg.x); v0[2] *= bflo(gg.y); v0[3] *= bfhi(gg.y);
                    v1[0] *= bflo(gg.z); v1[1] *= bfhi(gg.z); v1[2] *= bflo(gg.w); v1[3] *= bfhi(gg.w);
                    if (!FIRST) { const u32x4 oo = o[m][bj];
                        v0[0] += bflo(oo.x); v0[1] += bfhi(oo.x); v0[2] += bflo(oo.y); v0[3] += bfhi(oo.y);
                        v1[0] += bflo(oo.z); v1[1] += bfhi(oo.z); v1[2] += bflo(oo.w); v1[3] += bfhi(oo.w); }
                    u32x4 w; w.x = pk2(v0[0], v0[1]); w.y = pk2(v0[2], v0[3]); w.z = pk2(v1[0], v1[1]); w.w = pk2(v1[2], v1[3]);
                    *(GAS u32x4*)(mp + (size_t)m * 16 * 2048 + bj * 128) = w; }
            gp += (size_t)128 * 6144; mp += (size_t)128 * 2048;
            asm volatile("" : "+v"(gp), "+v"(mp) :: "memory");
        }
    }
};
template <int F8> struct EpiBranchF {
    static constexpr bool PERM = true, AFTER_DRAIN = false, HOOK = true;
    static constexpr int H0 = F8 ? 8 : 16, H1 = F8 ? 16 : 32;
    static constexpr float OS = F8 ? 1.0f / (Y8S * 1024.0f) : 1.0f;
    bf16_t* MG; const unsigned char* gate;
    static __device__ __forceinline__ float gb(unsigned w, int k) { return fmaxf((float)((w >> (8 * k)) & 0xffu) * (1.0f / 255.0f), 1e-6f); }
    __device__ __forceinline__ void hook(f32x4 (&acc)[2][2][4][2], const Unit& u, int t, int wr, int wc, int fr, int fq) const {
        const int row0 = u.pm * 256 + wr * 64 + fr, col0 = u.pn * 256 + wc * 64 + 8 * fq;
        const GAS unsigned char* gp = (const GAS unsigned char*)(gate + (size_t)row0 * 6144 + col0 + (t == H0 ? 0 : 2048));
#pragma unroll
        for (int ai = 0; ai < 2; ++ai) {
            u32x2 gn[4][2], gd[4][2];
#pragma unroll
            for (int m = 0; m < 4; ++m)
#pragma unroll
                for (int bj = 0; bj < 2; ++bj) { gn[m][bj] = *(const GAS u32x2*)(gp + (size_t)m * 16 * 6144 + bj * 32); gd[m][bj] = *(const GAS u32x2*)(gp + (size_t)m * 16 * 6144 + bj * 32 + 2048); }
#pragma unroll
            for (int m = 0; m < 4; ++m)
#pragma unroll
                for (int bj = 0; bj < 2; ++bj) { const u32x2 a = gn[m][bj], d = gd[m][bj];
#pragma unroll
                    for (int k = 0; k < 4; ++k) { acc[ai][bj][m][0][k] *= gb(a.x, k) * __builtin_amdgcn_rcpf(gb(d.x, k)); acc[ai][bj][m][1][k] *= gb(a.y, k) * __builtin_amdgcn_rcpf(gb(d.y, k)); } }
            gp += (size_t)128 * 6144;
            asm volatile("" : "+v"(gp) :: "memory");
        }
    }
    __device__ __forceinline__ void operator()(const f32x4 (&acc)[2][2][4][2], const Unit& u, int wr, int wc, int fr, int fq) const {
        const int rowg = u.pm * 256 + wr * 64, col0 = u.pn * 256 + wc * 64 + 8 * fq;
        const GAS unsigned char* gp = (const GAS unsigned char*)(gate + (size_t)(rowg + fr) * 6144 + col0 + 4096);
        GAS bf16_t* mp = (GAS bf16_t*)(MG + (size_t)(rowg + (fr & 7)) * 2048 + u.pn * 256 + wc * 64 + ((fr >> 3) * 4 + fq) * 8);
#pragma unroll
        for (int ai = 0; ai < 2; ++ai) {
            u32x2 g[4][2];
#pragma unroll
            for (int m = 0; m < 4; ++m)
#pragma unroll
                for (int bj = 0; bj < 2; ++bj) g[m][bj] = *(const GAS u32x2*)(gp + (size_t)m * 16 * 6144 + bj * 32);
#pragma unroll
            for (int m = 0; m < 4; ++m) { u32x4 w[2];
#pragma unroll
                for (int bj = 0; bj < 2; ++bj) { const u32x2 gg = g[m][bj]; const f32x4 v0 = acc[ai][bj][m][0], v1 = acc[ai][bj][m][1];
                    w[bj].x = pk2(v0[0] * (gb(gg.x, 0) * OS), v0[1] * (gb(gg.x, 1) * OS)); w[bj].y = pk2(v0[2] * (gb(gg.x, 2) * OS), v0[3] * (gb(gg.x, 3) * OS));
                    w[bj].z = pk2(v1[0] * (gb(gg.y, 0) * OS), v1[1] * (gb(gg.y, 1) * OS)); w[bj].w = pk2(v1[2] * (gb(gg.y, 2) * OS), v1[3] * (gb(gg.y, 3) * OS)); }
                store_rows8(mp + (size_t)m * 16 * 2048, (size_t)8 * 2048, w[0], w[1]); }
            gp += (size_t)128 * 6144; mp += (size_t)128 * 2048;
            asm volatile("" : "+v"(gp), "+v"(mp) :: "memory");
        }
    }
};
template <int XIN_BF16> struct EpiWout {
    static constexpr bool PERM = true, AFTER_DRAIN = false, HOOK = false;
    const float* xin; float* xout; bf16_t* XB; unsigned char* XB8;
    __device__ __forceinline__ void operator()(const f32x4 (&acc)[2][2][4][2], const Unit& u, int wr, int wc, int fr, int fq) const {
        const int rowg = u.pm * 256 + wr * 64, colw = u.pn * 256 + wc * 64;
        size_t off = (size_t)(rowg + fr) * 2048 + colw + 8 * fq;
        GAS bf16_t* sp = (GAS bf16_t*)(XB + (size_t)(rowg + (fr & 7)) * 2048 + colw + ((fr >> 3) * 4 + fq) * 8);
#pragma unroll
        for (int ai = 0; ai < 2; ++ai) {
            f32x4 xv[4][2][2];
#pragma unroll
            for (int m = 0; m < 4; ++m)
#pragma unroll
                for (int bj = 0; bj < 2; ++bj) { const size_t o = off + (size_t)m * 16 * 2048 + bj * 32;
                    if (XIN_BF16) { const u32x4 wv = *(const GAS u32x4*)(XB + o); xv[m][bj][0] = (f32x4){bflo(wv.x), bfhi(wv.x), bflo(wv.y), bfhi(wv.y)}; xv[m][bj][1] = (f32x4){bflo(wv.z), bfhi(wv.z), bflo(wv.w), bfhi(wv.w)}; }
                    else { xv[m][bj][0] = *(const GAS f32x4*)(xin + o); xv[m][bj][1] = *(const GAS f32x4*)(xin + o + 4); } }
#pragma unroll
            for (int m = 0; m < 4; ++m) { u32x4 w[2];
#pragma unroll
                for (int bj = 0; bj < 2; ++bj) { const f32x4 v0 = xv[m][bj][0] + acc[ai][bj][m][0], v1 = xv[m][bj][1] + acc[ai][bj][m][1];
                    w[bj].x = pk2(v0[0], v0[1]); w[bj].y = pk2(v0[2], v0[3]); w[bj].z = pk2(v1[0], v1[1]); w[bj].w = pk2(v1[2], v1[3]); }
                store_rows8(sp + (size_t)m * 16 * 2048, (size_t)8 * 2048, w[0], w[1]); }
            off += (size_t)128 * 2048; sp += (size_t)128 * 2048;
            asm volatile("" : "+v"(off), "+v"(sp) :: "memory");
        }
    }
};
struct EpiF32 {
    static constexpr bool PERM = false, AFTER_DRAIN = false, HOOK = false;
    float* C; int ldc;
    __device__ __forceinline__ void operator()(const f32x4 (&acc)[2][2][4][2], const Unit& u, int wr, int wc, int fr, int fq) const {
        const int row0 = u.pm * 256 + wr * 64 + fr, col0 = u.pn * 256 + wc * 32 + 4 * fq;
        GAS float* rowp = (GAS float*)(C + (size_t)row0 * ldc + col0);
#pragma unroll
        for (int ai = 0; ai < 2; ++ai)
#pragma unroll
            for (int m = 0; m < 4; ++m) {
#pragma unroll
                for (int bj = 0; bj < 2; ++bj)
#pragma unroll
                    for (int n = 0; n < 2; ++n) *(GAS f32x4*)(rowp + bj * 128 + n * 16) = acc[ai][bj][m][n];
                rowp += (size_t)EPI_STEP(m) * ldc;
                asm volatile("" : "+v"(rowp) :: "memory"); }
    }
};


struct SplitOrder : pg8::StaticOrder {
    int cut, nA, nB;
    __device__ bool next(int i, Unit& u) const {
        long L;
        if (c < cut) { if (i >= nA) return false; L = (long)i * cut + c; } else { if (i >= nB) return false; L = (long)nA * cut + (long)i * (G - cut) + (c - cut); }
        if (L >= nwg) return false;
        int wgid = (int)L; { const int q = nwg / pg8::NXCD, r = nwg % pg8::NXCD, xcd = wgid % pg8::NXCD, off = wgid / pg8::NXCD; wgid = (xcd < r ? xcd * (q + 1) : r * (q + 1) + (xcd - r) * q) + off; }
        const int nig = pg8::WGM * nN, gid = wgid / nig, fm = gid * pg8::WGM, gsz = (nM - fm) < pg8::WGM ? (nM - fm) : pg8::WGM;
        u.pm = fm + ((wgid % nig) % gsz); u.pn = (wgid % nig) / gsz; return true;
    }
};

struct EpiNull {
    static constexpr bool PERM = true, AFTER_DRAIN = false, HOOK = false;
    __device__ __forceinline__ void operator()(const f32x4 (&acc)[2][2][4][2], const Unit& u, int wr, int wc, int fr, int fq) const {
#pragma unroll
        for (int ai = 0; ai < 2; ++ai)
#pragma unroll
            for (int bj = 0; bj < 2; ++bj)
#pragma unroll
                for (int m = 0; m < 4; ++m) { asm volatile("" :: "v"(acc[ai][bj][m][0]), "v"(acc[ai][bj][m][1])); }
    }
};
struct EpiLocal {
    static constexpr bool PERM = true, AFTER_DRAIN = false, HOOK = false;
    bf16_t* C;
    __device__ __forceinline__ void operator()(const f32x4 (&acc)[2][2][4][2], const Unit& u, int wr, int wc, int fr, int fq) const {
        const int col0 = wc * 32 + 8 * fq;
#pragma unroll
        for (int ai = 0; ai < 2; ++ai)
#pragma unroll
            for (int m = 0; m < 4; ++m) {
                GAS bf16_t* rowp = (GAS bf16_t*)(C + (size_t)(blockIdx.x * 64 + 16 * m + fr) * 2048 + col0);
#pragma unroll
                for (int bj = 0; bj < 2; ++bj) { const f32x4 v0 = acc[ai][bj][m][0], v1 = acc[ai][bj][m][1];
                    u32x4 w; w.x = pk2s(v0[0], v0[1]); w.y = pk2s(v0[2], v0[3]); w.z = pk2s(v1[0], v1[1]); w.w = pk2s(v1[2], v1[3]);
                    *(GAS u32x4*)(rowp + bj * 128) = w; }
            }
    }
};
struct EpiContig {
    static constexpr bool PERM = true, AFTER_DRAIN = false, HOOK = false;
    bf16_t* C;
    __device__ __forceinline__ void operator()(const f32x4 (&acc)[2][2][4][2], const Unit& u, int wr, int wc, int fr, int fq) const {
        GAS unsigned char* tp = (GAS unsigned char*)C + (size_t)(u.pm * 8 + (u.pn & 7)) * 131072 + (wr * 4 + wc) * 16384 + (fq * 16 + fr) * 16;
#pragma unroll
        for (int ai = 0; ai < 2; ++ai)
#pragma unroll
            for (int m = 0; m < 4; ++m) {
#pragma unroll
                for (int bj = 0; bj < 2; ++bj) { const f32x4 v0 = acc[ai][bj][m][0], v1 = acc[ai][bj][m][1];
                    u32x4 w; w.x = pk2s(v0[0], v0[1]); w.y = pk2s(v0[2], v0[3]); w.z = pk2s(v1[0], v1[1]); w.w = pk2s(v1[2], v1[3]);
                    *(GAS u32x4*)(tp + ((ai * 4 + m) * 2 + bj) * 1024) = w; }
            }
    }
};
struct EpiNT {
    static constexpr bool PERM = true, AFTER_DRAIN = false, HOOK = false;
    bf16_t* C;
    __device__ __forceinline__ void operator()(const f32x4 (&acc)[2][2][4][2], const Unit& u, int wr, int wc, int fr, int fq) const {
        const int row0 = u.pm * 256 + wr * 64 + fr, col0 = u.pn * 256 + wc * 32 + 8 * fq;
        GAS bf16_t* rowp = (GAS bf16_t*)(C + (size_t)row0 * 2048 + col0);
#pragma unroll
        for (int ai = 0; ai < 2; ++ai)
#pragma unroll
            for (int m = 0; m < 4; ++m) {
#pragma unroll
                for (int bj = 0; bj < 2; ++bj) { const f32x4 v0 = acc[ai][bj][m][0], v1 = acc[ai][bj][m][1];
                    u32x4 w; w.x = pk2s(v0[0], v0[1]); w.y = pk2s(v0[2], v0[3]); w.z = pk2s(v1[0], v1[1]); w.w = pk2s(v1[2], v1[3]);
                    __builtin_nontemporal_store(w, (GAS u32x4*)(rowp + bj * 128)); }
                rowp += (size_t)EPI_STEP(m) * 2048;
                asm volatile("" : "+v"(rowp));
            }
    }
};
struct EpiRows8 {
    static constexpr bool PERM = true, AFTER_DRAIN = false, HOOK = false;
    bf16_t* C;
    __device__ __forceinline__ void operator()(const f32x4 (&acc)[2][2][4][2], const Unit& u, int wr, int wc, int fr, int fq) const {
        const int lane = fq * 16 + fr, r8 = lane & 7, ch = lane >> 3;
        GAS bf16_t* rowp = (GAS bf16_t*)(C + (size_t)(u.pm * 256 + wr * 64 + r8) * 2048 + u.pn * 256 + wc * 64 + ch * 8);
#pragma unroll
        for (int ai = 0; ai < 2; ++ai)
#pragma unroll
            for (int m = 0; m < 4; ++m) {
#pragma unroll
                for (int bj = 0; bj < 2; ++bj) { const f32x4 v0 = acc[ai][bj][m][0], v1 = acc[ai][bj][m][1];
                    u32x4 w; w.x = pk2s(v0[0], v0[1]); w.y = pk2s(v0[2], v0[3]); w.z = pk2s(v1[0], v1[1]); w.w = pk2s(v1[2], v1[3]);
                    *(GAS u32x4*)(rowp + (size_t)(bj * 8) * 2048) = w; }
                rowp += (size_t)EPI_STEP(m) * 2048;
                asm volatile("" : "+v"(rowp));
            }
    }
};
struct EpiHalf {
    static constexpr bool PERM = true, AFTER_DRAIN = false, HOOK = false;
    bf16_t* C;
    __device__ __forceinline__ void operator()(const f32x4 (&acc)[2][2][4][2], const Unit& u, int wr, int wc, int fr, int fq) const {
        const int row0 = u.pm * 256 + wr * 64 + fr, col0 = u.pn * 256 + wc * 32 + 8 * fq;
        GAS unsigned char* rowp = (GAS unsigned char*)C + (size_t)row0 * 2048 + col0;
#pragma unroll
        for (int ai = 0; ai < 2; ++ai)
#pragma unroll
            for (int m = 0; m < 4; ++m) {
#pragma unroll
                for (int bj = 0; bj < 2; ++bj) { const f32x4 v0 = acc[ai][bj][m][0], v1 = acc[ai][bj][m][1];
                    u32x2 w; w.x = pk4_fp8(v0[0], v0[1], v0[2], v0[3]); w.y = pk4_fp8(v1[0], v1[1], v1[2], v1[3]);
                    *(GAS u32x2*)(rowp + bj * 128) = w; }
                rowp += (size_t)EPI_STEP(m) * 2048;
                asm volatile("" : "+v"(rowp));
            }
    }
};
struct EpiScoreBf16 {
    static constexpr bool PERM = true, AFTER_DRAIN = false, HOOK = false;
    bf16_t* C;
    __device__ __forceinline__ void operator()(const f32x4 (&acc)[2][2][4][2], const Unit& u, int wr, int wc, int fr, int fq) const {
        GAS bf16_t* rowp = (GAS bf16_t*)(C + (size_t)(u.pm * 256 + wr * 64 + (fr & 7)) * 2048 + u.pn * 256 + wc * 64 + ((fr >> 3) * 4 + fq) * 8);
#pragma unroll
        for (int ai = 0; ai < 2; ++ai)
#pragma unroll
            for (int m = 0; m < 4; ++m) { u32x4 w[2];
#pragma unroll
                for (int bj = 0; bj < 2; ++bj) { const f32x4 v0 = acc[ai][bj][m][0], v1 = acc[ai][bj][m][1];
                    w[bj].x = pk2s(v0[0], v0[1]); w[bj].y = pk2s(v0[2], v0[3]); w[bj].z = pk2s(v1[0], v1[1]); w[bj].w = pk2s(v1[2], v1[3]); }
                store_rows8(rowp, (size_t)8 * 2048, w[0], w[1]);
                if (PROBE_DUP == 22) store_rows8(rowp + ((size_t)(WS_PA - WS_PQKV) / 2), (size_t)8 * 2048, w[0], w[1]);
                rowp += (size_t)EPI_STEP(m) * 2048;
                asm volatile("" : "+v"(rowp));
            }
    }
};
struct Ctx {
    LAS unsigned char* lds;
    int tid, lane, wave, G, bx;
    float* out; unsigned char* ws;
};
constexpr int PTR_OFF = TOP_OFF + 512;
__device__ __forceinline__ const float* inptr(const Ctx& C, int i) {
    const LAS unsigned* p = (const LAS unsigned*)(C.lds + PTR_OFF) + 2 * i;
    const unsigned lo = (unsigned)__builtin_amdgcn_readfirstlane((int)p[0]), hi = (unsigned)__builtin_amdgcn_readfirstlane((int)p[1]);
    return (const float*)(const GAS float*)(((unsigned long long)hi << 32) | lo);
}

__device__ __forceinline__ void transpose_item(const float* W, const float* g, int K, int N, bf16_t* WT, LAS float* scr, int item, int lane, int ldw = 0, int koff = 0, int ncols = 0) {
    if (ldw == 0) ldw = K;
    const int nblk = (ncols ? ncols : N) / 32, kb = item / nblk, nb = item % nblk, k0 = 64 * kb, n0 = 32 * nb;
#pragma unroll 8
    for (int i = 0; i < 32; ++i) { const int kk = 2 * i + (lane >> 5); float w = W[(size_t)(k0 + kk) * N + n0 + (lane & 31)]; if (g) w *= g[k0 + kk]; scr[kk * 33 + (lane & 31)] = w; }
    LDS_WAIT();
    const int c = lane & 7;
#pragma unroll
    for (int j = 0; j < 4; ++j) { const int n = (lane >> 3) + 8 * j; const LAS float* s = scr + (8 * c) * 33 + n;
        u32x4 o; o.x = pk2(s[0 * 33], s[1 * 33]); o.y = pk2(s[2 * 33], s[3 * 33]); o.z = pk2(s[4 * 33], s[5 * 33]); o.w = pk2(s[6 * 33], s[7 * 33]);
        *(u32x4*)(WT + (size_t)(n0 + n) * ldw + koff + k0 + 8 * c) = o; }
    LDS_WAIT();
}
__device__ __forceinline__ void transpose_item8(const float* W, const float* g, int K, int N, unsigned char* WT, LAS float* scr, int item, int lane, int ncols, float scale) {
    const int nblk = ncols / 32, kb = item / nblk, nb = item % nblk, k0 = 64 * kb, n0 = 32 * nb;
#pragma unroll 8
    for (int i = 0; i < 32; ++i) { const int kk = 2 * i + (lane >> 5); float w = W[(size_t)(k0 + kk) * N + n0 + (lane & 31)] * scale; if (g) w *= g[k0 + kk]; scr[kk * 33 + (lane & 31)] = fminf(fmaxf(w, -448.f), 448.f); }
    LDS_WAIT();
    const int n = lane >> 1;
#pragma unroll
    for (int j = 0; j < 2; ++j) { const int c = (lane & 1) * 2 + j; const LAS float* s = scr + (16 * c) * 33 + n; u32x4 o;
#pragma unroll
        for (int q = 0; q < 4; ++q) { int pk = 0; pk = __builtin_amdgcn_cvt_pk_fp8_f32(s[(4 * q) * 33], s[(4 * q + 1) * 33], pk, false); pk = __builtin_amdgcn_cvt_pk_fp8_f32(s[(4 * q + 2) * 33], s[(4 * q + 3) * 33], pk, true); o[q] = (unsigned)pk; }
        *(u32x4*)(WT + (size_t)(n0 + n) * K + k0 + 16 * c) = o; }
    LDS_WAIT();
}
__device__ __forceinline__ void cvt_rows(const Ctx& C, const float* src, const float* g, bf16_t* dst, size_t nelem) {
    const size_t n8 = nelem / 8, stride = (size_t)C.G * NTHR;
    for (size_t i = (size_t)C.bx * NTHR + C.tid; i < n8; i += stride) {
        f32x4 a = *(const f32x4*)(src + i * 8), b = *(const f32x4*)(src + i * 8 + 4);
        if (g) { const int d = (int)((i * 8) & 2047); const f32x4 ga = *(const f32x4*)(g + d), gb = *(const f32x4*)(g + d + 4); a = a * ga; b = b * gb; }
        u32x4 w; w.x = pk2(a[0], a[1]); w.y = pk2(a[2], a[3]); w.z = pk2(b[0], b[1]); w.w = pk2(b[2], b[3]);
        *(u32x4*)(dst + i * 8) = w;
    }
}

__device__ __forceinline__ void cvt_rows_fp8(const Ctx& C, const float* src, const float* g, unsigned char* dst, size_t nelem, float scale) {
    const size_t n16 = nelem / 16, stride = (size_t)C.G * NTHR;
    for (size_t i = (size_t)C.bx * NTHR + C.tid; i < n16; i += stride) {
        u32x4 w;
#pragma unroll
        for (int q = 0; q < 4; ++q) {
            f32x4 a = *(const f32x4*)(src + i * 16 + q * 4);
            if (g) { const int d = (int)((i * 16 + q * 4) & 2047); a = a * *(const f32x4*)(g + d); }
            a = a * scale;
#pragma unroll
            for (int j = 0; j < 4; ++j) a[j] = fminf(fmaxf(a[j], -448.f), 448.f);
            int pk = 0; pk = __builtin_amdgcn_cvt_pk_fp8_f32(a[0], a[1], pk, false); pk = __builtin_amdgcn_cvt_pk_fp8_f32(a[2], a[3], pk, true);
            w[q] = (unsigned)pk;
        }
        *(u32x4*)(dst + i * 16) = w;
    }
}

__device__ __forceinline__ void cvt_rows_fp4(const Ctx& C, const float* src, const float* g, unsigned char* dst, size_t nelem, float scale) {
    const size_t n32 = nelem / 32, stride = (size_t)C.G * NTHR;
    size_t i = (size_t)C.bx * NTHR + C.tid;
    f32x4 nx[8];
    if (i < n32) {
#pragma unroll
        for (int q = 0; q < 8; ++q) nx[q] = *(const f32x4*)(src + i * 32 + q * 4); }
    for (; i < n32; i += stride) {
        f32x4 cu[8];
#pragma unroll
        for (int q = 0; q < 8; ++q) cu[q] = nx[q];
        const size_t in = i + stride;
        if (in < n32) {
#pragma unroll
            for (int q = 0; q < 8; ++q) nx[q] = *(const f32x4*)(src + in * 32 + q * 4); }
        u32x4 w;
#pragma unroll
        for (int q = 0; q < 4; ++q) { unsigned pk = 0u;
            f32x4 a = cu[2 * q], b2 = cu[2 * q + 1];
            if (g) { const int d = (int)((i * 32 + q * 8) & 2047); a = a * *(const f32x4*)(g + d); b2 = b2 * *(const f32x4*)(g + d + 4); }
            a = a * scale; b2 = b2 * scale;
            pk = __builtin_amdgcn_cvt_scalef32_pk_fp4_f32(pk, a[0], a[1], 1.0f, 0); pk = __builtin_amdgcn_cvt_scalef32_pk_fp4_f32(pk, a[2], a[3], 1.0f, 1);
            pk = __builtin_amdgcn_cvt_scalef32_pk_fp4_f32(pk, b2[0], b2[1], 1.0f, 2); pk = __builtin_amdgcn_cvt_scalef32_pk_fp4_f32(pk, b2[2], b2[3], 1.0f, 3);
            w[q] = pk; }
        *(u32x4*)(dst + i * 16) = w;
    }
}
__device__ __forceinline__ void cvt_layer_weights(const Ctx& C, int l) {
    LAS float* scr = (LAS float*)(C.lds + C.wave * 16384);
    const int gw = C.bx * NWAVES + C.wave, NGW = C.G * NWAVES;
    const float* w_in = inptr(C, 3) + (size_t)l * D * INW; const float* gmix = inptr(C, 2) + (size_t)l * D;
    const float* wa = inptr(C, 9) + (size_t)l * 1024 * D; const float* wb = inptr(C, 10) + (size_t)l * 1024 * D; const float* wc = inptr(C, 11) + (size_t)l * 512 * D;
    const float* wo = inptr(C, 12) + (size_t)l * D * D;
    bf16_t* WIN = (bf16_t*)(C.ws + WS_WIN); bf16_t* WA = (bf16_t*)(C.ws + WS_WA); bf16_t* WB = (bf16_t*)(C.ws + WS_WB); bf16_t* WC = (bf16_t*)(C.ws + WS_WC);
    bf16_t* WOUT = (bf16_t*)(C.ws + WS_WOUT);
    constexpr int NBF = G1_NBF, NG8 = INW - G1_NBF;
    constexpr int I_IN = (D / 64) * (NBF / 32), I_G8 = (D / 64) * (NG8 / 32), I_A = (1024 / 64) * (D / 32), I_C = (512 / 64) * (D / 32), I_O = (D / 64) * (D / 32);
    constexpr int NITEMS = I_IN + I_G8 + 2 * I_A + I_C + I_O;
    struct TrD { const float* W; const float* g; unsigned char* WT; int N, nblk, ldw, koff, fp8; };
    constexpr int T_IN = (D / 64) * (NBF / 256), T_G8 = (D / 64) * (NG8 / 256), T_A = (1024 / 64) * (D / 256), T_C = (512 / 64) * (D / 256), T_O = (D / 64) * (D / 256);
    constexpr int NTILES = T_IN + T_G8 + 2 * T_A + T_C + T_O;
#define TR_DESC(dd, it_) do { int r_ = (it_); \
        if (r_ < T_IN) { dd = TrD{w_in, gmix, (unsigned char*)WIN, INW, NBF / 256, D, 0, 0}; } else { r_ -= T_IN; \
        if (r_ < T_G8) { dd = TrD{w_in + NBF, gmix, C.ws + WS_WIN8, INW, NG8 / 256, D, 0, 1}; } else { r_ -= T_G8; \
        if (r_ < T_A) { dd = TrD{wa, nullptr, (unsigned char*)WA, D, D / 256, 2560, 0, BR8}; } else { r_ -= T_A; \
        if (r_ < T_A) { dd = TrD{wb, nullptr, (unsigned char*)WA, D, D / 256, 2560, 1024, BR8}; } else { r_ -= T_A; \
        if (r_ < T_C) { dd = TrD{wc, nullptr, (unsigned char*)WA, D, D / 256, 2560, 2048, BR8}; } else { r_ -= T_C; \
        dd = TrD{wo, nullptr, (unsigned char*)WOUT, D, D / 256, D, 0, 0}; } } } } } ritem = r_; } while (0)
#define TR_LOAD(dd, ri, v) do { const int kb_ = (ri) / dd.nblk, nb_ = (ri) - kb_ * dd.nblk, k0_ = 64 * kb_, n0_ = 256 * nb_; \
        _Pragma("unroll") for (int i = 0; i < 8; ++i) { const int kk = (C.tid >> 6) + 8 * i; f32x4 w = *(const f32x4*)(dd.W + (size_t)(k0_ + kk) * dd.N + n0_ + 4 * (C.tid & 63)); if (dd.g) w = w * dd.g[k0_ + kk]; v[i] = w; } } while (0)
    LAS float* tile = (LAS float*)C.lds;
    auto tr_store = [&](const TrD& dd, int ri, const f32x4 (&v)[8]) {
        const int kb = ri / dd.nblk, nb = ri - kb * dd.nblk, k0 = 64 * kb, n0 = 256 * nb;
        __syncthreads();
#pragma unroll
        for (int i = 0; i < 8; ++i) { const int kk = (C.tid >> 6) + 8 * i; LAS float* tp = tile + kk * 257 + 4 * (C.tid & 63);
#pragma unroll
            for (int j = 0; j < 4; ++j) tp[j] = dd.fp8 ? fminf(fmaxf(v[i][j] * 1024.f, -448.f), 448.f) : v[i][j]; }
        __syncthreads();
        if (dd.fp8) { const int c = C.tid & 3;
#pragma unroll
            for (int j = 0; j < 2; ++j) { const int n = (C.tid >> 2) + 128 * j; const LAS float* sq = tile + (16 * c) * 257 + n; u32x4 o;
#pragma unroll
                for (int q = 0; q < 4; ++q) { int pk = 0; pk = __builtin_amdgcn_cvt_pk_fp8_f32(sq[(4 * q) * 257], sq[(4 * q + 1) * 257], pk, false); pk = __builtin_amdgcn_cvt_pk_fp8_f32(sq[(4 * q + 2) * 257], sq[(4 * q + 3) * 257], pk, true); o[q] = (unsigned)pk; }
                *(u32x4*)(dd.WT + (size_t)(n0 + n) * dd.ldw + dd.koff + k0 + 16 * c) = o; } }
        else { const int c = C.tid & 7;
#pragma unroll
            for (int j = 0; j < 4; ++j) { const int n = (C.tid >> 3) + 64 * j; const LAS float* sq = tile + (8 * c) * 257 + n;
                u32x4 o; o.x = pk2(sq[0 * 257], sq[1 * 257]); o.y = pk2(sq[2 * 257], sq[3 * 257]); o.z = pk2(sq[4 * 257], sq[5 * 257]); o.w = pk2(sq[6 * 257], sq[7 * 257]);
                *(u32x4*)((bf16_t*)dd.WT + (size_t)(n0 + n) * dd.ldw + dd.koff + k0 + 8 * c) = o; } }
    };
    {
        f32x4 va[8], vb[8]; TrD da, db; int ritem = 0, ra = 0, rb = 0;
        int it = C.bx;
        if (it < NTILES) { TR_DESC(da, it); ra = ritem; TR_LOAD(da, ra, va); }
        while (it < NTILES) {
            const int it1 = it + C.G;
            if (it1 < NTILES) { TR_DESC(db, it1); rb = ritem; TR_LOAD(db, rb, vb); }
            tr_store(da, ra, va);
            if (it1 >= NTILES) break;
            const int it2 = it1 + C.G;
            if (it2 < NTILES) { TR_DESC(da, it2); ra = ritem; TR_LOAD(da, ra, va); }
            tr_store(db, rb, vb);
            it = it2;
        }
        __syncthreads();
    }
#undef TR_DESC
#undef TR_LOAD
    const size_t gt = (size_t)C.bx * NTHR + C.tid, gs = (size_t)C.G * NTHR;
    {
        const float* wq = inptr(C, 14) + (size_t)l * D * D; const float* k1 = inptr(C, 15) + (size_t)l * 128 * 128; const float* k2 = inptr(C, 16) + (size_t)l * 128 * 128;
        const float* gf = inptr(C, 13) + (size_t)l * D; bf16_t* WSC = (bf16_t*)(C.ws + WS_WSC);
        const int q = C.lane >> 4, r16 = C.lane & 15;
        for (int item = gw; item < 2048; item += NGW) {
            const int nb = item >> 7, mt = (item >> 4) & 7, kc = item & 15;
            const float* kr = ((nb & 1) ? k2 : k1) + (size_t)(mt * 16 + r16) * 128 + 4 * q;
            f32x4 bfr[8];
#pragma unroll
            for (int s = 0; s < 8; ++s) bfr[s] = *(const f32x4*)(kr + 16 * s);
            f32x4 an[8];
            { const float* ar0 = wq + (size_t)((kc * 8) * 16 + r16) * D + nb * 128 + 4 * q;
#pragma unroll
              for (int s = 0; s < 8; ++s) an[s] = *(const f32x4*)(ar0 + 16 * s); }
            for (int t = 0; t < 8; ++t) { const int k0 = (kc * 8 + t) * 16;
                f32x4 av[8];
#pragma unroll
                for (int s = 0; s < 8; ++s) av[s] = an[s];
                if (t < 7) { const float* arn = wq + (size_t)(k0 + 16 + r16) * D + nb * 128 + 4 * q;
#pragma unroll
                    for (int s = 0; s < 8; ++s) an[s] = *(const f32x4*)(arn + 16 * s); }
                f32x4 acc = {0.f, 0.f, 0.f, 0.f};
#pragma unroll
                for (int s = 0; s < 8; ++s) {
#pragma unroll
                    for (int e2 = 0; e2 < 4; ++e2) acc = __builtin_amdgcn_mfma_f32_16x16x4f32(av[s][e2], bfr[s][e2], acc, 0, 0, 0); }
                const f32x4 gv = *(const f32x4*)(gf + k0 + 4 * q);
                u32x2 w; w.x = pk2(acc[0] * gv[0], acc[1] * gv[1]); w.y = pk2(acc[2] * gv[2], acc[3] * gv[3]);
                *(u32x2*)(WSC + (size_t)(nb * 128 + mt * 16 + r16) * D + k0 + 4 * q) = w; }
        }
    }
    {
        const float* ws_ = inptr(C, 5) + (size_t)l * 8 * 128 * 128; bf16_t* WM = (bf16_t*)(C.ws + WS_WM);
        for (size_t i = gt; i < (size_t)8 * 128 * 128; i += gs) { const int s = (int)(i & 127), t = (int)((i >> 7) & 127); WM[i] = (bf16_t)f2bf(s <= t ? ws_[i] : 0.f); }
    }
    {
        const float* wp = inptr(C, 7) + (size_t)l * 4 * 256 * 256; const float* sc = inptr(C, 8) + (size_t)l * 1024; bf16_t* WP = (bf16_t*)(C.ws + WS_WP);
        for (size_t i = gt; i < (size_t)4 * 256 * 256; i += gs) { const int c = (int)(i & 255), e = (int)((i >> 8) & 255), g = (int)(i >> 16); WP[i] = (bf16_t)f2bf(wp[((size_t)g * 256 + c) * 256 + e] * sc[g * 256 + e]); }
    }
}
__device__ __forceinline__ void prologue(const Ctx& C) {
    for (int l = 0; l < (BG_TABLES ? ((BG_TABLES0 && C.G == 256) ? 0 : 1) : DEPTH); ++l) {
#if PEER_FP4
        cvt_rows_fp4(C, inptr(C, 17) + (size_t)l * NEXP * D, inptr(C, 13) + (size_t)l * D, C.ws + WS_U + (size_t)l * NEXP * (D / 2), (size_t)NEXP * D, SCALE_U4);
        cvt_rows_fp4(C, inptr(C, 18) + (size_t)l * NEXP * D, nullptr, C.ws + WS_V + (size_t)l * NEXP * (D / 2), (size_t)NEXP * D, SCALE_V4);
#else
        cvt_rows_fp8(C, inptr(C, 17) + (size_t)l * NEXP * D, inptr(C, 13) + (size_t)l * D, C.ws + WS_U + (size_t)l * NEXP * D, (size_t)NEXP * D, 1024.f);
        cvt_rows_fp8(C, inptr(C, 18) + (size_t)l * NEXP * D, nullptr, C.ws + WS_V + (size_t)l * NEXP * D, (size_t)NEXP * D, 64.f);
#endif
    }
    cvt_layer_weights(C, 0);
    const int gw = C.bx * NWAVES + C.wave, NGW = C.G * NWAVES;
    const float* x = inptr(C, 0); bf16_t* XB = (bf16_t*)(C.ws + WS_XB); float* RS = (float*)(C.ws + WS_RSTD);
    f32x4 nv[8];
    { const f32x4* xr = (const f32x4*)(x + (size_t)min(gw, T - 1) * D) + C.lane;
#pragma unroll
      for (int j = 0; j < 8; ++j) nv[j] = xr[64 * j]; }
    for (int m = gw; m < T; m += NGW) {
        f32x4 v[8]; float s = 0.f;
#pragma unroll
        for (int j = 0; j < 8; ++j) { v[j] = nv[j]; s += (v[j][0] * v[j][0] + v[j][1] * v[j][1]) + (v[j][2] * v[j][2] + v[j][3] * v[j][3]); }
        { const f32x4* xr = (const f32x4*)(x + (size_t)min(m + NGW, T - 1) * D) + C.lane;
#pragma unroll
          for (int j = 0; j < 8; ++j) nv[j] = xr[64 * j]; }
        s = wave_sum(s);
        u32x2* o = (u32x2*)(XB + (size_t)m * D) + C.lane; unsigned* o8 = (unsigned*)(C.ws + WS_XB8 + (size_t)m * D) + C.lane;
#pragma unroll
        for (int j = 0; j < 8; ++j) { u32x2 w; w.x = pk2(v[j][0], v[j][1]); w.y = pk2(v[j][2], v[j][3]); o[64 * j] = w;
            int pk = 0; pk = __builtin_amdgcn_cvt_pk_fp8_f32(fminf(fmaxf(v[j][0], -448.f), 448.f), fminf(fmaxf(v[j][1], -448.f), 448.f), pk, false);
            pk = __builtin_amdgcn_cvt_pk_fp8_f32(fminf(fmaxf(v[j][2], -448.f), 448.f), fminf(fmaxf(v[j][3], -448.f), 448.f), pk, true); o8[64 * j] = (unsigned)pk; }
        if (C.lane == 0) RS[m] = rsqrtf(s * (1.0f / D) + EPS);
    }
}

__device__ __forceinline__ void att_naive(const Ctx& C) {
    const bf16_t* P = (const bf16_t*)(C.ws + WS_PQKV); bf16_t* OG = (bf16_t*)(C.ws + WS_OG); float* LSE = (float*)(C.ws + WS_LSE); const float* rel = inptr(C, 1);
    LAS float* pl = (LAS float*)(C.lds + C.wave * 1024);
    const int gw = C.bx * NWAVES + C.wave, NGW = C.G * NWAVES, lane = C.lane;
    for (int item = gw; item < 12 * T; item += NGW) {
        const int gh = item / T, token = item - gh * T, g = gh >> 2, h = gh & 3;
        const int d = g == 0 ? 1 : (g == 1 ? 4 : 16);
        const int tl = token & (SEQ - 1);
        const int jmax = min(128, tl / d);
        const bf16_t* qrow = P + (size_t)token * 4608 + gh * 128;
        float lg[3]; bool okk[3];
#pragma unroll
        for (int s = 0; s < 3; ++s) {
            const int j = lane + 64 * s; const bool ok = (j <= jmax); const int jj = ok ? j : 0;
            const bf16_t* krow = P + (size_t)(token - jj * d) * 4608 + 1536 + gh * 128;
            float acc = 0.f;
#pragma unroll 4
            for (int c = 0; c < 16; ++c) acc += dot8(*(const u32x4*)(qrow + c * 8), *(const u32x4*)(krow + c * 8));
            const float bias = rel[(int)kBucket[g * 129 + jj] * 12 + gh];
            lg[s] = ok ? acc + bias : -1e30f; okk[s] = ok;
        }
        const float mx = wave_max(fmaxf(lg[0], fmaxf(lg[1], lg[2])));
        const float e0 = okk[0] ? __expf(lg[0] - mx) : 0.f, e1 = okk[1] ? __expf(lg[1] - mx) : 0.f, e2 = okk[2] ? __expf(lg[2] - mx) : 0.f;
        const float ssum = wave_sum(e0 + e1 + e2);
        pl[lane] = e0; pl[lane + 64] = e1; if (lane == 0) pl[128] = e2;
        LDS_WAIT();
        float o0 = 0.f, o1 = 0.f;
        const bf16_t* vb = P + (size_t)token * 4608 + 3072 + gh * 128 + 2 * lane;
        for (int j = 0; j <= jmax; ++j) { const float p = pl[j]; const unsigned vv = *(const unsigned*)(vb - (size_t)j * d * 4608); o0 += p * bflo(vv); o1 += p * bfhi(vv); }
        const float inv = 1.0f / ssum;
        *(unsigned*)(OG + ((size_t)g * T + token) * 512 + h * 128 + 2 * lane) = pk2(o0 * inv, o1 * inv);
        if (lane == 0) LSE[((size_t)g * T + token) * 4 + h] = mx + __logf(ssum);
        LDS_WAIT();
    }
}
__device__ __forceinline__ void vss_rows(const Ctx& C) {
    const GAS bf16_t* PA = (const GAS bf16_t*)(C.ws + WS_PA); GAS float* VS = (GAS float*)(C.ws + WS_RSTD + 131072);
    const int gw = C.bx * NWAVES + C.wave, NGW = C.G * NWAVES;
    u32x4 n0, n1;
    { const GAS u32x4* r = (const GAS u32x4*)(PA + (size_t)min(gw, T - 1) * 2048 + 1024) + C.lane; n0 = r[0]; n1 = r[64]; }
    for (int m = gw; m < T; m += NGW) {
        const u32x4 w0 = n0, w1 = n1;
        { const GAS u32x4* r = (const GAS u32x4*)(PA + (size_t)min(m + NGW, T - 1) * 2048 + 1024) + C.lane; n0 = r[0]; n1 = r[64]; }
        const float s = wave_sum(dot8(w0, w0) + dot8(w1, w1));
        if (C.lane == 0) VS[m] = rsqrtf(s * (1.0f / 1024.0f) + EPS);
    }
}
__device__ __forceinline__ void mixa_naive(const Ctx& C, int l) {
    const bf16_t* PA = (const bf16_t*)(C.ws + WS_PA); const float* VS = (const float*)(C.ws + WS_RSTD + 131072); const bf16_t* WM = (const bf16_t*)(C.ws + WS_WM);
    bf16_t* YA = (bf16_t*)(C.ws + WS_YA); const float* ang = inptr(C, 4) + (size_t)l * 1024; const float* bs = inptr(C, 6) + (size_t)l * 1024;
    const int gw = C.bx * NWAVES + C.wave, NGW = C.G * NWAVES, lane = C.lane;
    for (int item = gw; item < 8 * T; item += NGW) {
        const int h = item / T, token = item - h * T, t = token & 127, c0 = token - t;
        float s0 = 0.f, s1 = 0.f;
        const bf16_t* wrow = WM + ((size_t)h * 128 + t) * 128;
        for (int s = 0; s <= t; ++s) { const float w = bf2f(wrow[s]) * VS[c0 + s]; const unsigned vv = *(const unsigned*)(PA + (size_t)(c0 + s) * 2048 + 1024 + h * 128 + 2 * lane); s0 += w * bflo(vv); s1 += w * bfhi(vv); }
        const float b = bs[h * 128 + t];
        const float S0 = s0 * ang[h * 128 + 2 * lane] + b, S1 = s1 * ang[h * 128 + 2 * lane + 1] + b;
        const unsigned uu = *(const unsigned*)(PA + (size_t)token * 2048 + h * 128 + 2 * lane);
        *(unsigned*)(YA + (size_t)token * 2560 + h * 128 + 2 * lane) = pk2(bflo(uu) * S0, bfhi(uu) * S1);
    }
}
__device__ __forceinline__ void mixb_naive(const Ctx& C) {
    const bf16_t* PB = (const bf16_t*)(C.ws + WS_PB); const bf16_t* WP = (const bf16_t*)(C.ws + WS_WP); bf16_t* YB = (bf16_t*)(C.ws + WS_YA);
    const int half = C.tid >> 8, c = C.tid & 255; LAS float* dsh = (LAS float*)(C.lds + half * 1024);
    for (int base = C.bx * 2; base < 4 * T; base += C.G * 2) {
        const int it = base + half, gb = it & 3, token = it >> 2, tl = token & (SEQ - 1);
        const int w = 2 << gb, cnt = min(w, tl + 1), col = gb * 256 + c;
        float sum = 0.f;
        for (int j = 0; j < cnt; ++j) sum += bf2f(PB[(size_t)(token - j) * 1024 + col]);
        dsh[c] = sum / (float)cnt - bf2f(PB[(size_t)token * 1024 + col]);
        __syncthreads();
        const bf16_t* wr = WP + ((size_t)gb * 256 + c) * 256; float y = 0.f;
#pragma unroll 4
        for (int k = 0; k < 256; k += 8) { const u32x4 wv = *(const u32x4*)(wr + k);
            y += dsh[k] * bflo(wv.x) + dsh[k + 1] * bfhi(wv.x) + dsh[k + 2] * bflo(wv.y) + dsh[k + 3] * bfhi(wv.y) + dsh[k + 4] * bflo(wv.z) + dsh[k + 5] * bfhi(wv.z) + dsh[k + 6] * bflo(wv.w) + dsh[k + 7] * bfhi(wv.w); }
        YB[(size_t)token * 2560 + 1024 + col] = (bf16_t)f2bf(y);
        __syncthreads();
    }
}
struct BgRow { f32x4 x[8]; };
__device__ __forceinline__ void bg_load(BgRow& r, const GAS float* row, int lane) {
    asm volatile("" : "+v"(lane));
#pragma unroll
    for (int q = 0; q < 8; ++q) r.x[q] = *(const GAS f32x4*)(row + 32 * lane + 4 * q); }
template <bool GAIN> __device__ __forceinline__ void bg_store(const BgRow& r, const GAS float* gain, GAS unsigned char* dst, int lane) {
    asm volatile("" : "+v"(lane));
    u32x4 w;
#pragma unroll
    for (int q = 0; q < 4; ++q) { unsigned pk = 0u; f32x4 a = r.x[2 * q], b2 = r.x[2 * q + 1];
        if (GAIN) { a = a * *(const GAS f32x4*)(gain + 32 * lane + 8 * q) * SCALE_U4; b2 = b2 * *(const GAS f32x4*)(gain + 32 * lane + 8 * q + 4) * SCALE_U4; } else { a = a * SCALE_V4; b2 = b2 * SCALE_V4; }
        pk = __builtin_amdgcn_cvt_scalef32_pk_fp4_f32(pk, a[0], a[1], 1.0f, 0); pk = __builtin_amdgcn_cvt_scalef32_pk_fp4_f32(pk, a[2], a[3], 1.0f, 1);
        pk = __builtin_amdgcn_cvt_scalef32_pk_fp4_f32(pk, b2[0], b2[1], 1.0f, 2); pk = __builtin_amdgcn_cvt_scalef32_pk_fp4_f32(pk, b2[2], b2[3], 1.0f, 3); w[q] = pk; }
    *(GAS u32x4*)(dst + 16 * lane) = w; }
__device__ __forceinline__ void combine_groups(const Ctx& C, bool bg = false) {
    const GAS float* bgsrc = (const GAS float*)inptr(C, 17); const GAS float* bggain = (const GAS float*)inptr(C, 13); GAS unsigned char* bgdst = (GAS unsigned char*)(C.ws + WS_U); BgRow bgr; int bgj = 0;
    const GAS bf16_t* OG = (const GAS bf16_t*)(C.ws + WS_OG); const GAS float* LSE = (const GAS float*)(C.ws + WS_LSE); GAS bf16_t* YC = (GAS bf16_t*)(C.ws + WS_YA);
    const int gw = C.bx * NWAVES + C.wave, NGW = C.G * NWAVES, lane = C.lane, h = lane >> 4;
    float nl0 = 0.f, nl1 = 0.f, nl2 = 0.f; u32x4 na = {0u, 0u, 0u, 0u}, nb = na, nc = na;
#define CMB_LOAD(m_) do { const int mm_ = min((m_), T - 1); nl0 = LSE[((size_t)0 * T + mm_) * 4 + h]; nl1 = LSE[((size_t)1 * T + mm_) * 4 + h]; nl2 = LSE[((size_t)2 * T + mm_) * 4 + h]; \
        na = *((const GAS u32x4*)(OG + ((size_t)0 * T + mm_) * 512) + lane); nb = *((const GAS u32x4*)(OG + ((size_t)1 * T + mm_) * 512) + lane); nc = *((const GAS u32x4*)(OG + ((size_t)2 * T + mm_) * 512) + lane); } while (0)
    CMB_LOAD(gw);
    for (int m = gw; m < T; m += NGW) {
        const float l0 = nl0, l1 = nl1, l2 = nl2; const u32x4 a = na, b = nb, c = nc;
        CMB_LOAD(m + NGW);
        const int bgrow = 8192 + bgj * NGW + gw; const bool bgon = bg && bgj < 4; ++bgj;
        if (bgon) bg_load(bgr, bgsrc + (size_t)bgrow * D, lane);
        const float mx = fmaxf(l0, fmaxf(l1, l2)); float w0 = __expf(l0 - mx), w1 = __expf(l1 - mx), w2 = __expf(l2 - mx); const float inv = 1.0f / (w0 + w1 + w2); w0 *= inv; w1 *= inv; w2 *= inv;
        if (BR8) { w0 *= Y8S; w1 *= Y8S; w2 *= Y8S; u32x2 o;
            o.x = pk4_fp8(w0 * bflo(a.x) + w1 * bflo(b.x) + w2 * bflo(c.x), w0 * bfhi(a.x) + w1 * bfhi(b.x) + w2 * bfhi(c.x), w0 * bflo(a.y) + w1 * bflo(b.y) + w2 * bflo(c.y), w0 * bfhi(a.y) + w1 * bfhi(b.y) + w2 * bfhi(c.y));
            o.y = pk4_fp8(w0 * bflo(a.z) + w1 * bflo(b.z) + w2 * bflo(c.z), w0 * bfhi(a.z) + w1 * bfhi(b.z) + w2 * bfhi(c.z), w0 * bflo(a.w) + w1 * bflo(b.w) + w2 * bflo(c.w), w0 * bfhi(a.w) + w1 * bfhi(b.w) + w2 * bfhi(c.w));
            *((GAS u32x2*)((GAS unsigned char*)YC + (size_t)m * 2560 + 2048) + lane) = o; }
        else { u32x4 o;
        o.x = pk2(w0 * bflo(a.x) + w1 * bflo(b.x) + w2 * bflo(c.x), w0 * bfhi(a.x) + w1 * bfhi(b.x) + w2 * bfhi(c.x));
        o.y = pk2(w0 * bflo(a.y) + w1 * bflo(b.y) + w2 * bflo(c.y), w0 * bfhi(a.y) + w1 * bfhi(b.y) + w2 * bfhi(c.y));
        o.z = pk2(w0 * bflo(a.z) + w1 * bflo(b.z) + w2 * bflo(c.z), w0 * bfhi(a.z) + w1 * bfhi(b.z) + w2 * bfhi(c.z));
        o.w = pk2(w0 * bflo(a.w) + w1 * bflo(b.w) + w2 * bflo(c.w), w0 * bfhi(a.w) + w1 * bfhi(b.w) + w2 * bfhi(c.w));
        *((GAS u32x4*)(YC + (size_t)m * 2560 + 2048) + lane) = o; }
        if (bgon) bg_store<true>(bgr, bggain, bgdst + (size_t)bgrow * (D / 2), lane);
    }
#undef CMB_LOAD
}
__device__ __forceinline__ void peer_naive(const Ctx& C, int l, bool last) {
    LAS float* xs = (LAS float*)(C.lds); LAS float* sc = (LAS float*)(C.lds + 8192);
    LAS float* v1s = (LAS float*)(C.lds + 16384); LAS int* i1s = (LAS int*)(C.lds + 16896); LAS float* v2s = (LAS float*)(C.lds + 17408); LAS int* i2s = (LAS int*)(C.lds + 17920);
    LAS int* ex = (LAS int*)(C.lds + 18432); LAS float* gt = (LAS float*)(C.lds + 18944); LAS float* hs = (LAS float*)(C.lds + 19456); LAS float* red = (LAS float*)(C.lds + 19968);
    LAS float* selv = (LAS float*)(C.lds + 20480); LAS int* sele = (LAS int*)(C.lds + 20992);
    const float* SC = (const float*)(C.ws + WS_PQKV); const bf16_t* U = (const bf16_t*)(C.ws + WS_U) + (size_t)l * NEXP * D; const bf16_t* V = (const bf16_t*)(C.ws + WS_V) + (size_t)l * NEXP * D;
    bf16_t* XB = (bf16_t*)(C.ws + WS_XB); float* RS = (float*)(C.ws + WS_RSTD); const float* fg = inptr(C, 19);
    const int tid = C.tid, lane = C.lane, wave = C.wave, h = wave;
    for (int token = C.bx; token < T; token += C.G) {
        const f32x4 xv = *((const f32x4*)(C.out + (size_t)token * D) + tid);
        *((LAS f32x4*)xs + tid) = xv; *((LAS f32x4*)sc + tid) = *((const f32x4*)(SC + (size_t)token * D) + tid);
        float ss = wave_sum((xv[0] * xv[0] + xv[1] * xv[1]) + (xv[2] * xv[2] + xv[3] * xv[3]));
        if (lane == 0) red[wave] = ss;
        __syncthreads();
        ss = 0.f;
#pragma unroll
        for (int i = 0; i < 8; ++i) ss += red[i];
        const float rstd = rsqrtf(ss * (1.0f / D) + EPS);
#pragma unroll
        for (int half = 0; half < 2; ++half) { const LAS float* src = sc + h * 256 + half * 128; LAS float* vd = half ? v2s : v1s; LAS int* id = half ? i2s : i1s;
#pragma unroll
            for (int q = 0; q < 2; ++q) { const int j = lane + 64 * q; const float v = src[j]; int rank = 0;
                for (int i = 0; i < 128; ++i) { const float u = src[i]; rank += (u > v || (u == v && i < j)) ? 1 : 0; }
                if (rank < 16) { vd[h * 16 + rank] = v; id[h * 16 + rank] = j; } } }
        __syncthreads();
#pragma unroll
        for (int q = 0; q < 4; ++q) { const int pos = lane + 64 * q; const float cv = v1s[h * 16 + (pos >> 4)] + v2s[h * 16 + (pos & 15)]; int rank = 0;
            for (int i = 0; i < 256; ++i) { const float u = v1s[h * 16 + (i >> 4)] + v2s[h * 16 + (i & 15)]; rank += (u > cv || (u == cv && i < pos)) ? 1 : 0; }
            if (rank < 16) { selv[h * 16 + rank] = cv; sele[h * 16 + rank] = i1s[h * 16 + (pos >> 4)] * 128 + i2s[h * 16 + (pos & 15)]; } }
        __syncthreads();
        { const float v = selv[h * 16 + (lane & 15)] * rstd; float mx = v;
#pragma unroll
          for (int o = 1; o < 16; o <<= 1) mx = fmaxf(mx, __shfl_xor(mx, o));
          const float e = __expf(v - mx); float sm = e;
#pragma unroll
          for (int o = 1; o < 16; o <<= 1) sm += __shfl_xor(sm, o);
          if (lane < 16) { gt[h * 16 + lane] = e / sm; ex[h * 16 + lane] = sele[h * 16 + lane]; } }
        __syncthreads();
        { float xr[32];
#pragma unroll
          for (int i = 0; i < 4; ++i) { const f32x4 a = *(const LAS f32x4*)(xs + i * 512 + lane * 8), b = *(const LAS f32x4*)(xs + i * 512 + lane * 8 + 4);
              xr[i * 8 + 0] = a[0]; xr[i * 8 + 1] = a[1]; xr[i * 8 + 2] = a[2]; xr[i * 8 + 3] = a[3]; xr[i * 8 + 4] = b[0]; xr[i * 8 + 5] = b[1]; xr[i * 8 + 6] = b[2]; xr[i * 8 + 7] = b[3]; }
          for (int kk = 0; kk < 16; ++kk) { const int k = wave * 16 + kk; const bf16_t* urow = U + (size_t)ex[k] * D; float acc = 0.f;
#pragma unroll
              for (int i = 0; i < 4; ++i) { const u32x4 uv = *(const u32x4*)(urow + i * 512 + lane * 8);
                  acc += xr[i * 8 + 0] * bflo(uv.x) + xr[i * 8 + 1] * bfhi(uv.x) + xr[i * 8 + 2] * bflo(uv.y) + xr[i * 8 + 3] * bfhi(uv.y)
                       + xr[i * 8 + 4] * bflo(uv.z) + xr[i * 8 + 5] * bfhi(uv.z) + xr[i * 8 + 6] * bflo(uv.w) + xr[i * 8 + 7] * bfhi(uv.w); }
              acc = wave_sum(acc);
              if (lane == 0) hs[k] = gelu_erf(acc * rstd) * gt[k]; } }
        __syncthreads();
        float y0 = 0.f, y1 = 0.f, y2 = 0.f, y3 = 0.f;
#pragma unroll 8
        for (int k = 0; k < 128; ++k) { const float hk = hs[k]; const u32x2 vv = *(const u32x2*)(V + (size_t)ex[k] * D + tid * 4);
            y0 += hk * bflo(vv.x); y1 += hk * bfhi(vv.x); y2 += hk * bflo(vv.y); y3 += hk * bfhi(vv.y); }
        f32x4 xn; xn[0] = xv[0] + y0; xn[1] = xv[1] + y1; xn[2] = xv[2] + y2; xn[3] = xv[3] + y3;
        float s2 = wave_sum((xn[0] * xn[0] + xn[1] * xn[1]) + (xn[2] * xn[2] + xn[3] * xn[3]));
        if (lane == 0) red[8 + wave] = s2;
        __syncthreads();
        s2 = 0.f;
#pragma unroll
        for (int i = 0; i < 8; ++i) s2 += red[8 + i];
        const float rstd2 = rsqrtf(s2 * (1.0f / D) + EPS);
        if (last) { const f32x4 g = *((const f32x4*)fg + tid); f32x4 o; o[0] = xn[0] * rstd2 * g[0]; o[1] = xn[1] * rstd2 * g[1]; o[2] = xn[2] * rstd2 * g[2]; o[3] = xn[3] * rstd2 * g[3];
            *((f32x4*)(C.out + (size_t)token * D) + tid) = o; }
        else { *((f32x4*)(C.out + (size_t)token * D) + tid) = xn; u32x2 w; w.x = pk2(xn[0], xn[1]); w.y = pk2(xn[2], xn[3]); *((u32x2*)(XB + (size_t)token * D) + tid) = w;
            if (tid == 0) RS[token] = rstd2; }
        __syncthreads();
    }
}


typedef short s16x4 __attribute__((ext_vector_type(4)));
using pg8::bf16x8;
__device__ __forceinline__ s16x4 tr_read(const LAS unsigned char* p) { return __builtin_bit_cast(s16x4, __builtin_amdgcn_ds_read_tr16_b64_v4i16((LAS s16x4*)p)); }
__device__ __forceinline__ bf16x8 cat8(const s16x4 lo, const s16x4 hi) { return __builtin_shufflevector(lo, hi, 0, 1, 2, 3, 4, 5, 6, 7); }
#define MFMA16(a, b, c) __builtin_amdgcn_mfma_f32_16x16x32_bf16((a), (b), (c), 0, 0, 0)
constexpr int VSTR = 288;
constexpr int DSTR = 528;

struct AttUnit { int g, h, d, n, gh, spk0; size_t tok0; };
__device__ __forceinline__ AttUnit att_unit(int u) {
    AttUnit a; a.g = u >> 9; const int rem = u & 511; a.h = rem & 3; const int idx = rem >> 2;
    const int dsh = 2 * a.g, nbs = 4 - dsh; a.d = 1 << dsh;
    const int sb = idx >> nbs; a.n = idx & ((1 << nbs) - 1);
    const int bb = sb >> dsh, r = sb & (a.d - 1); a.gh = a.g * 4 + a.h;
    a.tok0 = (size_t)bb * SEQ + r;
    a.spk0 = (a.n - 1) * 128;
    return a;
}
__device__ __forceinline__ void att_mfma(const Ctx& C, bool bg = false) {
    const GAS float* bgsrc = (const GAS float*)inptr(C, 18); GAS unsigned char* bgdst = (GAS unsigned char*)(C.ws + WS_V); BgRow bgr;
    const GAS unsigned char* P = (const GAS unsigned char*)(C.ws + WS_PQKV); GAS bf16_t* OG = (GAS bf16_t*)(C.ws + WS_OG); GAS float* LSE = (GAS float*)(C.ws + WS_LSE); const GAS float* rel = (const GAS float*)inptr(C, 1);
    LAS unsigned char* vt = C.lds; LAS float* bias = (LAS float*)(C.lds + 256 * VSTR);
    constexpr int KOFF = 74752;
    const int lane = C.lane, wave = C.wave, g4 = lane >> 4, r16 = lane & 15;
    const int chunk = C.tid & 15, row0 = C.tid >> 4;
#define ATT_KDMA(A) do { _Pragma("unroll") for (int j = 0; j < 4; ++j) { const int row = 32 * wave + 8 * j + (lane >> 3), ksp = max((A).spk0 + row, 0), cc = (lane & 7) ^ ((row >> 1) & 7); \
        __builtin_amdgcn_global_load_lds((const GAS unsigned*)(P + ((A).tok0 + (size_t)ksp * (A).d) * 4608 + 1536 + (A).gh * 128 + cc * 16), (LAS unsigned*)(C.lds + KOFF + (32 * wave + 8 * j) * 128), 16, 0, 0); } } while (0)
    u32x2 vv[8]; float bv = 0.f; long qn[4];
#define ATT_PREFETCH(A) do { \
        _Pragma("unroll") for (int i = 0; i < 8; ++i) { const int ksp = (A).spk0 + row0 + 32 * i; vv[i] = *(const GAS u32x2*)(P + ((A).tok0 + (size_t)max(ksp, 0) * (A).d) * 4608 + 3072 + (A).gh * 128 + chunk * 8); } \
        bv = (C.tid < 129) ? rel[(int)kBucket[(A).g * 129 + C.tid] * 12 + (A).gh] : 0.f; \
        { const size_t tq_ = (A).tok0 + (size_t)((A).n * 128 + 16 * wave + r16) * (A).d; \
          _Pragma("unroll") for (int ks = 0; ks < 4; ++ks) qn[ks] = *(const GAS long*)(P + tq_ * 4608 + (A).gh * 128 + 32 * ks + 8 * g4); } } while (0)
    int u = C.bx;
    AttUnit cur = att_unit(u < 1536 ? u : 0);
    if (u < 1536) { __syncthreads(); ATT_KDMA(cur); ATT_PREFETCH(cur); }
    for (; u < 1536; u += C.G) {
        const int g = cur.g, h = cur.h, d = cur.d, n = cur.n, gh = cur.gh, spk0 = cur.spk0; const size_t tok0 = cur.tok0;
        VM_WAIT();
        __syncthreads();
#pragma unroll
        for (int i = 0; i < 8; ++i) { const int ki = row0 + 32 * i; u32x2 v8 = vv[i]; if (spk0 + ki < 0) v8 = (u32x2){0u, 0u};
            const f32x2 a = __builtin_amdgcn_cvt_pk_f32_fp8((int)v8.x, false), b2 = __builtin_amdgcn_cvt_pk_f32_fp8((int)v8.x, true), c2 = __builtin_amdgcn_cvt_pk_f32_fp8((int)v8.y, false), d2 = __builtin_amdgcn_cvt_pk_f32_fp8((int)v8.y, true);
            u32x4 v; v.x = pk2(a.x, a.y); v.y = pk2(b2.x, b2.y); v.z = pk2(c2.x, c2.y); v.w = pk2(d2.x, d2.y);
            *(LAS u32x4*)(vt + ki * VSTR + chunk * 16) = v; }
        if (C.tid < 129) bias[C.tid] = bv;
        long qf[4];
#pragma unroll
        for (int ks = 0; ks < 4; ++ks) qf[ks] = qn[ks];
        __syncthreads();
        const int un = u + C.G;
        if (un < 1536) { cur = att_unit(un); ATT_PREFETCH(cur); }
        const int bgrow = (u / C.G) * (C.G * NWAVES) + C.bx * NWAVES + wave;
        __builtin_amdgcn_sched_barrier(0);
        const int qi = 16 * wave + r16; const size_t tq = tok0 + (size_t)(n * 128 + qi) * d;
        const int ki0 = min(16 * wave, 96);
        f32x4 st[10];
        {
            const LAS unsigned char* kb = C.lds + KOFF + (ki0 + r16) * 128 + (g4 & 1) * 8; const int sw = (r16 >> 1) & 7;
#pragma unroll
            for (int kt = 0; kt < 10; ++kt) { f32x4 acc = {0.f, 0.f, 0.f, 0.f};
#pragma unroll
                for (int ks = 0; ks < 4; ++ks) acc = __builtin_amdgcn_mfma_f32_16x16x32_fp8_fp8(*(const LAS long*)(kb + kt * 2048 + (((2 * ks + (g4 >> 1)) ^ sw) * 16)), qf[ks], acc, 0, 0, 0);
                st[kt] = acc; }
        }
        __syncthreads();
        if (un < 1536) ATT_KDMA(cur);
        if (bg) bg_load(bgr, bgsrc + (size_t)bgrow * D, lane);
        __builtin_amdgcn_sched_barrier(0);
        float mx = -1e30f;
#pragma unroll
        for (int kt = 0; kt < 10; ++kt)
#pragma unroll
            for (int i = 0; i < 4; ++i) { const int ki = ki0 + 16 * kt + 4 * g4 + i, off = 128 + qi - ki; const bool ok = (off >= 0) && (off <= 128) && (spk0 + ki >= 0);
                float v = st[kt][i] * 0.08838834764831845f + bias[ok ? off : 0]; v = ok ? v : -1e30f; st[kt][i] = v; mx = fmaxf(mx, v); }
        mx = fmaxf(mx, __shfl_xor(mx, 16)); mx = fmaxf(mx, __shfl_xor(mx, 32));
        float sum = 0.f;
#pragma unroll
        for (int kt = 0; kt < 10; ++kt)
#pragma unroll
            for (int i = 0; i < 4; ++i) { const float ee = (st[kt][i] > -1e29f) ? __expf(st[kt][i] - mx) : 0.f; st[kt][i] = ee; sum += ee; }
        sum += __shfl_xor(sum, 16); sum += __shfl_xor(sum, 32);
        f32x4 o[8];
#pragma unroll
        for (int mt = 0; mt < 8; ++mt) o[mt] = (f32x4){0.f, 0.f, 0.f, 0.f};
#pragma unroll
        for (int s = 0; s < 5; ++s) {
            u32x4 pw; pw.x = pk2(st[2 * s][0], st[2 * s][1]); pw.y = pk2(st[2 * s][2], st[2 * s][3]); pw.z = pk2(st[2 * s + 1][0], st[2 * s + 1][1]); pw.w = pk2(st[2 * s + 1][2], st[2 * s + 1][3]);
            const bf16x8 pf = __builtin_bit_cast(bf16x8, pw);
            const LAS unsigned char* a0 = vt + (ki0 + 32 * s + 4 * g4 + (r16 >> 2)) * VSTR + (4 * (r16 & 3)) * 2;
#pragma unroll
            for (int mt = 0; mt < 8; ++mt) { const s16x4 lo = tr_read(a0 + 32 * mt), hi = tr_read(a0 + 32 * mt + 16 * VSTR); o[mt] = MFMA16(cat8(lo, hi), pf, o[mt]); }
        }
        const float inv = 1.0f / sum;
        GAS bf16_t* op = OG + ((size_t)g * T + tq) * 512 + h * 128 + 4 * g4;
#pragma unroll
        for (int mt = 0; mt < 8; ++mt) { u32x2 w; w.x = pk2(o[mt][0] * inv, o[mt][1] * inv); w.y = pk2(o[mt][2] * inv, o[mt][3] * inv); *(GAS u32x2*)(op + 16 * mt) = w; }
        if (g4 == 0) LSE[((size_t)g * T + tq) * 4 + h] = mx + __logf(sum);
        if (bg) bg_store<false>(bgr, nullptr, bgdst + (size_t)bgrow * (D / 2), lane);
    }
#undef ATT_PREFETCH
#undef ATT_KDMA
}
__device__ __forceinline__ void mixa_mfma(const Ctx& C, int l, bool bg = false) {
    const GAS float* bgsrc = (const GAS float*)inptr(C, 17); const GAS float* bggain = (const GAS float*)inptr(C, 13); GAS unsigned char* bgdst = (GAS unsigned char*)(C.ws + WS_U); BgRow bgr;
    const GAS bf16_t* PA = (const GAS bf16_t*)(C.ws + WS_PA); const GAS float* VS = (const GAS float*)(C.ws + WS_RSTD + 131072); const GAS bf16_t* WM = (const GAS bf16_t*)(C.ws + WS_WM);
    GAS bf16_t* YA = (GAS bf16_t*)(C.ws + WS_YA); const GAS float* ang = (const GAS float*)(inptr(C, 4) + (size_t)l * 1024); const GAS float* bs = (const GAS float*)(inptr(C, 6) + (size_t)l * 1024);
    LAS unsigned char* vt = C.lds;
    const int lane = C.lane, wave = C.wave, g4 = lane >> 4, r16 = lane & 15;
    for (int u = C.bx; u < 1024; u += C.G) {
        const int h = u & 7; const size_t c0 = (size_t)(u >> 3) * 128;
        __syncthreads();
        {   const int chunk = C.tid & 15, row0 = C.tid >> 4;
            const f32x4 ga = *(const GAS f32x4*)(ang + h * 128 + chunk * 8), gb = *(const GAS f32x4*)(ang + h * 128 + chunk * 8 + 4);
#pragma unroll
            for (int i = 0; i < 4; ++i) { const int row = row0 + 32 * i; const u32x4 v = *(const GAS u32x4*)(PA + (c0 + row) * 2048 + 1024 + h * 128 + chunk * 8); const float rs = VS[c0 + row];
                u32x4 w; w.x = pk2(bflo(v.x) * rs * ga[0], bfhi(v.x) * rs * ga[1]); w.y = pk2(bflo(v.y) * rs * ga[2], bfhi(v.y) * rs * ga[3]);
                w.z = pk2(bflo(v.z) * rs * gb[0], bfhi(v.z) * rs * gb[1]); w.w = pk2(bflo(v.w) * rs * gb[2], bfhi(v.w) * rs * gb[3]);
                *(LAS u32x4*)(vt + row * VSTR + chunk * 16) = w; }
        }
        __syncthreads();
        const int bgrow = (u / C.G) * (C.G * NWAVES) + C.bx * NWAVES + wave;
        if (bg) bg_load(bgr, bgsrc + (size_t)bgrow * D, lane);
        const int t = 16 * wave + r16;
        f32x4 acc[8];
#pragma unroll
        for (int mt = 0; mt < 8; ++mt) acc[mt] = (f32x4){0.f, 0.f, 0.f, 0.f};
        const int nks = (wave >> 1) + 1;
        const size_t token = c0 + t;
        bf16x8 wf[4]; u32x2 uu[8];
#pragma unroll
        for (int ks = 0; ks < 4; ++ks) wf[ks] = *(const GAS bf16x8*)(WM + ((size_t)h * 128 + t) * 128 + 32 * ks + 8 * g4);
#pragma unroll
        for (int mt = 0; mt < 8; ++mt) uu[mt] = *(const GAS u32x2*)(PA + token * 2048 + h * 128 + 16 * mt + 4 * g4);
        const float bsv = bs[h * 128 + t];
        __builtin_amdgcn_sched_barrier(0);
#pragma unroll
        for (int ks = 0; ks < 4; ++ks) if (ks < nks) {
            const LAS unsigned char* a0 = vt + (32 * ks + 8 * g4 + (r16 >> 2)) * VSTR + (4 * (r16 & 3)) * 2;
#pragma unroll
            for (int mt = 0; mt < 8; ++mt) { const s16x4 lo = tr_read(a0 + 32 * mt), hi = tr_read(a0 + 32 * mt + 4 * VSTR); acc[mt] = MFMA16(cat8(lo, hi), wf[ks], acc[mt]); }
        }
#pragma unroll
        for (int mt = 0; mt < 8; ++mt) { const int dd = 16 * mt + 4 * g4;
            if (BR8) *(GAS unsigned*)((GAS unsigned char*)YA + token * 2560 + h * 128 + dd) = pk4_fp8(Y8S * bflo(uu[mt].x) * (acc[mt][0] + bsv), Y8S * bfhi(uu[mt].x) * (acc[mt][1] + bsv), Y8S * bflo(uu[mt].y) * (acc[mt][2] + bsv), Y8S * bfhi(uu[mt].y) * (acc[mt][3] + bsv));
            else { u32x2 w; w.x = pk2(bflo(uu[mt].x) * (acc[mt][0] + bsv), bfhi(uu[mt].x) * (acc[mt][1] + bsv)); w.y = pk2(bflo(uu[mt].y) * (acc[mt][2] + bsv), bfhi(uu[mt].y) * (acc[mt][3] + bsv));
            *(GAS u32x2*)(YA + token * 2560 + h * 128 + dd) = w; } }
        if (bg) bg_store<true>(bgr, bggain, bgdst + (size_t)bgrow * (D / 2), lane);
    }
}
__device__ __forceinline__ void mixb_mfma(const Ctx& C, bool bg = false) {
    const GAS float* bgsrc = (const GAS float*)inptr(C, 18); GAS unsigned char* bgdst = (GAS unsigned char*)(C.ws + WS_V); BgRow bgr;
    const GAS bf16_t* PB = (const GAS bf16_t*)(C.ws + WS_PB); const GAS bf16_t* WP = (const GAS bf16_t*)(C.ws + WS_WP); GAS bf16_t* YB = (GAS bf16_t*)(C.ws + WS_YA);
    LAS unsigned char* dt = C.lds;
    const int lane = C.lane, wave = C.wave, g4 = lane >> 4, r16 = lane & 15;
    for (int u = C.bx; u < 512; u += C.G) {
        const int gb = u & 3, t0 = (u >> 2) * 128, w = 2 << gb;
        __syncthreads();
        {
            const int cp = C.tid & 127, seg = C.tid >> 7, rbeg = 32 * seg, tl0 = (t0 & (SEQ - 1)) + rbeg;
            const GAS bf16_t* pc = PB + (size_t)(t0 + rbeg) * 1024 + gb * 256 + 2 * cp;
            unsigned pv[48];
#pragma unroll
            for (int j = 1; j <= 16; ++j) pv[16 - j] = (tl0 - j >= 0) ? *(const GAS unsigned*)(pc - (size_t)j * 1024) : 0u;
#pragma unroll
            for (int rr = 0; rr < 32; ++rr) pv[16 + rr] = *(const GAS unsigned*)(pc + (size_t)rr * 1024);
            __builtin_amdgcn_sched_barrier(0);
#define MIXB_WINDOW(W) do { float s0 = 0.f, s1 = 0.f; \
                _Pragma("unroll") for (int j = 1; j <= (W); ++j) { s0 += bflo(pv[16 - j]); s1 += bfhi(pv[16 - j]); } \
                _Pragma("unroll") for (int rr = 0; rr < 32; ++rr) { const int tl = tl0 + rr; const unsigned cur = pv[16 + rr], old = pv[16 + rr - (W)]; \
                    s0 += bflo(cur) - bflo(old); s1 += bfhi(cur) - bfhi(old); \
                    const float inv = 1.0f / (float)min((W), tl + 1); \
                    *(LAS unsigned*)(dt + (rbeg + rr) * DSTR + cp * 4) = pk2(s0 * inv - bflo(cur), s1 * inv - bfhi(cur)); } } while (0)
            if (gb == 0) MIXB_WINDOW(2); else if (gb == 1) MIXB_WINDOW(4); else if (gb == 2) MIXB_WINDOW(8); else MIXB_WINDOW(16);
#undef MIXB_WINDOW
        }
        __syncthreads();
        const int bgrow = 12288 + (u / C.G) * (C.G * NWAVES) + C.bx * NWAVES + wave;
        if (bg) bg_load(bgr, bgsrc + (size_t)bgrow * D, lane);
        f32x4 acc[2][8];
#pragma unroll
        for (int mt = 0; mt < 2; ++mt)
#pragma unroll
            for (int nt = 0; nt < 8; ++nt) acc[mt][nt] = (f32x4){0.f, 0.f, 0.f, 0.f};
        bf16x8 af[8][2];
#pragma unroll
        for (int ks = 0; ks < 8; ++ks) { af[ks][0] = *(const GAS bf16x8*)(WP + ((size_t)gb * 256 + 32 * wave + r16) * 256 + 32 * ks + 8 * g4); af[ks][1] = *(const GAS bf16x8*)(WP + ((size_t)gb * 256 + 32 * wave + 16 + r16) * 256 + 32 * ks + 8 * g4); }
        __builtin_amdgcn_sched_barrier(0);
#pragma unroll
        for (int ks = 0; ks < 8; ++ks) {
#pragma unroll
            for (int nt = 0; nt < 8; ++nt) { const bf16x8 bfr = *(const LAS bf16x8*)(dt + (16 * nt + r16) * DSTR + (32 * ks + 8 * g4) * 2); acc[0][nt] = MFMA16(af[ks][0], bfr, acc[0][nt]); acc[1][nt] = MFMA16(af[ks][1], bfr, acc[1][nt]); }
        }
#pragma unroll
        for (int mt = 0; mt < 2; ++mt)
#pragma unroll
            for (int nt = 0; nt < 8; ++nt) {
                if (BR8) *(GAS unsigned*)((GAS unsigned char*)YB + (size_t)(t0 + 16 * nt + r16) * 2560 + 1024 + gb * 256 + 32 * wave + 16 * mt + 4 * g4) = pk4_fp8(Y8S * acc[mt][nt][0], Y8S * acc[mt][nt][1], Y8S * acc[mt][nt][2], Y8S * acc[mt][nt][3]);
                else { u32x2 wv; wv.x = pk2s(acc[mt][nt][0], acc[mt][nt][1]); wv.y = pk2s(acc[mt][nt][2], acc[mt][nt][3]);
                *(GAS u32x2*)(YB + (size_t)(t0 + 16 * nt + r16) * 2560 + 1024 + gb * 256 + 32 * wave + 16 * mt + 4 * g4) = wv; } }
        if (bg) bg_store<false>(bgr, nullptr, bgdst + (size_t)bgrow * (D / 2), lane);
    }
}

template <int CTRL> __device__ __forceinline__ unsigned dpp_u(unsigned v) { return (unsigned)__builtin_amdgcn_update_dpp(0, (int)v, CTRL, 0xF, 0xF, false); }
template <int CTRL> __device__ __forceinline__ float dpp_f(float v) { return __int_as_float(__builtin_amdgcn_update_dpp(0, __float_as_int(v), CTRL, 0xF, 0xF, false)); }
__device__ __forceinline__ unsigned row_max_u32(unsigned v) { v = max(v, dpp_u<0xB1>(v)); v = max(v, dpp_u<0x4E>(v)); v = max(v, dpp_u<0x141>(v)); v = max(v, dpp_u<0x140>(v)); return v; }
__device__ __forceinline__ float row_max_f32(float v) { v = fmaxf(v, dpp_f<0xB1>(v)); v = fmaxf(v, dpp_f<0x4E>(v)); v = fmaxf(v, dpp_f<0x141>(v)); v = fmaxf(v, dpp_f<0x140>(v)); return v; }
__device__ __forceinline__ float row_sum_f32(float v) { v += dpp_f<0xB1>(v); v += dpp_f<0x4E>(v); v += dpp_f<0x141>(v); v += dpp_f<0x140>(v); return v; }
__device__ __forceinline__ unsigned mono_key(float v) { const unsigned u = __float_as_uint(v); return u ^ ((unsigned)((int)u >> 31) | 0x80000000u); }
__device__ __forceinline__ unsigned row_top16(unsigned (&k)[8], int r) {
#define CE_(i, j) do { const unsigned hi_ = max(k[i], k[j]), lo_ = min(k[i], k[j]); k[i] = hi_; k[j] = lo_; } while (0)
    CE_(0, 1); CE_(2, 3); CE_(4, 5); CE_(6, 7);
    CE_(0, 2); CE_(1, 3); CE_(4, 6); CE_(5, 7);
    CE_(1, 2); CE_(5, 6);
    CE_(0, 4); CE_(1, 5); CE_(2, 6); CE_(3, 7);
    CE_(2, 4); CE_(3, 5);
    CE_(1, 2); CE_(3, 4); CE_(5, 6);
#undef CE_
    unsigned sel = 0u;
#pragma unroll
    for (int t = 0; t < 16; ++t) {
        const unsigned m = row_max_u32(k[0]);
        const bool win = (k[0] == m);
#pragma unroll
        for (int i = 0; i < 7; ++i) k[i] = win ? k[i + 1] : k[i];
        k[7] = win ? 0u : k[7];
        sel = (r == t) ? m : sel;
    }
    return sel;
}
__device__ __forceinline__ float unmono_key(unsigned k) { return __uint_as_float((k & 0x80000000u) ? (k ^ 0x80000000u) : ~k); }
__device__ __forceinline__ void peer_topk_dpp(const Ctx& C, int lbg = -1) {
    const GAS bf16_t* SC = (const GAS bf16_t*)(C.ws + WS_PQKV); GAS int* EXG = (GAS int*)(C.ws + WS_EXG); GAS float* CVG = (GAS float*)(C.ws + WS_CVG);
    const int lane = C.lane, r = lane & 15, rho = lane >> 4;
    const bool bg = BG_TABLES && lbg >= 0;
    const GAS float* tu = nullptr; const GAS float* tv = nullptr; GAS unsigned char* du = nullptr; GAS unsigned char* dv = nullptr; f32x4 gq[8], bx_[8]; int R = C.bx * NWAVES + C.wave;
    if (bg) { tu = (const GAS float*)(inptr(C, 17) + (size_t)lbg * NEXP * D); tv = (const GAS float*)(inptr(C, 18) + (size_t)lbg * NEXP * D);
        du = (GAS unsigned char*)(C.ws + WS_U + (size_t)lbg * NEXP * (D / 2)); dv = (GAS unsigned char*)(C.ws + WS_V + (size_t)lbg * NEXP * (D / 2));
        const GAS float* gf = (const GAS float*)(inptr(C, 13) + (size_t)lbg * D) + 32 * lane;
#pragma unroll
        for (int q = 0; q < 8; ++q) gq[q] = *(const GAS f32x4*)(gf + 4 * q) * SCALE_U4; }
#define BG_LOAD() do { if (bg && R < 2 * NEXP) { const GAS float* s_ = (R < NEXP ? tu + (size_t)R * D : tv + (size_t)(R - NEXP) * D) + 32 * lane; \
        _Pragma("unroll") for (int q = 0; q < 8; ++q) bx_[q] = *(const GAS f32x4*)(s_ + 4 * q); } } while (0)
#define BG_STORE() do { if (bg && R < 2 * NEXP) { const bool isu_ = R < NEXP; u32x4 w_; \
        _Pragma("unroll") for (int q = 0; q < 4; ++q) { unsigned pk = 0u; f32x4 a = bx_[2 * q], b2 = bx_[2 * q + 1]; \
            if (isu_) { a = a * gq[2 * q]; b2 = b2 * gq[2 * q + 1]; } else { a = a * SCALE_V4; b2 = b2 * SCALE_V4; } \
            pk = __builtin_amdgcn_cvt_scalef32_pk_fp4_f32(pk, a[0], a[1], 1.0f, 0); pk = __builtin_amdgcn_cvt_scalef32_pk_fp4_f32(pk, a[2], a[3], 1.0f, 1); \
            pk = __builtin_amdgcn_cvt_scalef32_pk_fp4_f32(pk, b2[0], b2[1], 1.0f, 2); pk = __builtin_amdgcn_cvt_scalef32_pk_fp4_f32(pk, b2[2], b2[3], 1.0f, 3); w_[q] = pk; } \
        *(GAS u32x4*)((isu_ ? du + (size_t)R * (D / 2) : dv + (size_t)(R - NEXP) * (D / 2)) + 16 * lane) = w_; } R += C.G * NWAVES; } while (0)
    LAS float* selv = (LAS float*)(C.lds + C.wave * 512); LAS int* sele = (LAS int*)(C.lds + C.wave * 512 + 256);
    const int cnt = (r == 0) ? 16 : (r == 1) ? 8 : (r == 2) ? 5 : (r == 3) ? 4 : (r == 4) ? 3 : (r < 8) ? 2 : 1;
    const int NGW = C.G * NWAVES;
    float nx1[8], nx2[8];
    { const int tl = C.wave >> 1, token = C.bx * NWAVES + (tl & 7) + (tl >> 3) * NGW, head = (C.wave & 1) * 4 + rho; const GAS bf16_t* sp = SC + (size_t)min(token, T - 1) * D + head * 256;
#pragma unroll
      for (int i = 0; i < 8; ++i) { nx1[i] = bf2f(sp[r + 16 * i]); nx2[i] = bf2f(sp[128 + r + 16 * i]); } }
    for (int q = C.wave; ; q += NWAVES) {
        const int tl = q >> 1, token = C.bx * NWAVES + (tl & 7) + (tl >> 3) * NGW;
        if (token >= T) break;
        BG_LOAD();
        const int head = (q & 1) * 4 + rho;
        unsigned k1[8], k2[8];
#pragma unroll
        for (int i = 0; i < 8; ++i) { k1[i] = (mono_key(nx1[i]) & ~127u) | (unsigned)(127 - (r + 16 * i)); k2[i] = (mono_key(nx2[i]) & ~127u) | (unsigned)(127 - (r + 16 * i)); }
        { const int qn = q + NWAVES, tln = qn >> 1, tokn = C.bx * NWAVES + (tln & 7) + (tln >> 3) * NGW, headn = (qn & 1) * 4 + rho; const GAS bf16_t* spn = SC + (size_t)min(tokn, T - 1) * D + headn * 256;
#pragma unroll
          for (int i = 0; i < 8; ++i) { nx1[i] = bf2f(spn[r + 16 * i]); nx2[i] = bf2f(spn[128 + r + 16 * i]); } }
        const unsigned s1 = row_top16(k1, r), s2 = row_top16(k2, r);
        const int idx1 = 127 - (int)(s1 & 127u), idx2 = 127 - (int)(s2 & 127u);
        const float v1 = unmono_key(s1 & ~127u), v2 = unmono_key(s2 & ~127u);
        int p = 0;
        float v2p = __int_as_float(__builtin_amdgcn_ds_bpermute((lane & 48) * 4, __float_as_int(v2)));
        int i2p = __builtin_amdgcn_ds_bpermute((lane & 48) * 4, idx2);
#pragma unroll
        for (int t = 0; t < 16; ++t) {
            const float c = v1 + v2p;
            unsigned ck = (mono_key(c) & ~15u) | (unsigned)(15 - r); ck = (p < cnt) ? ck : 0u;
            const unsigned m = row_max_u32(ck);
            const bool win = (ck == m);
            if (win) { selv[rho * 16 + t] = c; sele[rho * 16 + t] = idx1 * 128 + i2p; }
            p += win ? 1 : 0;
            const int a = ((lane & 48) + min(p, 15)) * 4;
            v2p = __int_as_float(__builtin_amdgcn_ds_bpermute(a, __float_as_int(v2))); i2p = __builtin_amdgcn_ds_bpermute(a, idx2);
        }
        LDS_WAIT();
        const float cv = selv[lane]; const int ev = sele[lane];
        EXG[(size_t)token * 128 + head * 16 + r] = ev; CVG[(size_t)token * 128 + head * 16 + r] = cv;
        LDS_WAIT();
        BG_STORE();
    }
    while (bg && R < 2 * NEXP) { BG_LOAD(); BG_STORE(); }
#undef BG_LOAD
#undef BG_STORE
}
__device__ __forceinline__ float transpose_reduce16(const float (&s)[16], int lane) {
    const bool b3 = lane & 8, b2 = lane & 4, b1 = lane & 2, b0 = lane & 1;
    float a[8], b[4], c[2];
#pragma unroll
    for (int q = 0; q < 8; ++q) { const float keep = b3 ? s[q + 8] : s[q], send = b3 ? s[q] : s[q + 8]; a[q] = keep + dpp_f<0x128>(send); }
#pragma unroll
    for (int q = 0; q < 4; ++q) { const float keep = b2 ? a[q + 4] : a[q], send = b2 ? a[q] : a[q + 4]; b[q] = keep + dpp_f<0x141>(send); }
#pragma unroll
    for (int q = 0; q < 2; ++q) { const float keep = b1 ? b[q + 2] : b[q], send = b1 ? b[q] : b[q + 2]; c[q] = keep + dpp_f<0x4E>(send); }
    const float keep = b0 ? c[1] : c[0], send = b0 ? c[0] : c[1];
    float rsum = keep + dpp_f<0xB1>(send);
    rsum += __shfl_xor(rsum, 16); rsum += __shfl_xor(rsum, 32);
    return rsum;
}
__device__ __forceinline__ void peer_gather(const Ctx& C, int l, bool last, bool dry = false) {
    const unsigned char* U8 = C.ws + WS_U + (size_t)l * NEXP * D; const unsigned char* V8 = C.ws + WS_V + (size_t)l * NEXP * D;
    const int* EXG = (const int*)(C.ws + WS_EXG); const float* CVG = (const float*)(C.ws + WS_CVG);
    bf16_t* XB = (bf16_t*)(C.ws + WS_XB); float* RS = (float*)(C.ws + WS_RSTD);
    const int lane = C.lane;
    LAS float* hl = (LAS float*)(C.lds + 8192 + C.wave * 1024); LAS int* el = (LAS int*)(C.lds + 8192 + C.wave * 1024 + 512);
    const int gw = C.bx * NWAVES + C.wave, NGW = C.G * NWAVES;
    for (int token = gw; token < T; token += NGW) {
        f32x4 xq[8]; float ss = 0.f;
        const float* xrow = C.out + (size_t)token * D;
#pragma unroll
        for (int i = 0; i < 2; ++i)
#pragma unroll
            for (int q = 0; q < 4; ++q) { const f32x4 v = *(const f32x4*)(xrow + i * 1024 + lane * 16 + q * 4); xq[i * 4 + q] = v; ss += (v[0] * v[0] + v[1] * v[1]) + (v[2] * v[2] + v[3] * v[3]); }
        const float rstd = rsqrtf(wave_sum(ss) * (1.0f / D) + EPS);
        {
            const int e0 = EXG[(size_t)token * 128 + lane], e1 = EXG[(size_t)token * 128 + 64 + lane];
            const float z0 = CVG[(size_t)token * 128 + lane] * rstd, z1 = CVG[(size_t)token * 128 + 64 + lane] * rstd;
            const float p0 = __expf(z0 - row_max_f32(z0)), p1 = __expf(z1 - row_max_f32(z1));
            const float g0 = p0 / row_sum_f32(p0), g1 = p1 / row_sum_f32(p1);
            el[lane] = e0; el[64 + lane] = e1; hl[lane] = g0; hl[64 + lane] = g1;
        }
        LDS_WAIT();
        for (int b = 0; b < 8; ++b) {
            float s[16];
#pragma unroll
            for (int sb = 0; sb < 2; ++sb) {
                u32x4 ld[16];
#pragma unroll
                for (int j = 0; j < 8; ++j) { const int e = __builtin_amdgcn_readfirstlane(el[b * 16 + sb * 8 + j]); const unsigned char* rowp = U8 + (size_t)e * D + lane * 16;
                    ld[j * 2] = *(const u32x4*)rowp; ld[j * 2 + 1] = *(const u32x4*)(rowp + 1024); }
#pragma unroll
                for (int j = 0; j < 8; ++j) { f32x2 acc = {0.f, 0.f};
#pragma unroll
                    for (int i = 0; i < 2; ++i)
#pragma unroll
                        for (int q = 0; q < 4; ++q) { const int w = (int)ld[j * 2 + i][q]; const f32x4 xv = xq[i * 4 + q];
                            acc = __builtin_amdgcn_cvt_pk_f32_fp8(w, false) * (f32x2){xv[0], xv[1]} + acc; acc = __builtin_amdgcn_cvt_pk_f32_fp8(w, true) * (f32x2){xv[2], xv[3]} + acc; }
                    s[sb * 8 + j] = acc.x + acc.y; }
            }
            const float tot = transpose_reduce16(s, lane);
            const float a = tot * rstd * (1.0f / 1024.0f);
            const float h = gelu_erf(a) * hl[b * 16 + (lane & 15)] * (1.0f / 64.0f);
            LDS_WAIT();
            if (lane < 16) hl[b * 16 + lane] = h;
        }
        LDS_WAIT();
        f32x2 ya[16];
#pragma unroll
        for (int i = 0; i < 16; ++i) ya[i] = (f32x2){0.f, 0.f};
        for (int kb = 0; kb < 16; ++kb) {
            u32x4 ld[16];
#pragma unroll
            for (int j = 0; j < 8; ++j) { const int e = __builtin_amdgcn_readfirstlane(el[kb * 8 + j]); const unsigned char* rowp = V8 + (size_t)e * D + lane * 16;
                ld[j * 2] = *(const u32x4*)rowp; ld[j * 2 + 1] = *(const u32x4*)(rowp + 1024); }
#pragma unroll
            for (int j = 0; j < 8; ++j) { const float hk = hl[kb * 8 + j]; const f32x2 hh = {hk, hk};
#pragma unroll
                for (int i = 0; i < 2; ++i)
#pragma unroll
                    for (int q = 0; q < 4; ++q) { const int w = (int)ld[j * 2 + i][q];
                        ya[(i * 4 + q) * 2] = __builtin_amdgcn_cvt_pk_f32_fp8(w, false) * hh + ya[(i * 4 + q) * 2]; ya[(i * 4 + q) * 2 + 1] = __builtin_amdgcn_cvt_pk_f32_fp8(w, true) * hh + ya[(i * 4 + q) * 2 + 1]; } }
        }
        float s2 = 0.f;
#pragma unroll
        for (int i = 0; i < 8; ++i) { xq[i][0] += ya[i * 2].x; xq[i][1] += ya[i * 2].y; xq[i][2] += ya[i * 2 + 1].x; xq[i][3] += ya[i * 2 + 1].y;
            s2 += (xq[i][0] * xq[i][0] + xq[i][1] * xq[i][1]) + (xq[i][2] * xq[i][2] + xq[i][3] * xq[i][3]); }
        const float rstd2 = rsqrtf(wave_sum(s2) * (1.0f / D) + EPS);
        float* orow = C.out + (size_t)token * D;
        if (dry) { if (rstd2 == 12345.678f) RS[token] = rstd2; }
        else if (last) { const float* fg = inptr(C, 19);
#pragma unroll
            for (int i = 0; i < 2; ++i)
#pragma unroll
                for (int q = 0; q < 4; ++q) { const int d = i * 1024 + lane * 16 + q * 4; const f32x4 g = *(const f32x4*)(fg + d); f32x4 o = xq[i * 4 + q] * rstd2; o = o * g; *(f32x4*)(orow + d) = o; } }
        else {
#pragma unroll
            for (int i = 0; i < 2; ++i)
#pragma unroll
                for (int q = 0; q < 4; ++q) { const int d = i * 1024 + lane * 16 + q * 4; const f32x4 v = xq[i * 4 + q]; *(f32x4*)(orow + d) = v;
                    u32x2 w; w.x = pk2(v[0], v[1]); w.y = pk2(v[2], v[3]); *(u32x2*)(XB + (size_t)token * D + d) = w; }
            if (lane == 0) RS[token] = rstd2; }
        LDS_WAIT();
    }
}


template <int CTRL> __device__ __forceinline__ float xsel_add(bool sel, float lo, float hi) { const float keep = sel ? hi : lo, send = sel ? lo : hi; return keep + dpp_f<CTRL>(send); }
__device__ __forceinline__ float treduce8(const float (&v)[8], int lane) {
    const bool b2 = lane & 4, b1 = lane & 2, b0 = lane & 1;
    float a[4], c[2];
#pragma unroll
    for (int q = 0; q < 4; ++q) a[q] = xsel_add<0x141>(b2, v[q], v[q + 4]);
#pragma unroll
    for (int q = 0; q < 2; ++q) c[q] = xsel_add<0x4E>(b1, a[q], a[q + 2]);
    return xsel_add<0xB1>(b0, c[0], c[1]);
}
__device__ __forceinline__ float xsel_add_shfl(bool sel, float lo, float hi, int m) { const float keep = sel ? hi : lo, send = sel ? lo : hi; return keep + __shfl_xor(send, m); }
__device__ __forceinline__ void peer_sweep(const Ctx& C, int l, bool last, bool dry = false) {
    #if PEER_FP4
    const GAS unsigned char* U8 = (const GAS unsigned char*)(C.ws + WS_U + (size_t)l * NEXP * (D / 2)); const GAS unsigned char* V8 = (const GAS unsigned char*)(C.ws + WS_V + (size_t)l * NEXP * (D / 2));
    typedef u32x2 ldv_t; constexpr int PIECE = 64, ROWSH = 10; constexpr float INV_SU = 1.0f / SCALE_U4, INV_SV = 1.0f / SCALE_V4;
#define PEER_CVT(w, k) __builtin_amdgcn_cvt_scalef32_pk_f32_fp4((w), 1.0f, (k))
#define PEER_DOT(LDV, XV, a2) do { \
        a2 = PEER_CVT(LDV.x, 0) * (f32x2){XV[0][0], XV[0][1]} + a2; a2 = PEER_CVT(LDV.x, 1) * (f32x2){XV[0][2], XV[0][3]} + a2; a2 = PEER_CVT(LDV.x, 2) * (f32x2){XV[1][0], XV[1][1]} + a2; a2 = PEER_CVT(LDV.x, 3) * (f32x2){XV[1][2], XV[1][3]} + a2; \
        a2 = PEER_CVT(LDV.y, 0) * (f32x2){XV[2][0], XV[2][1]} + a2; a2 = PEER_CVT(LDV.y, 1) * (f32x2){XV[2][2], XV[2][3]} + a2; a2 = PEER_CVT(LDV.y, 2) * (f32x2){XV[3][0], XV[3][1]} + a2; a2 = PEER_CVT(LDV.y, 3) * (f32x2){XV[3][2], XV[3][3]} + a2; } while (0)
#define PEER_AXPY(LDV, hh, ya) do { \
        ya[0] = PEER_CVT(LDV.x, 0) * hh + ya[0]; ya[1] = PEER_CVT(LDV.x, 1) * hh + ya[1]; ya[2] = PEER_CVT(LDV.x, 2) * hh + ya[2]; ya[3] = PEER_CVT(LDV.x, 3) * hh + ya[3]; \
        ya[4] = PEER_CVT(LDV.y, 0) * hh + ya[4]; ya[5] = PEER_CVT(LDV.y, 1) * hh + ya[5]; ya[6] = PEER_CVT(LDV.y, 2) * hh + ya[6]; ya[7] = PEER_CVT(LDV.y, 3) * hh + ya[7]; } while (0)
#else
    const GAS unsigned char* U8 = (const GAS unsigned char*)(C.ws + WS_U + (size_t)l * NEXP * D); const GAS unsigned char* V8 = (const GAS unsigned char*)(C.ws + WS_V + (size_t)l * NEXP * D);
    typedef u32x4 ldv_t; constexpr int PIECE = 128, ROWSH = 11; constexpr float INV_SU = 1.0f / 1024.0f, INV_SV = 1.0f / 64.0f;
#define PEER_DOT(LDV, XV, a2) do { \
        a2 = __builtin_amdgcn_cvt_pk_f32_fp8((int)LDV.x, false) * (f32x2){XV[0][0], XV[0][1]} + a2; a2 = __builtin_amdgcn_cvt_pk_f32_fp8((int)LDV.x, true) * (f32x2){XV[0][2], XV[0][3]} + a2; \
        a2 = __builtin_amdgcn_cvt_pk_f32_fp8((int)LDV.y, false) * (f32x2){XV[1][0], XV[1][1]} + a2; a2 = __builtin_amdgcn_cvt_pk_f32_fp8((int)LDV.y, true) * (f32x2){XV[1][2], XV[1][3]} + a2; \
        a2 = __builtin_amdgcn_cvt_pk_f32_fp8((int)LDV.z, false) * (f32x2){XV[2][0], XV[2][1]} + a2; a2 = __builtin_amdgcn_cvt_pk_f32_fp8((int)LDV.z, true) * (f32x2){XV[2][2], XV[2][3]} + a2; \
        a2 = __builtin_amdgcn_cvt_pk_f32_fp8((int)LDV.w, false) * (f32x2){XV[3][0], XV[3][1]} + a2; a2 = __builtin_amdgcn_cvt_pk_f32_fp8((int)LDV.w, true) * (f32x2){XV[3][2], XV[3][3]} + a2; } while (0)
#define PEER_AXPY(LDV, hh, ya) do { \
        ya[0] = __builtin_amdgcn_cvt_pk_f32_fp8((int)LDV.x, false) * hh + ya[0]; ya[1] = __builtin_amdgcn_cvt_pk_f32_fp8((int)LDV.x, true) * hh + ya[1]; \
        ya[2] = __builtin_amdgcn_cvt_pk_f32_fp8((int)LDV.y, false) * hh + ya[2]; ya[3] = __builtin_amdgcn_cvt_pk_f32_fp8((int)LDV.y, true) * hh + ya[3]; \
        ya[4] = __builtin_amdgcn_cvt_pk_f32_fp8((int)LDV.z, false) * hh + ya[4]; ya[5] = __builtin_amdgcn_cvt_pk_f32_fp8((int)LDV.z, true) * hh + ya[5]; \
        ya[6] = __builtin_amdgcn_cvt_pk_f32_fp8((int)LDV.w, false) * hh + ya[6]; ya[7] = __builtin_amdgcn_cvt_pk_f32_fp8((int)LDV.w, true) * hh + ya[7]; } while (0)
#endif
    const GAS int* EXG = (const GAS int*)(C.ws + WS_EXG); const GAS float* CVG = (const GAS float*)(C.ws + WS_CVG);
    GAS bf16_t* XB = (GAS bf16_t*)(C.ws + WS_XB); GAS unsigned char* XB8 = (GAS unsigned char*)(C.ws + WS_XB8); GAS float* RS = (GAS float*)(C.ws + WS_RSTD); GAS float* OUT = (GAS float*)C.out;
    const int lane = C.lane, j8 = lane & 7, gidx = lane >> 3;
    LAS unsigned char* wl = C.lds + C.wave * 14464;
    LAS float* acc = (LAS float*)wl;
    LAS int* el = (LAS int*)(wl + 4096);
    LAS float* gl = (LAS float*)(wl + 8192);
    LAS float* ssl = (LAS float*)(wl + 12288);
    LAS float* rsl = (LAS float*)(wl + 14336);
    const int gw = C.bx * NWAVES + C.wave, NGW = C.G * NWAVES;
    for (int tbase = gw; tbase < T; tbase += 8 * NGW) {
        const int ntk = min(8, (T - tbase + NGW - 1) / NGW);
        for (int tk = 0; tk < ntk; ++tk) { const int token = tbase + tk * NGW; const GAS float* xrow = OUT + (size_t)token * D; float ss = 0.f;
#pragma unroll
            for (int q = 0; q < 8; ++q) { const f32x4 v = *(const GAS f32x4*)(xrow + q * 256 + lane * 4); ss += (v[0] * v[0] + v[1] * v[1]) + (v[2] * v[2] + v[3] * v[3]); }
            const float rstd = rsqrtf(wave_sum(ss) * (1.0f / D) + EPS);
            const int e0 = EXG[(size_t)token * 128 + lane], e1 = EXG[(size_t)token * 128 + 64 + lane];
            const float z0 = CVG[(size_t)token * 128 + lane] * rstd, z1 = CVG[(size_t)token * 128 + 64 + lane] * rstd;
            const float p0 = __expf(z0 - row_max_f32(z0)), p1 = __expf(z1 - row_max_f32(z1));
            el[tk * 128 + lane] = e0; el[tk * 128 + 64 + lane] = e1; gl[tk * 128 + lane] = p0 / row_sum_f32(p0); gl[tk * 128 + 64 + lane] = p1 / row_sum_f32(p1);
            acc[tk * 128 + lane] = 0.f; acc[tk * 128 + 64 + lane] = 0.f; ssl[tk * 64 + lane] = 0.f; if (lane == 0) rsl[tk] = rstd; }
        LDS_WAIT();
        {
            const int nit = 16 * ntk;
#define A_ISSUE(LD, XV, it) do { const int s_ = is_, tk_ = itk_; if ((it) < nit - 1) { if (++itk_ == ntk) { itk_ = 0; ++is_; } } \
                const GAS unsigned char* ub_ = U8 + s_ * PIECE + j8 * (PIECE / 8); const GAS float* xr_ = OUT + (size_t)(tbase + tk_ * NGW) * D + s_ * 128 + j8 * 16; \
                _Pragma("unroll") for (int i = 0; i < 16; ++i) { const unsigned e_ = (unsigned)el[tk_ * 128 + 8 * i + gidx]; LD[i] = *(const GAS ldv_t*)(ub_ + ((size_t)e_ << ROWSH)); } \
                XV[0] = *(const GAS f32x4*)xr_; XV[1] = *(const GAS f32x4*)(xr_ + 4); XV[2] = *(const GAS f32x4*)(xr_ + 8); XV[3] = *(const GAS f32x4*)(xr_ + 12); } while (0)
#define A_COMPUTE(LD, XV, it) do { if ((it) < nit) { const int tk_ = ctk_; if (++ctk_ == ntk) { ctk_ = 0; ++cs_; } float pa[8], pb[8]; \
                _Pragma("unroll") for (int i = 0; i < 16; ++i) { f32x2 a2 = {0.f, 0.f}; \
                    PEER_DOT(LD[i], XV, a2); \
                    if (i < 8) pa[i] = a2.x + a2.y; else pb[i - 8] = a2.x + a2.y; } \
                const float r0_ = treduce8(pa, lane), r1_ = treduce8(pb, lane); \
                LAS float* ap_ = acc + tk_ * 128 + 8 * j8 + gidx; ap_[0] += r0_; ap_[64] += r1_; } } while (0)
            ldv_t ldA[16], ldB[16]; f32x4 xA[4], xB[4]; int is_ = 0, itk_ = 0, cs_ = 0, ctk_ = 0;
            A_ISSUE(ldA, xA, 0);
            for (int it = 0; it < nit; it += 2) {
                A_ISSUE(ldB, xB, it + 1); A_COMPUTE(ldA, xA, it);
                A_ISSUE(ldA, xA, it + 2); A_COMPUTE(ldB, xB, it + 1);
            }
#undef A_ISSUE
#undef A_COMPUTE
        }
        LDS_WAIT();
        for (int tk = 0; tk < ntk; ++tk) { const float rstd = rsl[tk];
#pragma unroll
            for (int m = 0; m < 2; ++m) { const int k = tk * 128 + m * 64 + lane; acc[k] = gelu_erf(acc[k] * rstd * INV_SU) * gl[k] * INV_SV; } }
        LDS_WAIT();
        {
            const int nit = 16 * ntk;
#define Y_ISSUE(LD, XV, it) do { const int s_ = is_, tk_ = itk_; if ((it) < nit - 1) { if (++itk_ == ntk) { itk_ = 0; ++is_; } } \
                const GAS unsigned char* vb_ = V8 + s_ * PIECE + j8 * (PIECE / 8); \
                _Pragma("unroll") for (int i = 0; i < 16; ++i) { const unsigned e_ = (unsigned)el[tk_ * 128 + 8 * i + gidx]; LD[i] = *(const GAS ldv_t*)(vb_ + ((size_t)e_ << ROWSH)); } \
                XV = *(const GAS f32x2*)(OUT + (size_t)(tbase + tk_ * NGW) * D + s_ * 128 + j8 * 16 + 2 * gidx); } while (0)
#define Y_COMPUTE(LD, XV, it) do { if ((it) < nit) { const int s_ = cs_, tk_ = ctk_; if (++ctk_ == ntk) { ctk_ = 0; ++cs_; } const size_t xo_ = (size_t)(tbase + tk_ * NGW) * D + s_ * 128 + j8 * 16 + 2 * gidx; \
                f32x2 ya[8]; _Pragma("unroll") for (int q = 0; q < 8; ++q) ya[q] = (f32x2){0.f, 0.f}; \
                _Pragma("unroll") for (int i = 0; i < 16; ++i) { const float hk = acc[tk_ * 128 + 8 * i + gidx]; const f32x2 hh = {hk, hk}; \
                    PEER_AXPY(LD[i], hh, ya); } \
                const bool b5 = lane & 32, b4 = lane & 16, b3 = lane & 8; float y8[8], y4[4], y2[2]; \
                _Pragma("unroll") for (int q = 0; q < 4; ++q) { y8[2 * q] = xsel_add_shfl(b5, ya[q].x, ya[q + 4].x, 32); y8[2 * q + 1] = xsel_add_shfl(b5, ya[q].y, ya[q + 4].y, 32); } \
                _Pragma("unroll") for (int q = 0; q < 4; ++q) y4[q] = xsel_add_shfl(b4, y8[q], y8[q + 4], 16); \
                _Pragma("unroll") for (int q = 0; q < 2; ++q) y2[q] = xsel_add<0x128>(b3, y4[q], y4[q + 2]); \
                f32x2 xn; xn.x = XV.x + y2[0]; xn.y = XV.y + y2[1]; \
                if (!dry) { *(GAS f32x2*)(OUT + xo_) = xn; if (!last) { *(GAS unsigned*)(XB + xo_) = pk2(xn.x, xn.y); *(GAS unsigned short*)(XB8 + xo_) = (unsigned short)__builtin_amdgcn_cvt_pk_fp8_f32(fminf(fmaxf(xn.x, -448.f), 448.f), fminf(fmaxf(xn.y, -448.f), 448.f), 0, false); } } \
                ssl[tk_ * 64 + lane] += xn.x * xn.x + xn.y * xn.y; } } while (0)
            ldv_t ldA[16], ldB[16]; f32x2 xA, xB; int is_ = 0, itk_ = 0, cs_ = 0, ctk_ = 0;
            Y_ISSUE(ldA, xA, 0);
            for (int it = 0; it < nit; it += 2) {
                Y_ISSUE(ldB, xB, it + 1); Y_COMPUTE(ldA, xA, it);
                Y_ISSUE(ldA, xA, it + 2); Y_COMPUTE(ldB, xB, it + 1);
            }
#undef Y_ISSUE
#undef Y_COMPUTE
        }
        LDS_WAIT();
        for (int tk = 0; tk < ntk; ++tk) { const int token = tbase + tk * NGW;
            const float rstd2 = rsqrtf(wave_sum(ssl[tk * 64 + lane]) * (1.0f / D) + EPS);
            if (dry) { if (rstd2 == 12345.678f) RS[token] = rstd2; }
            else if (!last) { if (lane == 0) RS[token] = rstd2; }
            else { VM_WAIT(); const GAS float* fg = (const GAS float*)inptr(C, 19); GAS float* orow = OUT + (size_t)token * D;
#pragma unroll
                for (int q = 0; q < 8; ++q) { const f32x4 v = *(const GAS f32x4*)(orow + q * 256 + lane * 4), g = *(const GAS f32x4*)(fg + q * 256 + lane * 4); f32x4 o = v * rstd2; o = o * g; *(GAS f32x4*)(orow + q * 256 + lane * 4) = o; } } }
        LDS_WAIT();
    }
}

#undef PEER_DOT
#undef PEER_AXPY

#define F4CVT(w, k) __builtin_amdgcn_cvt_scalef32_pk_f32_fp4((w), 1.0f, (k))
__device__ __forceinline__ void peer_sweep4(const Ctx& C, int l, bool last, bool dry = false) {
    const GAS unsigned char* U4 = (const GAS unsigned char*)(C.ws + WS_U + (size_t)l * NEXP * (D / 2)); const GAS unsigned char* V4 = (const GAS unsigned char*)(C.ws + WS_V + (size_t)l * NEXP * (D / 2));
    const GAS int* EXG = (const GAS int*)(C.ws + WS_EXG); const GAS float* CVG = (const GAS float*)(C.ws + WS_CVG);
    GAS bf16_t* XB = (GAS bf16_t*)(C.ws + WS_XB); GAS unsigned char* XB8 = (GAS unsigned char*)(C.ws + WS_XB8); GAS float* RS = (GAS float*)(C.ws + WS_RSTD); GAS float* OUT = (GAS float*)C.out;
    const int lane = C.lane, j8 = lane & 7, gidx = lane >> 3;
    LAS unsigned char* wl = C.lds + C.wave * 19584;
    LAS float* acc = (LAS float*)wl; LAS int* el = (LAS int*)(wl + 4096); LAS float* gl = (LAS float*)(wl + 8192); LAS unsigned char* vtile = wl + 8192; LAS float* ssl = (LAS float*)(wl + 16384); LAS float* rsl = (LAS float*)(wl + 18432);
    LAS unsigned char* hp = wl + 18496; LAS float* hsc = (LAS float*)(wl + 19520);
    const int gw = C.bx * NWAVES + C.wave, NGW = C.G * NWAVES;
    constexpr float INV_SU = 1.0f / SCALE_U4, INV_SV = 1.0f / SCALE_V4;
    for (int tbase = gw; tbase < T; tbase += 8 * NGW) {
        const int ntk = min(8, (T - tbase + NGW - 1) / NGW);
        {
            u32x2 nxw[8]; int ne0, ne1; float nc0, nc1;
#define SETUP_LOAD(tk_) do { const int tkn_ = min((tk_), ntk - 1); const int tokn_ = tbase + tkn_ * NGW; \
                _Pragma("unroll") for (int q = 0; q < 8; ++q) nxw[q] = *(const GAS u32x2*)(XB + (size_t)tokn_ * D + q * 256 + lane * 4); \
                ne0 = EXG[(size_t)tokn_ * 128 + lane]; ne1 = EXG[(size_t)tokn_ * 128 + 64 + lane]; nc0 = CVG[(size_t)tokn_ * 128 + lane]; nc1 = CVG[(size_t)tokn_ * 128 + 64 + lane]; } while (0)
            SETUP_LOAD(0);
            for (int tk = 0; tk < ntk; ++tk) { const int token = tbase + tk * NGW; float ss = 0.f; f32x4 xr8[8];
#pragma unroll
                for (int q = 0; q < 8; ++q) { const u32x2 wv = nxw[q]; const f32x4 v = {bflo(wv.x), bfhi(wv.x), bflo(wv.y), bfhi(wv.y)}; xr8[q] = v; ss += (v[0] * v[0] + v[1] * v[1]) + (v[2] * v[2] + v[3] * v[3]); }
                const int e0 = ne0, e1 = ne1; const float c0 = nc0, c1 = nc1;
                SETUP_LOAD(tk + 1);
                const float rstd = rsqrtf(wave_sum(ss) * (1.0f / D) + EPS);
                {
                    const float st = 2.0f * rstd; GAS unsigned short* xh = (GAS unsigned short*)(C.ws + WS_XH4 + (size_t)token * (D / 2)) + lane; GAS unsigned short* xl = (GAS unsigned short*)(C.ws + WS_XL4 + (size_t)token * (D / 2)) + lane;
#pragma unroll
                    for (int q = 0; q < 8; ++q) { const f32x4 xs = xr8[q] * st; unsigned ph = 0u, pl = 0u;
                        ph = __builtin_amdgcn_cvt_scalef32_pk_fp4_f32(ph, xs[0], xs[1], 1.0f, 0); ph = __builtin_amdgcn_cvt_scalef32_pk_fp4_f32(ph, xs[2], xs[3], 1.0f, 1);
                        const f32x2 d0 = __builtin_amdgcn_cvt_scalef32_pk_f32_fp4(ph, 1.0f, 0), d1 = __builtin_amdgcn_cvt_scalef32_pk_f32_fp4(ph, 1.0f, 1);
                        pl = __builtin_amdgcn_cvt_scalef32_pk_fp4_f32(pl, 8.f * (xs[0] - d0.x), 8.f * (xs[1] - d0.y), 1.0f, 0); pl = __builtin_amdgcn_cvt_scalef32_pk_fp4_f32(pl, 8.f * (xs[2] - d1.x), 8.f * (xs[3] - d1.y), 1.0f, 1);
                        xh[q * 64] = (unsigned short)ph; xl[q * 64] = (unsigned short)pl; } }
                const float z0 = c0 * rstd, z1 = c1 * rstd;
                const float p0 = __expf(z0 - row_max_f32(z0)), p1 = __expf(z1 - row_max_f32(z1));
                el[tk * 128 + lane] = e0; el[tk * 128 + 64 + lane] = e1; gl[tk * 128 + lane] = p0 / row_sum_f32(p0); gl[tk * 128 + 64 + lane] = p1 / row_sum_f32(p1);
                acc[tk * 128 + lane] = 0.f; acc[tk * 128 + 64 + lane] = 0.f; ssl[tk * 64 + lane] = 0.f; if (lane == 0) rsl[tk] = rstd; }
#undef SETUP_LOAD
        }
        LDS_WAIT(); VM_WAIT();
        {
            const int nit = 8 * ntk, m16 = lane & 15, kc = lane >> 4;
            int is_ = 0, itk_ = 0, ctk_ = 0;
            const GAS unsigned char* XB8r = (const GAS unsigned char*)(C.ws + WS_XB8);
#define A4_ISSUE(LD, H, XV, WITHX) do { const GAS unsigned char* ub_ = U4 + is_ * 128 + (m16 & 1) * 64 + kc * 16; \
                _Pragma("unroll") for (int i = 0; i < 8; ++i) { const unsigned e_ = (unsigned)el[itk_ * 128 + 8 * (8 * (H) + i) + (m16 >> 1)]; LD[i] = *(const GAS u32x4*)(ub_ + ((size_t)e_ << 10)); } \
                if (WITHX) { const size_t xo_ = (size_t)(tbase + itk_ * NGW) * (D / 2) + is_ * 128 + (m16 & 1) * 64 + kc * 16; XV[0] = *(const GAS u32x4*)(XB8r + (WS_XH4 - WS_XB8) + xo_); XV[1] = *(const GAS u32x4*)(XB8r + (WS_XL4 - WS_XB8) + xo_); } } while (0)
#define A4_ADVANCE(it) do { if ((it) < nit - 1) { if (++itk_ == ntk) { itk_ = 0; ++is_; } } } while (0)
#define A4_COMPUTE(LD, XV, H) do { const pg8::pg8_v4i h4_ = __builtin_bit_cast(pg8::pg8_v4i, XV[0]), q4_ = __builtin_bit_cast(pg8::pg8_v4i, XV[1]); \
                const pg8::pg8_v8i xh_ = __builtin_shufflevector(h4_, h4_, 0, 1, 2, 3, 4, 5, 6, 7), xl_ = __builtin_shufflevector(q4_, q4_, 0, 1, 2, 3, 4, 5, 6, 7); \
                _Pragma("unroll") for (int i = 0; i < 8; ++i) { const pg8::pg8_v4i l4_ = __builtin_bit_cast(pg8::pg8_v4i, LD[i]); const pg8::pg8_v8i ua_ = __builtin_shufflevector(l4_, l4_, 0, 1, 2, 3, 4, 5, 6, 7); \
                    f32x4 r_ = __builtin_amdgcn_mfma_scale_f32_16x16x128_f8f6f4(ua_, xl_, (f32x4){0.f, 0.f, 0.f, 0.f}, 4, 4, 0, 0, 0, 0); r_ = r_ * 0.125f; \
                    r_ = __builtin_amdgcn_mfma_scale_f32_16x16x128_f8f6f4(ua_, xh_, r_, 4, 4, 0, 0, 0, 0); \
                    const float t1_ = dpp_f<0xB1>(r_[1]), t3_ = dpp_f<0xB1>(r_[3]); \
                    if (m16 == 0) { LAS f32x2* ap_ = (LAS f32x2*)(acc + ctk_ * 128 + 8 * (8 * (H) + i) + 2 * kc); f32x2 o_ = *ap_; o_.x += r_[0] + t1_; o_.y += r_[2] + t3_; *ap_ = o_; } } } while (0)
#define A4_FINISH() do { if (++ctk_ == ntk) ctk_ = 0; } while (0)
            u32x4 lda[8], ldb[8], x0[2], x1[2];
            A4_ISSUE(lda, 0, x0, true);
            for (int it = 0; it < nit; it += 2) {
                A4_ISSUE(ldb, 1, x0, false); A4_ADVANCE(it);      A4_COMPUTE(lda, x0, 0);
                A4_ISSUE(lda, 0, x1, true);                        A4_COMPUTE(ldb, x0, 1); A4_FINISH();
                A4_ISSUE(ldb, 1, x1, false); A4_ADVANCE(it + 1);  A4_COMPUTE(lda, x1, 0);
                A4_ISSUE(lda, 0, x0, true);                        A4_COMPUTE(ldb, x1, 1); A4_FINISH();
            }
#undef A4_ISSUE
#undef A4_ADVANCE
#undef A4_COMPUTE
#undef A4_FINISH
        }
        LDS_WAIT();
        for (int tk = 0; tk < ntk; ++tk) {
            const int k = tk * 128 + 2 * lane; const f32x2 av = *(LAS f32x2*)(acc + k), gv = *(LAS f32x2*)(gl + k);
            const float h0 = gelu_erf(av.x * (0.5f * INV_SU)) * gv.x * INV_SV, h1 = gelu_erf(av.y * (0.5f * INV_SU)) * gv.y * INV_SV;
            const float mx = wave_max(fmaxf(fabsf(h0), fabsf(h1))), s = mx > 0.f ? 6.0f / mx : 0.f, a0 = h0 * s, a1 = h1 * s;
            const unsigned ph = __builtin_amdgcn_cvt_scalef32_pk_fp4_f32(0u, a0, a1, 1.0f, 0); const f32x2 dh = __builtin_amdgcn_cvt_scalef32_pk_f32_fp4(ph, 1.0f, 0);
            const unsigned pl = __builtin_amdgcn_cvt_scalef32_pk_fp4_f32(0u, 8.f * (a0 - dh.x), 8.f * (a1 - dh.y), 1.0f, 0);
            hp[tk * 128 + lane] = (unsigned char)ph; hp[tk * 128 + 64 + lane] = (unsigned char)pl; if (lane == 0) hsc[tk] = mx * (1.0f / 6.0f); }
        LDS_WAIT();
        {
            const int nit = 8 * ntk;
            int is_ = 0, itk_ = 0, cs_ = 0, ctk_ = 0;
#define Y4_ISSUE(LD, H, XV, WITHX) do { const GAS unsigned char* vb_ = V4 + is_ * 128 + j8 * 16; \
                _Pragma("unroll") for (int i = 0; i < 8; ++i) { const unsigned e_ = (unsigned)el[itk_ * 128 + 8 * (8 * (H) + i) + gidx]; LD[i] = *(const GAS u32x4*)(vb_ + ((size_t)e_ << 10)); } \
                if (WITHX) { const GAS bf16_t* xp_ = XB + (size_t)(tbase + itk_ * NGW) * D + is_ * 256 + lane; \
                    _Pragma("unroll") for (int p = 0; p < 4; ++p) XV[p] = bf2f(xp_[64 * p]); } } while (0)
#define Y4_ADVANCE(it) do { if ((it) < nit - 1) { if (++itk_ == ntk) { itk_ = 0; ++is_; } } } while (0)
#define Y4_COMPUTE(LD, H) do { \
                _Pragma("unroll") for (int i = 0; i < 8; ++i) *(LAS u32x4*)(vtile + (8 * i + gidx) * 128 + ((j8 ^ ((4 * (i & 1) + (gidx >> 1)) & 7)) * 16)) = LD[i]; \
                const int m32_ = lane & 31, kg_ = lane >> 5, li_ = lane & 15, grp_ = (lane >> 4) & 1; \
                pg8::pg8_v4i ha_ = {0, 0, 0, 0}; if (m32_ < 2) ha_ = *(const LAS pg8::pg8_v4i*)(hp + ctk_ * 128 + m32_ * 64 + 32 * (H) + 16 * kg_); \
                const pg8::pg8_v8i ha8_ = __builtin_shufflevector(ha_, ha_, 0, 1, 2, 3, 4, 5, 6, 7); \
                LDS_WAIT(); \
                const LAS unsigned char* tb_ = vtile + (32 * kg_ + li_) * 128 + grp_ * 8; const int sw_ = li_ >> 1; \
                _Pragma("unroll") for (int bk = 0; bk < 8; ++bk) { \
                    const v2i_t t0_ = __builtin_amdgcn_ds_read_tr4_b64_v2i32((LAS v2i_t*)(tb_ + ((bk ^ sw_) * 16))), t1_ = __builtin_amdgcn_ds_read_tr4_b64_v2i32((LAS v2i_t*)(tb_ + 16 * 128 + ((bk ^ sw_) * 16))); \
                    const pg8::pg8_v8i vb8_ = {t0_.x, t0_.y, t1_.x, t1_.y, 0, 0, 0, 0}; \
                    const f32x16 d_ = __builtin_amdgcn_mfma_scale_f32_32x32x64_f8f6f4(ha8_, vb8_, (f32x16){0.f, 0.f, 0.f, 0.f, 0.f, 0.f, 0.f, 0.f, 0.f, 0.f, 0.f, 0.f, 0.f, 0.f, 0.f, 0.f}, 4, 4, 0, 0, 0, 0); \
                    yb[bk] += d_[0] + d_[1] * 0.125f; } \
                LDS_WAIT(); } while (0)
#define Y4_FINISH(XV, it) do { if ((it) < nit) { const size_t xo_ = (size_t)(tbase + ctk_ * NGW) * D + cs_ * 256 + lane; const float hs_ = hsc[ctk_]; float sq_ = 0.f; \
                _Pragma("unroll") for (int p = 0; p < 4; ++p) { const float up_ = __shfl(yb[2 * p + 1], lane & 31); const float xn = XV[p] + (lane < 32 ? yb[2 * p] : up_) * hs_; \
                    if (!dry) { XB[xo_ + 64 * p] = (bf16_t)pk2(xn, 0.f);     \
                        if (!last) { const int pk = __builtin_amdgcn_cvt_pk_fp8_f32(fminf(fmaxf(xn, -448.f), 448.f), 0.f, 0, false); XB8[xo_ + 64 * p] = (unsigned char)pk; } } \
                    sq_ += xn * xn; } \
                ssl[ctk_ * 64 + lane] += sq_; } \
                _Pragma("unroll") for (int q = 0; q < 8; ++q) yb[q] = 0.f; \
                if (++ctk_ == ntk) { ctk_ = 0; ++cs_; } } while (0)
            u32x4 lda[8], ldb[8]; f32x4 x0, x1; float yb[8];
#pragma unroll
            for (int q = 0; q < 8; ++q) yb[q] = 0.f;
            Y4_ISSUE(lda, 0, x0, true);
            for (int it = 0; it < nit; it += 2) {
                Y4_ISSUE(ldb, 1, x0, false); Y4_ADVANCE(it);      Y4_COMPUTE(lda, 0);
                Y4_ISSUE(lda, 0, x1, true);                        Y4_COMPUTE(ldb, 1); Y4_FINISH(x0, it);
                Y4_ISSUE(ldb, 1, x1, false); Y4_ADVANCE(it + 1);  Y4_COMPUTE(lda, 0);
                Y4_ISSUE(lda, 0, x0, true);                        Y4_COMPUTE(ldb, 1); Y4_FINISH(x1, it + 1);
            }
#undef Y4_ISSUE
#undef Y4_ADVANCE
#undef Y4_COMPUTE
#undef Y4_FINISH
        }
        LDS_WAIT();
        if (!last || dry) {
            for (int tk = 0; tk < ntk; ++tk) { const float rstd2 = rsqrtf(wave_sum(ssl[tk * 64 + lane]) * (1.0f / D) + EPS);
                if (dry) { if (rstd2 == 12345.678f) RS[tbase + tk * NGW] = rstd2; } else if (lane == 0) RS[tbase + tk * NGW] = rstd2; } }
        else {
            VM_WAIT(); const GAS float* fg = (const GAS float*)inptr(C, 19);
            f32x4 gq[8]; u32x2 nr[8];
#pragma unroll
            for (int q = 0; q < 8; ++q) { gq[q] = *(const GAS f32x4*)(fg + q * 256 + lane * 4); nr[q] = *(const GAS u32x2*)(XB + (size_t)tbase * D + q * 256 + lane * 4); }
            for (int tk = 0; tk < ntk; ++tk) { GAS float* orow = OUT + (size_t)(tbase + tk * NGW) * D; f32x4 cr[8];
#pragma unroll
                for (int q = 0; q < 8; ++q) cr[q] = (f32x4){bflo(nr[q].x), bfhi(nr[q].x), bflo(nr[q].y), bfhi(nr[q].y)};
                { const GAS bf16_t* nrow = XB + (size_t)(tbase + min(tk + 1, ntk - 1) * NGW) * D;
#pragma unroll
                  for (int q = 0; q < 8; ++q) nr[q] = *(const GAS u32x2*)(nrow + q * 256 + lane * 4); }
                const float rstd2 = rsqrtf(wave_sum(ssl[tk * 64 + lane]) * (1.0f / D) + EPS);
#pragma unroll
                for (int q = 0; q < 8; ++q) { f32x4 o = cr[q] * rstd2; o = o * gq[q]; *(GAS f32x4*)(orow + q * 256 + lane * 4) = o; } } }
        LDS_WAIT();
    }
}
#undef F4CVT

constexpr int NPHASE = 1 + 8 * DEPTH - 1;
struct Args { const float* in[20]; float* out; unsigned char* ws; int ph_lo, ph_hi; };

__global__ void __launch_bounds__(NTHR, 2) fwd(Args args) {
    extern __shared__ __attribute__((aligned(16))) unsigned char lds_raw[];
    Ctx C;
    C.lds = (LAS unsigned char*)lds_raw; C.tid = threadIdx.x; C.lane = C.tid & 63; C.wave = __builtin_amdgcn_readfirstlane(C.tid >> 6); C.G = gridDim.x; C.bx = blockIdx.x;
    C.out = args.out; C.ws = args.ws;
    PG8_LAS unsigned char* lds = (PG8_LAS unsigned char*)lds_raw;
    volatile LAS unsigned* MISC = (volatile LAS unsigned*)(lds + MISC_OFF);
    for (int u = C.tid; u < (LDS_BYTES - TOP_OFF) / 4; u += NTHR) ((LAS unsigned*)(lds + TOP_OFF))[u] = 0u;
    __syncthreads();
    if (C.tid < 20) { const unsigned long long pv = (unsigned long long)args.in[C.tid]; LAS unsigned* p = (LAS unsigned*)(lds + PTR_OFF) + 2 * C.tid; p[0] = (unsigned)pv; p[1] = (unsigned)(pv >> 32); }
    __syncthreads();
    const int lo = args.ph_lo, hi = args.ph_hi;
    unsigned* barw = (unsigned*)(C.ws + WS_CTL) + CW_BAR;
    XcdBarrier bar; bar.bar = barw; bar.x = 0; bar.st = nullptr;
    if (hi - lo > 1) bar = xcd_barrier_post(barw, MISC + 8);
#ifndef PH_MASK
#define PH_MASK 0xFF
#endif
#define PHEN(i) (((PH_MASK) >> (i)) & 1)
#define IN(k) (lo <= (k) && (k) < hi)
#define SEAM(k) do { if (IN(k) && IN((k) + 1)) { xcd_barrier(bar); if (PROBE_DUP == 12) xcd_barrier(bar); } } while (0)

#define PHASE_CTX() Ctx P; P.lds = C.lds; P.out = C.out; P.ws = C.ws; P.G = C.G; P.bx = C.bx; P.tid = C.tid; \
    asm volatile("" : "+s"(P.out), "+s"(P.ws), "+s"(P.G), "+s"(P.bx), "+v"(P.tid)); \
    P.out = (float*)(GAS float*)P.out; P.ws = (unsigned char*)(GAS unsigned char*)P.ws; P.lane = P.tid & 63; P.wave = __builtin_amdgcn_readfirstlane(P.tid >> 6)
    if (PHEN(0) && IN(0)) { { PHASE_CTX(); prologue(P); } if (PROBE_DUP == 3) { __syncthreads(); PHASE_CTX(); prologue(P); } SEAM(0); }
    for (int l = 0; l < DEPTH; ++l) {
        const int base = 1 + 8 * l;
        if (PHEN(1) && IN(base + 0)) {
            { PHASE_CTX();
              constexpr int NG8 = INW - G1_NBF, U8 = (T / 256) * (NG8 / 256);
              pg8::Gemm g{(const bf16_t*)(P.ws + WS_XB8), (const bf16_t*)(P.ws + WS_WIN8), T, NG8, D / 2}; SplitOrder S; S.init(T, NG8, P.G, P.bx);
              { const int rem = 1920 % P.G;
                if (G1_NBF == 7680 && P.G == 256 && rem == 128) { S.cut = 128; S.nA = 5; S.nB = 7; }
                else if (G1_NBF == 3072 && P.G == 256) { S.cut = 128; S.nA = 9; S.nB = 12; }
                else { S.cut = 0; S.nA = 0; S.nB = (U8 + P.G - 1) / P.G; } }
              static_assert(G1_NBF == 3072, "EpiG1B: the fp8 call holds exactly the q/k/v and gate columns");
              EpiG1B E{P.ws + WS_PQKV, P.ws + WS_PG, (const float*)(P.ws + WS_RSTD), G1_NBF / 256, 1.0f / 1024.0f};
              pg8::gemm_phase<EpiG1B, SplitOrder, false, true>(lds, g, S, E, nullptr);
              if (PROBE_DUP == 2 || PROBE_DUP == 13) { __syncthreads(); pg8::gemm_phase<EpiG1B, SplitOrder, false, true>(lds, g, S, E, nullptr); } }
            __syncthreads();
            if (G1_NBF > 0) { PHASE_CTX();
              pg8::Gemm g{(const bf16_t*)(P.ws + WS_XB), (const bf16_t*)(P.ws + WS_WIN), T, G1_NBF, D}; SplitOrder S; S.init(T, G1_NBF, P.G, P.bx);
              if (G1_NBF == 3072 && P.G == 256) { S.cut = 128; S.nA = 4; S.nB = 2; } else { S.cut = 0; S.nA = 0; S.nB = ((T / 256) * (G1_NBF / 256) + P.G - 1) / P.G; }
              EpiG1 E{(bf16_t*)(P.ws + WS_PA), (bf16_t*)(P.ws + WS_PB), (bf16_t*)(P.ws + WS_PQKV), (bf16_t*)(P.ws + WS_PG), (const float*)(P.ws + WS_RSTD), 0, 1.0f};
              pg8::gemm_phase<EpiG1, SplitOrder, false>(lds, g, S, E, nullptr);
              if (PROBE_DUP == 2) { __syncthreads(); pg8::gemm_phase<EpiG1, SplitOrder, false>(lds, g, S, E, nullptr); } }
            SEAM(base + 0);
        }
        if (PHEN(2) && IN(base + 1)) {
#ifdef ATT_NAIVE
            PHASE_CTX(); att_naive(P); vss_rows(P);
#else
            { PHASE_CTX(); att_mfma(P, BG_TABLES && BG_TABLES0 && l == 0 && P.G == 256); } { PHASE_CTX(); vss_rows(P); }
            if (PROBE_DUP == 5) { { PHASE_CTX(); att_mfma(P); } { PHASE_CTX(); vss_rows(P); } }
#endif
            SEAM(base + 1); }
        if (PHEN(3) && IN(base + 2)) {
#ifdef MIXA_NAIVE
            { PHASE_CTX(); mixa_naive(P, l); }
#else
            { PHASE_CTX(); mixa_mfma(P, l, BG_TABLES && BG_TABLES0 && l == 0 && P.G == 256); }
#endif
#ifdef MIXB_NAIVE
            { PHASE_CTX(); mixb_naive(P); }
#else
            { PHASE_CTX(); mixb_mfma(P, BG_TABLES && BG_TABLES0 && l == 0 && P.G == 256); }
#endif
            { PHASE_CTX(); combine_groups(P, BG_TABLES && BG_TABLES0 && l == 0 && P.G == 256); }
            if (PROBE_DUP == 6) { { PHASE_CTX(); mixa_mfma(P, l); } { PHASE_CTX(); mixb_mfma(P); } { PHASE_CTX(); combine_groups(P); } }
            SEAM(base + 2); }
        if (PHEN(4) && IN(base + 3)) {
            PHASE_CTX();
            pg8::Gemm g{(const bf16_t*)(P.ws + WS_YA), (const bf16_t*)(P.ws + WS_WA), T, D, BR8 ? 1280 : 2560}; pg8::StaticOrder S; S.init(T, D, P.G, P.bx);
            EpiBranchF<BR8> E{(bf16_t*)(P.ws + WS_PA), (const unsigned char*)(P.ws + WS_PG)};
            pg8::gemm_phase<EpiBranchF<BR8>, pg8::StaticOrder, false, BR8 != 0>(lds, g, S, E, nullptr);
            if (PROBE_DUP == 7) { __syncthreads(); pg8::gemm_phase<EpiBranchF<BR8>, pg8::StaticOrder, false, BR8 != 0>(lds, g, S, E, nullptr); }
            SEAM(base + 3);
        }
        if (PHEN(5) && IN(base + 4)) {
            PHASE_CTX();
            pg8::Gemm g{(const bf16_t*)(P.ws + WS_PA), (const bf16_t*)(P.ws + WS_WOUT), T, D, D}; pg8::StaticOrder S; S.init(T, D, P.G, P.bx);
            const float* xin0 = inptr(P, 0);
            if (l == 0) { EpiWout<0> E{xin0, P.out, (bf16_t*)(P.ws + WS_XB), P.ws + WS_XB8}; pg8::gemm_phase<EpiWout<0>, pg8::StaticOrder, false>(lds, g, S, E, nullptr);
                if (PROBE_DUP == 10) { __syncthreads(); pg8::gemm_phase<EpiWout<0>, pg8::StaticOrder, false>(lds, g, S, E, nullptr); } }
            else { EpiWout<1> E{xin0, P.out, (bf16_t*)(P.ws + WS_XB), P.ws + WS_XB8}; pg8::gemm_phase<EpiWout<1>, pg8::StaticOrder, false>(lds, g, S, E, nullptr); }
            SEAM(base + 4);
        }
        if (PHEN(6) && IN(base + 5)) {
            PHASE_CTX();
            pg8::Gemm g{(const bf16_t*)(P.ws + WS_XB), (const bf16_t*)(P.ws + WS_WSC), T, D, D}; pg8::StaticOrder S; S.init(T, D, P.G, P.bx);
            EpiScoreBf16 E{(bf16_t*)(P.ws + WS_PQKV)};
            pg8::gemm_phase<EpiScoreBf16, pg8::StaticOrder, false>(lds, g, S, E, nullptr);
            if (PROBE_DUP == 8) { __syncthreads(); pg8::gemm_phase<EpiScoreBf16, pg8::StaticOrder, false>(lds, g, S, E, nullptr); }
            if (PROBE_DUP == 15) { __syncthreads(); pg8::Gemm g2{(const bf16_t*)(P.ws + WS_XB), (const bf16_t*)(P.ws + WS_WSC), T, 2 * D, D / 2}; pg8::StaticOrder S2; S2.init(T, 2 * D, P.G, P.bx); EpiScoreBf16 E2{(bf16_t*)(P.ws + WS_PA)}; pg8::gemm_phase<EpiScoreBf16, pg8::StaticOrder, false>(lds, g2, S2, E2, nullptr); }
            if (PROBE_DUP == 16) { __syncthreads(); pg8::Gemm g2{(const bf16_t*)(P.ws + WS_XB), (const bf16_t*)(P.ws + WS_WSC), T, 2 * D, D / 2}; pg8::StaticOrder S2; S2.init(T, 2 * D, P.G, P.bx); EpiNull E2; pg8::gemm_phase<EpiNull, pg8::StaticOrder, false>(lds, g2, S2, E2, nullptr); }
            if (PROBE_DUP == 17) { __syncthreads(); pg8::Gemm g2{(const bf16_t*)(P.ws + WS_XB), (const bf16_t*)(P.ws + WS_WSC), T, 2 * D, D / 2}; pg8::StaticOrder S2; S2.init(T, 2 * D, P.G, P.bx); EpiHalf E2{(bf16_t*)(P.ws + WS_PA)}; pg8::gemm_phase<EpiHalf, pg8::StaticOrder, false>(lds, g2, S2, E2, nullptr); }
            if (PROBE_DUP == 18) { __syncthreads(); pg8::Gemm g2{(const bf16_t*)(P.ws + WS_XB), (const bf16_t*)(P.ws + WS_WSC), T, 2 * D, D / 2}; pg8::StaticOrder S2; S2.init(T, 2 * D, P.G, P.bx); EpiLocal E2{(bf16_t*)(P.ws + WS_PA)}; pg8::gemm_phase<EpiLocal, pg8::StaticOrder, false>(lds, g2, S2, E2, nullptr); }
            if (PROBE_DUP == 19) { __syncthreads(); pg8::Gemm g2{(const bf16_t*)(P.ws + WS_XB), (const bf16_t*)(P.ws + WS_WSC), T, 2 * D, D / 2}; pg8::StaticOrder S2; S2.init(T, 2 * D, P.G, P.bx); EpiContig E2{(bf16_t*)(P.ws + WS_PA)}; pg8::gemm_phase<EpiContig, pg8::StaticOrder, false>(lds, g2, S2, E2, nullptr); }
            if (PROBE_DUP == 20) { __syncthreads(); pg8::Gemm g2{(const bf16_t*)(P.ws + WS_XB), (const bf16_t*)(P.ws + WS_WSC), T, 2 * D, D / 2}; pg8::StaticOrder S2; S2.init(T, 2 * D, P.G, P.bx); EpiNT E2{(bf16_t*)(P.ws + WS_PA)}; pg8::gemm_phase<EpiNT, pg8::StaticOrder, false>(lds, g2, S2, E2, nullptr); }
            if (PROBE_DUP == 21) { __syncthreads(); pg8::Gemm g2{(const bf16_t*)(P.ws + WS_XB), (const bf16_t*)(P.ws + WS_WSC), T, 2 * D, D / 2}; pg8::StaticOrder S2; S2.init(T, 2 * D, P.G, P.bx); EpiRows8 E2{(bf16_t*)(P.ws + WS_PA)}; pg8::gemm_phase<EpiRows8, pg8::StaticOrder, false>(lds, g2, S2, E2, nullptr); }
            if (PROBE_DUP == 14) { __syncthreads(); pg8::Gemm g2{(const bf16_t*)(P.ws + WS_XB), (const bf16_t*)(P.ws + WS_WSC), T, D, D / 2}; EpiScoreBf16 E2{(bf16_t*)(P.ws + WS_PA)}; pg8::gemm_phase<EpiScoreBf16, pg8::StaticOrder, false>(lds, g2, S, E2, nullptr); }
            SEAM(base + 5);
        }
        if (PHEN(7) && IN(base + 6)) { { PHASE_CTX(); peer_topk_dpp(P, l + 1 < DEPTH ? l + 1 : -1); } if (PROBE_DUP == 4) { PHASE_CTX(); peer_topk_dpp(P); } VM_WAIT(); __syncthreads(); if (PROBE_DUP == 1) { PHASE_CTX(); peer_gather(P, l, l == DEPTH - 1, true); }
#ifdef PEER_ROWS
            { PHASE_CTX(); peer_gather(P, l, l == DEPTH - 1); }
#else
            if (PROBE_DUP == 11) { PHASE_CTX(); peer_sweep(P, l, l == DEPTH - 1, true); }
#if PEER_FP4
            if (PROBE_DUP == 11) { PHASE_CTX(); peer_sweep4(P, l, l == DEPTH - 1, true); }
            { PHASE_CTX(); peer_sweep4(P, l, l == DEPTH - 1); }
#else
            { PHASE_CTX(); peer_sweep(P, l, l == DEPTH - 1); }
#endif
#endif
            if (l + 1 < DEPTH) { if (IN(base + 7)) __syncthreads(); else SEAM(base + 6); } }
        if (PHEN(0) && l + 1 < DEPTH && IN(base + 7)) { { PHASE_CTX(); cvt_layer_weights(P, l + 1); } if (PROBE_DUP == 9) { __syncthreads(); PHASE_CTX(); cvt_layer_weights(P, l + 1); } SEAM(base + 7); }
    }
#undef IN
#undef SEAM
}
}

#ifndef MK_ONE_LAUNCH
#define MK_ONE_LAUNCH 1
#endif
extern "C" void kernel_launch(void* const* d_in, const int* in_sizes, int n_in, void* d_out, int out_size, void* d_ws, size_t ws_size, hipStream_t stream) {
    using namespace mk;
    static int grid = 0;
    if (grid == 0) {
        if (n_in != 20 || in_sizes[0] != T * D || out_size != T * D || ws_size < WS_END) { fprintf(stderr, "kernel_launch: unexpected shapes (n_in %d, in0 %d, out %d, ws %zu < %zu); nothing launched\n", n_in, n_in > 0 ? in_sizes[0] : -1, out_size, ws_size, (size_t)WS_END); grid = -1; return; }
        int dev = 0, cus = 0, per_cu = 0;
        if (hipGetDevice(&dev) != hipSuccess || hipDeviceGetAttribute(&cus, hipDeviceAttributeMultiprocessorCount, dev) != hipSuccess) { fprintf(stderr, "kernel_launch: device query failed\n"); grid = -1; return; }
        if (hipFuncSetAttribute((const void*)fwd, hipFuncAttributeMaxDynamicSharedMemorySize, LDS_BYTES) != hipSuccess) { fprintf(stderr, "kernel_launch: hipFuncSetAttribute failed\n"); grid = -1; return; }
        if (hipOccupancyMaxActiveBlocksPerMultiprocessor(&per_cu, (const void*)fwd, NTHR, LDS_BYTES) != hipSuccess || per_cu < 1) fprintf(stderr, "kernel_launch: note: occupancy query reports %d workgroups per CU\n", per_cu);
        (void)hipGetLastError();
        grid = cus;
    }
    if (grid < 0) return;
    if (hipMemsetAsync((char*)d_ws + WS_CTL, 0, CTL_ZERO_BYTES, stream) != hipSuccess) { fprintf(stderr, "kernel_launch: memset failed\n"); return; }
    Args a{};
    for (int i = 0; i < 20; ++i) a.in[i] = (const float*)d_in[i];
    a.out = (float*)d_out; a.ws = (unsigned char*)d_ws;
#if MK_ONE_LAUNCH
    a.ph_lo = 0; a.ph_hi = NPHASE;
    hipLaunchKernelGGL(fwd, dim3(grid), dim3(NTHR), LDS_BYTES, stream, a);
#else
    for (int p = 0; p < NPHASE; ++p) { a.ph_lo = p; a.ph_hi = p + 1; hipLaunchKernelGGL(fwd, dim3(grid), dim3(NTHR), LDS_BYTES, stream, a); }
#endif
    const hipError_t le = hipPeekAtLastError();
    if (le != hipSuccess) fprintf(stderr, "kernel_launch: launch failed: %s\n", hipGetErrorName(le));
}
```

```cpp
#include <hip/hip_runtime.h>
#include <cstdio>
#include <cstdint>
namespace pg8 {
#define PG8_LAS __attribute__((address_space(3)))
typedef unsigned short bf16_t;
typedef short bf16x8 __attribute__((ext_vector_type(8)));
typedef float f32x4 __attribute__((ext_vector_type(4)));
typedef unsigned u32x4 __attribute__((ext_vector_type(4)));
constexpr int BM = 256, BK = 64, HALF = 128, HTB = HALF * BK * 2  , STAGE_BYTES = 8 * HTB, NXCD = 8, WGM = 8;

__host__ __device__ __forceinline__ int lds_byte(int r, int c) { const int st = (r >> 4) * 2 + (c >> 5), rr = r & 15, cc = c & 31, ob = rr * 64 + cc * 2; return st * 1024 + (ob ^ (((ob >> 9) & 1) << 5)); }
__host__ __device__ __forceinline__ void stage_rc(int b, int& R, int& C) { const int st = b / 1024, sb = b % 1024, swz = sb ^ (((sb >> 9) & 1) << 5); R = (st >> 1) * 16 + swz / 64; C = (st & 1) * 32 + (swz % 64) / 2; }
__host__ __device__ __forceinline__ int perm32(int rho) { const int n = rho >> 4, i = rho & 15; return 8 * (i >> 2) + 4 * n + (i & 3); }
__host__ __device__ __forceinline__ int perm32b(int rho) { const int n = rho >> 4, i = rho & 15; return 16 * (i >> 2) + 4 * n + (i & 3); }

struct Unit { int pm, pn; };
struct Gemm { const bf16_t* A; const bf16_t* Bt; int M, N, K; };

struct StaticOrder {
    int nM, nN, nwg, G, c;
    __host__ __device__ void init(int M, int N, int G_, int c_) { nM = M / BM; nN = N / BM; nwg = nM * nN; G = G_; c = c_; }
    __host__ __device__ bool next(int i, Unit& u) const {
        const long L = (long)i * G + c; if (L >= nwg) return false;
        int wgid = (int)L; { const int q = nwg / NXCD, r = nwg % NXCD, xcd = wgid % NXCD, off = wgid / NXCD; wgid = (xcd < r ? xcd * (q + 1) : r * (q + 1) + (xcd - r) * q) + off; }
        const int nig = WGM * nN, gid = wgid / nig, fm = gid * WGM, gsz = (nM - fm) < WGM ? (nM - fm) : WGM;
        u.pm = fm + ((wgid % nig) % gsz); u.pn = (wgid % nig) / gsz; return true;
    }
    __device__ __forceinline__ void a_ready(const Unit&) const {}
    __device__ __forceinline__ void done(const Unit&) const {}
};
struct CountedOrder : StaticOrder {
    const unsigned* ready; unsigned need; unsigned* tmo;
    __device__ __forceinline__ void a_ready(const Unit& u) const {
        if (threadIdx.x < 64) {
            const unsigned long long t0 = __builtin_amdgcn_s_memrealtime(); unsigned polls = 0;
            while ((unsigned)__builtin_amdgcn_readfirstlane(__hip_atomic_load(ready + 64 * u.pm, __ATOMIC_RELAXED, __HIP_MEMORY_SCOPE_AGENT)) < need) {
                if ((++polls & 255u) == 0u && __builtin_amdgcn_readfirstlane(__hip_atomic_load(tmo, __ATOMIC_RELAXED, __HIP_MEMORY_SCOPE_AGENT)) != 0u) break;
                if (__builtin_amdgcn_s_memrealtime() - t0 > 2000000ull) {
                    if (threadIdx.x == 0) { unsigned expect = 0u; __hip_atomic_compare_exchange_strong(tmo + 1, &expect, 0x600u | (unsigned)(u.pm & 0xff), __ATOMIC_RELAXED, __ATOMIC_RELAXED, __HIP_MEMORY_SCOPE_AGENT); __hip_atomic_store(tmo, 1u, __ATOMIC_RELAXED, __HIP_MEMORY_SCOPE_AGENT); }
                    break; }
                __builtin_amdgcn_s_sleep(2); }
            __builtin_amdgcn_fence(__ATOMIC_ACQUIRE, "agent");
            asm volatile("s_waitcnt vmcnt(0)" ::: "memory");
        }
#if !defined(BROKEN_HOOK_NO_BARRIER)
        asm volatile("" ::: "memory"); __builtin_amdgcn_s_barrier(); asm volatile("" ::: "memory");
#endif
    }
};

__device__ __forceinline__ unsigned cvt_pk_bf16(float lo, float hi) { unsigned r; asm volatile("v_cvt_pk_bf16_f32 %0, %1, %2" : "=v"(r) : "v"(lo), "v"(hi)); return r; }
typedef float f32x2 __attribute__((ext_vector_type(2)));
__device__ __forceinline__ f32x2 gelu_pk(f32x2 v) {
    const f32x2 av = __builtin_elementwise_abs(v), d = av * 0.2316418882f + 1.0f;
    f32x2 t; t.x = __builtin_amdgcn_rcpf(d.x); t.y = __builtin_amdgcn_rcpf(d.y);
    f32x2 q = t * 0.5307027145f + (-0.7265760135f); q = q * t + 0.7107068705f; q = q * t + (-0.142248368f); q = q * t + 0.127414796f; q = q * t;
    const f32x2 s = (v * v) * (-0.72134752044f);
    f32x2 e; e.x = __builtin_amdgcn_exp2f(s.x); e.y = __builtin_amdgcn_exp2f(s.y);
    const f32x2 m = v * (q * e), r = v - m;
    f32x2 o; o.x = v.x < 0.f ? m.x : r.x; o.y = v.y < 0.f ? m.y : r.y; return o;
}

struct EpiF32 {
    static constexpr bool PERM = false, AFTER_DRAIN = false, HOOK = false;
    float* C; int ldc; const float* bias;
    __device__ __forceinline__ void operator()(const f32x4 (&acc)[2][2][4][2], const Unit& u, int wr, int wc, int fr, int fq) const {
        const int row0 = u.pm * BM + wr * 64 + fr, col0 = u.pn * BM + wc * 32 + 4 * fq;
        f32x4 bv[2][2];
#pragma unroll
        for (int bj = 0; bj < 2; ++bj)
#pragma unroll
            for (int n = 0; n < 2; ++n) bv[bj][n] = bias ? *(const f32x4*)(bias + col0 + bj * HALF + n * 16) : (f32x4){0.f, 0.f, 0.f, 0.f};
#pragma unroll
        for (int ai = 0; ai < 2; ++ai)
#pragma unroll
            for (int m = 0; m < 4; ++m) { float* rowp = C + (size_t)(row0 + ai * HALF + m * 16) * ldc + col0;
#pragma unroll
                for (int bj = 0; bj < 2; ++bj)
#pragma unroll
                    for (int n = 0; n < 2; ++n) *(f32x4*)(rowp + bj * HALF + n * 16) = acc[ai][bj][m][n] + bv[bj][n]; }
    }
};
template <int ACT  > struct EpiBf16 {
    static constexpr bool PERM = true, AFTER_DRAIN = false;
    bf16_t* O; int ldc; const float* bias; int split_cols; size_t split_stride;
    __device__ __forceinline__ void operator()(const f32x4 (&acc)[2][2][4][2], const Unit& u, int wr, int wc, int fr, int fq) const {
        const int row0 = u.pm * BM + wr * 64 + fr; int colt = u.pn * BM; bf16_t* base = O;
        if (split_cols) { const int t = colt / split_cols; base += (size_t)t * split_stride; colt -= t * split_cols; }
        const int col0 = colt + wc * 32 + 8 * fq, bcol0 = u.pn * BM + wc * 32 + 8 * fq;
        f32x4 bv[2][2];
#pragma unroll
        for (int bj = 0; bj < 2; ++bj)
#pragma unroll
            for (int n = 0; n < 2; ++n) bv[bj][n] = bias ? *(const f32x4*)(bias + bcol0 + bj * HALF + 4 * n) : (f32x4){0.f, 0.f, 0.f, 0.f};
#pragma unroll
        for (int ai = 0; ai < 2; ++ai)
#pragma unroll
            for (int m = 0; m < 4; ++m) { bf16_t* rowp = base + (size_t)(row0 + ai * HALF + m * 16) * ldc + col0;
#pragma unroll
                for (int bj = 0; bj < 2; ++bj) { f32x4 v0 = acc[ai][bj][m][0] + bv[bj][0], v1 = acc[ai][bj][m][1] + bv[bj][1];
                    if (ACT == 1) { f32x2 a = gelu_pk((f32x2){v0[0], v0[1]}), b = gelu_pk((f32x2){v0[2], v0[3]}), c = gelu_pk((f32x2){v1[0], v1[1]}), d = gelu_pk((f32x2){v1[2], v1[3]});
                        v0 = (f32x4){a.x, a.y, b.x, b.y}; v1 = (f32x4){c.x, c.y, d.x, d.y}; }
                    if (ACT == 2) {
#pragma unroll
                        for (int j = 0; j < 4; ++j) { v0[j] = 0.5f * v0[j] * (1.0f + erff(v0[j] * 0.70710678f)); v1[j] = 0.5f * v1[j] * (1.0f + erff(v1[j] * 0.70710678f)); } }
                    u32x4 w; w.x = cvt_pk_bf16(v0[0], v0[1]); w.y = cvt_pk_bf16(v0[2], v0[3]); w.z = cvt_pk_bf16(v1[0], v1[1]); w.w = cvt_pk_bf16(v1[2], v1[3]);
                    *(u32x4*)(rowp + bj * HALF) = w; } }
    }
};

struct PanelStats {
    unsigned* xbuf;
    unsigned* cnt;
    unsigned* tmo;
    int ntn; float eps;
    unsigned code;
    __device__ __forceinline__ bool run(const f32x4 (&v)[2][2][4][2], const Unit& u, int wr, int wc, int fr, int fq, PG8_LAS unsigned char* lds, int wid, int lane) const {
        typedef float f32x2v __attribute__((ext_vector_type(2)));
        PG8_LAS f32x2v* P = (PG8_LAS f32x2v*)lds;
        PG8_LAS f32x2v* S = (PG8_LAS f32x2v*)(lds + 8192);
        PG8_LAS unsigned* flag = (PG8_LAS unsigned*)(lds + 8192 + 2048);
#pragma unroll
        for (int ai = 0; ai < 2; ++ai)
#pragma unroll
            for (int m = 0; m < 4; ++m) {
                float s = 0.f;
#pragma unroll
                for (int bj = 0; bj < 2; ++bj)
#pragma unroll
                    for (int n = 0; n < 2; ++n) { const f32x4 x = v[ai][bj][m][n]; s += (x[0] + x[1]) + (x[2] + x[3]); }
                s += __shfl_xor(s, 16); s += __shfl_xor(s, 32);
                const float mw = s * (1.0f / 64.0f); float q = 0.f;
#pragma unroll
                for (int bj = 0; bj < 2; ++bj)
#pragma unroll
                    for (int n = 0; n < 2; ++n) { const f32x4 d = v[ai][bj][m][n] - mw; q += (d[0] * d[0] + d[1] * d[1]) + (d[2] * d[2] + d[3] * d[3]); }
                q += __shfl_xor(q, 16); q += __shfl_xor(q, 32);
                if (fq == 0) P[(ai * HALF + wr * 64 + m * 16 + fr) * 4 + wc] = (f32x2v){mw, q};
            }
        asm volatile("s_waitcnt lgkmcnt(0)" ::: "memory"); __builtin_amdgcn_s_barrier(); asm volatile("" ::: "memory");
#if defined(BROKEN_NO_WAIT)
        if (blockIdx.x >= 64) { const long long t0 = clock64(); while (clock64() - t0 < 60000) __builtin_amdgcn_s_sleep(8); }
#endif
        const int row = wid * 32 + (lane & 31);
        if (lane < 32) {
            const f32x2v a = P[row * 4 + 0], b = P[row * 4 + 1], c = P[row * 4 + 2], d = P[row * 4 + 3];
            const float mt = (a.x + b.x + c.x + d.x) * 0.25f;
            const float da = a.x - mt, db = b.x - mt, dc = c.x - mt, dd = d.x - mt;
            const float m2 = (a.y + b.y) + (c.y + d.y) + 64.0f * ((da * da + db * db) + (dc * dc + dd * dd));
            unsigned long long* slot = (unsigned long long*)xbuf + ((size_t)(u.pm * BM + row) * 4 + u.pn);
            __hip_atomic_store(slot, ((unsigned long long)__float_as_uint(m2) << 32) | __float_as_uint(mt), __ATOMIC_RELAXED, __HIP_MEMORY_SCOPE_AGENT);
        }
        asm volatile("s_waitcnt vmcnt(0)" ::: "memory");
        if (lane == 0) __hip_atomic_fetch_add(cnt + 64 * u.pm, 1u, __ATOMIC_RELAXED, __HIP_MEMORY_SCOPE_AGENT);
        if (wid == 0) {
            bool dead = false; const unsigned long long t0 = __builtin_amdgcn_s_memrealtime(); const unsigned want = 8u * (unsigned)ntn;
            for (;;) {
#if defined(BROKEN_NO_WAIT)
                break;
#endif
                if ((unsigned)__builtin_amdgcn_readfirstlane(__hip_atomic_load(cnt + 64 * u.pm, __ATOMIC_RELAXED, __HIP_MEMORY_SCOPE_AGENT)) >= want) break;
                if (__builtin_amdgcn_s_memrealtime() - t0 > 2000000ull) {
                    if (lane == 0) { unsigned expect = 0u; __hip_atomic_compare_exchange_strong(tmo + 1, &expect, code | (unsigned)(u.pm & 0xff), __ATOMIC_RELAXED, __ATOMIC_RELAXED, __HIP_MEMORY_SCOPE_AGENT);
                                     __hip_atomic_store(tmo, 1u, __ATOMIC_RELAXED, __HIP_MEMORY_SCOPE_AGENT); }
                    dead = true; break; }
                __builtin_amdgcn_s_sleep(2);
            }
            __builtin_amdgcn_fence(__ATOMIC_ACQUIRE, "agent");
            if (lane == 0) flag[0] = dead ? 1u : 0u;
        }
        asm volatile("s_waitcnt vmcnt(0) lgkmcnt(0)" ::: "memory"); __builtin_amdgcn_s_barrier(); asm volatile("" ::: "memory");
        const bool bad = flag[0] != 0u;
        if (lane < 32) {
            const unsigned long long* slot = (const unsigned long long*)xbuf + (size_t)(u.pm * BM + row) * 4; float mt[4], m2[4]; float ms = 0.f;
#pragma unroll
            for (int t = 0; t < 4; ++t) { if (t < ntn) { const unsigned long long w = __hip_atomic_load(slot + t, __ATOMIC_RELAXED, __HIP_MEMORY_SCOPE_AGENT); mt[t] = __uint_as_float((unsigned)w); m2[t] = __uint_as_float((unsigned)(w >> 32)); } else { mt[t] = 0.f; m2[t] = 0.f; } ms += mt[t]; }
            const float mean = ms / (float)ntn; float q = 0.f;
#pragma unroll
            for (int t = 0; t < 4; ++t) if (t < ntn) { const float dm = mt[t] - mean; q += m2[t] + 256.0f * dm * dm; }
            S[row] = (f32x2v){mean, 1.0f / sqrtf(q / (256.0f * (float)ntn) + eps)};
        }
        asm volatile("s_waitcnt lgkmcnt(0)" ::: "memory"); __builtin_amdgcn_s_barrier(); asm volatile("" ::: "memory");
        return bad;
    }
};
struct EpiLnRes {
    static constexpr bool PERM = false, AFTER_DRAIN = true;
    const float* base; float* out; int ldc; const float* bias; PanelStats st; unsigned poison;
    __device__ __forceinline__ void refuse(size_t i0, size_t stride, int M, int N) const { const float q = __builtin_nanf(""); for (size_t i = i0; i < (size_t)M * N; i += stride) out[(i / N) * ldc + i % N] = q;
        if (i0 == 0) { unsigned expect = 0u; __hip_atomic_compare_exchange_strong(st.tmo + 1, &expect, 0x7f0u, __ATOMIC_RELAXED, __ATOMIC_RELAXED, __HIP_MEMORY_SCOPE_AGENT); __hip_atomic_store(st.tmo, 1u, __ATOMIC_RELAXED, __HIP_MEMORY_SCOPE_AGENT); } }
    __device__ __forceinline__ void fused(f32x4 (&acc)[2][2][4][2], const Unit& u, int wr, int wc, int fr, int fq, PG8_LAS unsigned char* lds, int wid, int lane) const {
        typedef float f32x2v __attribute__((ext_vector_type(2)));
        const PG8_LAS f32x2v* S = (const PG8_LAS f32x2v*)(lds + 8192);
        const int col0 = u.pn * BM + wc * 32 + 4 * fq;
#pragma unroll
        for (int bj = 0; bj < 2; ++bj)
#pragma unroll
            for (int n = 0; n < 2; ++n) { const f32x4 bv = bias ? *(const f32x4*)(bias + col0 + bj * HALF + n * 16) : (f32x4){0.f, 0.f, 0.f, 0.f};
#pragma unroll
                for (int ai = 0; ai < 2; ++ai)
#pragma unroll
                    for (int m = 0; m < 4; ++m) acc[ai][bj][m][n] += bv; }
        const bool bad = st.run(acc, u, wr, wc, fr, fq, lds, wid, lane) || poison != 0u;
        const float qnan = __builtin_nanf("");
#pragma unroll
        for (int ai = 0; ai < 2; ++ai)
#pragma unroll
            for (int m = 0; m < 4; ++m) { const int r = ai * HALF + wr * 64 + m * 16 + fr; const f32x2v sr = S[r]; const size_t off = (size_t)(u.pm * BM + r) * ldc + col0;
#pragma unroll
                for (int bj = 0; bj < 2; ++bj)
#pragma unroll
                    for (int n = 0; n < 2; ++n) { const f32x4 bs = *(const f32x4*)(base + off + bj * HALF + n * 16); f32x4 o = bs + (acc[ai][bj][m][n] - sr.x) * sr.y;
                        if (bad) o = (f32x4){qnan, qnan, qnan, qnan}; *(f32x4*)(out + off + bj * HALF + n * 16) = o; }
                asm volatile("" ::: "memory"); }
    }
};
struct EpiLnResLn {
    static constexpr bool PERM = false, AFTER_DRAIN = true;
    const float* base; float* out; bf16_t* xn; int ldc; const float* bias; PanelStats st1, st2; unsigned poison;
    __device__ __forceinline__ void refuse(size_t i0, size_t stride, int M, int N) const { const float q = __builtin_nanf(""); for (size_t i = i0; i < (size_t)M * N; i += stride) { const size_t o = (i / N) * ldc + i % N; out[o] = q; xn[o] = (bf16_t)0x7fc0u; }
        if (i0 == 0) { unsigned expect = 0u; __hip_atomic_compare_exchange_strong(st1.tmo + 1, &expect, 0x7f0u, __ATOMIC_RELAXED, __ATOMIC_RELAXED, __HIP_MEMORY_SCOPE_AGENT); __hip_atomic_store(st1.tmo, 1u, __ATOMIC_RELAXED, __HIP_MEMORY_SCOPE_AGENT); } }
    __device__ __forceinline__ void fused(f32x4 (&acc)[2][2][4][2], const Unit& u, int wr, int wc, int fr, int fq, PG8_LAS unsigned char* lds, int wid, int lane) const {
        typedef float f32x2v __attribute__((ext_vector_type(2))); typedef unsigned u32x2v __attribute__((ext_vector_type(2)));
        const PG8_LAS f32x2v* S = (const PG8_LAS f32x2v*)(lds + 8192);
        const int col0 = u.pn * BM + wc * 32 + 4 * fq;
#pragma unroll
        for (int bj = 0; bj < 2; ++bj)
#pragma unroll
            for (int n = 0; n < 2; ++n) { const f32x4 bv = bias ? *(const f32x4*)(bias + col0 + bj * HALF + n * 16) : (f32x4){0.f, 0.f, 0.f, 0.f};
#pragma unroll
                for (int ai = 0; ai < 2; ++ai)
#pragma unroll
                    for (int m = 0; m < 4; ++m) acc[ai][bj][m][n] += bv; }
        bool bad = st1.run(acc, u, wr, wc, fr, fq, lds, wid, lane) || poison != 0u;
        const float qnan = __builtin_nanf("");
#pragma unroll
        for (int ai = 0; ai < 2; ++ai)
#pragma unroll
            for (int m = 0; m < 4; ++m) { const int r = ai * HALF + wr * 64 + m * 16 + fr; const f32x2v sr = S[r]; const size_t off = (size_t)(u.pm * BM + r) * ldc + col0;
#pragma unroll
                for (int bj = 0; bj < 2; ++bj)
#pragma unroll
                    for (int n = 0; n < 2; ++n) { const f32x4 bs = *(const f32x4*)(base + off + bj * HALF + n * 16); acc[ai][bj][m][n] = bs + (acc[ai][bj][m][n] - sr.x) * sr.y; }
                asm volatile("" : "+v"(acc[ai][0][m][0]), "+v"(acc[ai][0][m][1]), "+v"(acc[ai][1][m][0]), "+v"(acc[ai][1][m][1]));
                if (m & 1) asm volatile("" ::: "memory"); }
        const bool bad1 = bad;
        bad = st2.run(acc, u, wr, wc, fr, fq, lds, wid, lane) || bad;
#pragma unroll
        for (int ai = 0; ai < 2; ++ai)
#pragma unroll
            for (int m = 0; m < 4; ++m) { const int r = ai * HALF + wr * 64 + m * 16 + fr; const f32x2v sr = S[r]; const size_t off = (size_t)(u.pm * BM + r) * ldc + col0;
#pragma unroll
                for (int bj = 0; bj < 2; ++bj)
#pragma unroll
                    for (int n = 0; n < 2; ++n) { const f32x4 x1 = acc[ai][bj][m][n]; *(f32x4*)(out + off + bj * HALF + n * 16) = bad1 ? (f32x4){qnan, qnan, qnan, qnan} : x1;
                        const f32x4 o = (x1 - sr.x) * sr.y; u32x2v w; w.x = cvt_pk_bf16(o[0], o[1]); w.y = cvt_pk_bf16(o[2], o[3]);
                        if (bad) { w.x = 0x7fc07fc0u; w.y = 0x7fc07fc0u; } *(u32x2v*)(xn + off + bj * HALF + n * 16) = w; }
                asm volatile("" ::: "memory"); }
    }
};

typedef int pg8_v8i __attribute__((ext_vector_type(8)));
typedef int pg8_v4i __attribute__((ext_vector_type(4)));
__device__ __forceinline__ pg8_v8i cat32(const bf16x8 lo, const bf16x8 hi) { return __builtin_shufflevector(__builtin_bit_cast(pg8_v4i, lo), __builtin_bit_cast(pg8_v4i, hi), 0, 1, 2, 3, 4, 5, 6, 7); }
template <class Epi, class Sched, bool STAMP = false, bool FP8 = false>
__device__ __forceinline__ void gemm_phase(PG8_LAS unsigned char* lds, const Gemm g, const Sched& S, const Epi& E, unsigned long long* stamps) {
    int tid_opaque = threadIdx.x; asm volatile("" : "+v"(tid_opaque));
    const int tid = tid_opaque, wid = __builtin_amdgcn_readfirstlane(tid >> 6), lane = tid & 63, wr = wid >> 2, wc = wid & 3, fr = lane & 15, fq = lane >> 4;
    const int K = g.K, nt = K / BK;
    int ts_lo = 0, ts_hi = 0, nts = 0; const unsigned long long rt_entry = STAMP ? (unsigned long long)wall_clock64() : 0ull;
#define PG8_STAMP() do { if (STAMP && wid == 0 && nts < 64) { const unsigned long long _c = (unsigned long long)clock64(); \
        ts_lo = (lane == nts) ? (int)(unsigned)_c : ts_lo; ts_hi = (lane == nts) ? (int)(unsigned)(_c >> 32) : ts_hi; ++nts; } } while (0)
    PG8_STAMP();
    unsigned voffA[2], voffB[2];
#pragma unroll
    for (int i = 0; i < 2; ++i) { int R, C; stage_rc(tid * 16 + i * 8192, R, C); const int Rb = (int)Epi::PERM == 2 ? (64 * (R >> 5) + perm32b(R & 31)) : Epi::PERM ? (64 * (R >> 5) + perm32(R & 31)) : R;
        voffA[i] = (unsigned)(R * K + C) * 2u; voffB[i] = (unsigned)(Rb * K + C) * 2u; }
    const size_t kstep = (size_t)(BK * 2);
    const size_t hstep = (size_t)HALF * K * 2;
    const size_t tstep = 2 * hstep;
    const size_t hstepB = (int)Epi::PERM == 2 ? (size_t)8 * K * 2 : Epi::PERM ? (size_t)32 * K * 2 : hstep;
    const unsigned ldsw = (unsigned)wid * 1024u;
    const int aoff = lds_byte(wr * 64 + fr, fq * 8), boff = lds_byte(wc * 32 + fr, fq * 8);
#define PG8_SA(b, h) (((b) * 2 + (h)) * HTB)
#define PG8_SB(b, h) ((4 + (b) * 2 + (h)) * HTB)
#define PG8_STAGE(bufoff, gbase, voff) do { _Pragma("unroll") for (int _i = 0; _i < 2; ++_i) \
        __builtin_amdgcn_global_load_lds((const unsigned*)((const char*)(gbase) + (voff)[_i]), (PG8_LAS unsigned*)(lds + (bufoff) + ldsw + _i * 8192), 16, 0, 0); } while (0)
#define PG8_LDA(dst, b, h) do { _Pragma("unroll") for (int m = 0; m < 4; ++m) _Pragma("unroll") for (int k = 0; k < 2; ++k) dst[m][k] = *(const PG8_LAS bf16x8*)(lds + PG8_SA(b, h) + aoff + m * 2048 + k * 1024); } while (0)
#define PG8_LDB(dst, b, h) do { _Pragma("unroll") for (int n = 0; n < 2; ++n) _Pragma("unroll") for (int k = 0; k < 2; ++k) dst[n][k] = *(const PG8_LAS bf16x8*)(lds + PG8_SB(b, h) + boff + n * 2048 + k * 1024); } while (0)
#define PG8_MMA(ai, bj, At, Bt) do { __builtin_amdgcn_s_setprio(1); _Pragma("unroll") for (int m = 0; m < 4; ++m) _Pragma("unroll") for (int n = 0; n < 2; ++n) { \
        if constexpr (FP8) { const pg8_v8i b8_ = cat32(Bt[n][0], Bt[n][1]), a8_ = cat32(At[m][0], At[m][1]); asm volatile("v_mfma_f32_16x16x128_f8f6f4 %0, %1, %2, %0" : "+v"(acc[ai][bj][m][n]) : "v"(b8_), "v"(a8_)); }   \
        else { _Pragma("unroll") for (int k = 0; k < 2; ++k) acc[ai][bj][m][n] = __builtin_amdgcn_mfma_f32_16x16x32_bf16(Bt[n][k], At[m][k], acc[ai][bj][m][n], 0, 0, 0); } } \
        __builtin_amdgcn_s_setprio(0); } while (0)
#define PG8_WAIT_V(n) asm volatile("s_waitcnt vmcnt(" #n ")" ::: "memory")
#define PG8_WAIT_L(n) asm volatile("s_waitcnt lgkmcnt(" #n ")" ::: "memory")
#define PG8_BAR __builtin_amdgcn_s_barrier()
#define PG8_SCHED __builtin_amdgcn_sched_barrier(0)
    Unit cur, nxt; int ui = 0;
    if (!S.next(0, cur)) return;
    f32x4 acc[2][2][4][2];
#pragma unroll
    for (int a = 0; a < 2; ++a)
#pragma unroll
        for (int b = 0; b < 2; ++b)
#pragma unroll
            for (int m = 0; m < 4; ++m)
#pragma unroll
                for (int n = 0; n < 2; ++n) acc[a][b][m][n] = (f32x4){0.f, 0.f, 0.f, 0.f};
    bf16x8 At[4][2], B0[2][2], B1[2][2];
    const char* cA = (const char*)g.A + (size_t)cur.pm * tstep; const char* cB = (const char*)g.Bt + (size_t)cur.pn * tstep;
    const unsigned long long ga64_ = (unsigned long long)g.A, gb64_ = (unsigned long long)g.Bt;
    const char* gA_ = (const char*)(((unsigned long long)(unsigned)__builtin_amdgcn_readfirstlane((int)(unsigned)(ga64_ >> 32)) << 32) | (unsigned)__builtin_amdgcn_readfirstlane((int)(unsigned)ga64_));
    const char* gB_ = (const char*)(((unsigned long long)(unsigned)__builtin_amdgcn_readfirstlane((int)(unsigned)(gb64_ >> 32)) << 32) | (unsigned)__builtin_amdgcn_readfirstlane((int)(unsigned)gb64_));
    S.a_ready(cur);
    PG8_STAGE(PG8_SB(0, 0), cB, voffB); PG8_STAGE(PG8_SA(0, 0), cA, voffA); PG8_STAGE(PG8_SB(0, 1), cB + hstepB, voffB); PG8_STAGE(PG8_SA(0, 1), cA + hstep, voffA);
    if (wr == 1) PG8_BAR;
    PG8_WAIT_V(4); PG8_BAR;
    PG8_STAGE(PG8_SB(1, 0), cB + kstep, voffB); PG8_STAGE(PG8_SA(1, 0), cA + kstep, voffA); PG8_STAGE(PG8_SB(1, 1), cB + hstepB + kstep, voffB);
    PG8_WAIT_V(6); PG8_BAR;
    PG8_STAMP();
    for (;;) {
        const bool has_next = S.next(ui + 1, nxt);
        const char* nA = has_next ? gA_ + (size_t)nxt.pm * tstep : cA; const char* nB = has_next ? gB_ + (size_t)nxt.pn * tstep : cB;
        for (int t = 0; t < nt; t += 2) {
            if constexpr (Epi::HOOK) { if (t == Epi::H0 || t == Epi::H1) E.hook(acc, cur, t, wr, wc, fr, fq); }
            const bool last = (t == nt - 2);
            const char* a1 = cA + (size_t)(t + 1) * kstep;
            const char* a2 = last ? nA : cA + (size_t)(t + 2) * kstep; const char* b2 = last ? nB : cB + (size_t)(t + 2) * kstep;
            const char* a3 = a2 + kstep; const char* b3 = b2 + kstep;
            if (last && has_next) S.a_ready(nxt);
            PG8_LDB(B0, 0, 0); PG8_SCHED; PG8_LDA(At, 0, 0); PG8_STAGE(PG8_SA(1, 1), a1 + hstep, voffA);
            PG8_WAIT_L(8); PG8_BAR; PG8_WAIT_L(0); PG8_MMA(0, 0, At, B0); PG8_BAR; PG8_SCHED;
            PG8_LDB(B1, 0, 1); PG8_STAGE(PG8_SB(0, 0), b2, voffB);
            PG8_BAR; PG8_WAIT_L(0); PG8_MMA(0, 1, At, B1); PG8_BAR;
            PG8_LDA(At, 0, 1); PG8_STAGE(PG8_SA(0, 0), a2, voffA);
            PG8_BAR; PG8_WAIT_L(0); PG8_MMA(1, 0, At, B0); PG8_BAR; PG8_SCHED;
            PG8_STAGE(PG8_SB(0, 1), b2 + hstepB, voffB);
            PG8_WAIT_V(6); PG8_BAR; PG8_MMA(1, 1, At, B1); PG8_BAR;
            PG8_LDB(B0, 1, 0); PG8_SCHED; PG8_LDA(At, 1, 0); PG8_STAGE(PG8_SA(0, 1), a2 + hstep, voffA);
            PG8_WAIT_L(8); PG8_BAR; PG8_WAIT_L(0); PG8_MMA(0, 0, At, B0); PG8_BAR; PG8_SCHED;
            PG8_LDB(B1, 1, 1); PG8_STAGE(PG8_SB(1, 0), b3, voffB);
            PG8_BAR; PG8_WAIT_L(0); PG8_MMA(0, 1, At, B1); PG8_BAR;
            PG8_LDA(At, 1, 1); PG8_STAGE(PG8_SA(1, 0), a3, voffA);
            PG8_BAR; PG8_WAIT_L(0); PG8_MMA(1, 0, At, B0); PG8_BAR; PG8_SCHED;
            PG8_STAGE(PG8_SB(1, 1), b3 + hstepB, voffB);
            PG8_WAIT_V(6); PG8_BAR; PG8_MMA(1, 1, At, B1); PG8_BAR;
        }
        PG8_STAMP();
        if constexpr (!Epi::AFTER_DRAIN) { E(acc, cur, wr, wc, fr, fq); S.done(cur); }
        PG8_STAMP();
        if (!has_next) break;
#pragma unroll
        for (int a = 0; a < 2; ++a)
#pragma unroll
            for (int b = 0; b < 2; ++b)
#pragma unroll
                for (int m = 0; m < 4; ++m)
#pragma unroll
                    for (int n = 0; n < 2; ++n) acc[a][b][m][n] = (f32x4){0.f, 0.f, 0.f, 0.f};
        cur = nxt; cA = nA; cB = nB; ++ui;
    }
    PG8_WAIT_V(0);
    if (wr == 0) PG8_BAR;
    PG8_BAR;
    if constexpr (Epi::AFTER_DRAIN) { E.fused(acc, cur, wr, wc, fr, fq, lds, wid, lane); S.done(cur); }
    PG8_STAMP();
    if (STAMP && wid == 0) { stamps[lane] = lane < nts ? (((unsigned long long)(unsigned)ts_hi << 32) | (unsigned)ts_lo) : 0ull;
        if (lane == 62) stamps[62] = rt_entry; if (lane == 63) stamps[63] = (unsigned long long)wall_clock64(); }
#undef PG8_STAMP
#undef PG8_SA
#undef PG8_SB
#undef PG8_STAGE
#undef PG8_LDA
#undef PG8_LDB
#undef PG8_MMA
#undef PG8_WAIT_V
#undef PG8_WAIT_L
#undef PG8_BAR
#undef PG8_SCHED
}
}
#ifndef A8
#define A8 1
#endif
#ifndef BG_TABLES0
#define BG_TABLES0 1
#endif
#ifndef BG_TABLES
#define BG_TABLES 1
#endif
#ifndef PROBE_DUP
#define PROBE_DUP 0
#endif
#ifndef BR8
#define BR8 0
#endif
#ifndef G1_NBF
#define G1_NBF 3072
#endif

namespace mk {
using pg8::bf16_t; using pg8::f32x4; using pg8::u32x4; using pg8::Unit; using pg8::f32x2;
#define LAS __attribute__((address_space(3)))
#define GAS __attribute__((address_space(1)))
typedef unsigned u32x2 __attribute__((ext_vector_type(2)));

constexpr int NWAVES = 8, NTHR = 512;
constexpr int T = 16384, D = 2048, SEQ = 2048, DEPTH = 2, INW = 13824, NEXP = 16384;
constexpr float EPS = 1e-6f;
constexpr size_t MiB = 1u << 20;
constexpr size_t WS_CTL = 0, CTL_ZERO_BYTES = 1 * MiB;
constexpr size_t WS_WIN = 1 * MiB;
constexpr size_t WS_WA = 55 * MiB;
constexpr size_t WS_WB = 59 * MiB;
constexpr size_t WS_WC = 63 * MiB;
constexpr size_t WS_WOUT = 65 * MiB;
constexpr size_t WS_WSC = 73 * MiB;
constexpr size_t WS_WM = 81 * MiB;
constexpr size_t WS_WP = 82 * MiB;
constexpr size_t WS_U = 83 * MiB;
constexpr size_t WS_V = 211 * MiB;
constexpr size_t WS_XB = 339 * MiB;
constexpr size_t WS_RSTD = 403 * MiB;
constexpr size_t WS_PA = 404 * MiB;
constexpr size_t WS_PB = 468 * MiB;
constexpr size_t WS_PQKV = 500 * MiB;
constexpr size_t WS_PG = 644 * MiB;
constexpr size_t WS_YA = 836 * MiB;
constexpr size_t WS_YB = 868 * MiB;
constexpr size_t WS_YC = 900 * MiB;
constexpr size_t WS_OG = 916 * MiB;
constexpr size_t WS_LSE = 964 * MiB;
constexpr size_t WS_XB8 = 147 * MiB;
constexpr size_t WS_WIN8 = 179 * MiB;
constexpr size_t WS_XH4 = 243 * MiB;
constexpr size_t WS_XL4 = 259 * MiB;
constexpr size_t WS_EXG = 965 * MiB;
constexpr size_t WS_CVG = 973 * MiB;
constexpr size_t WS_END = 981 * MiB;
constexpr int CW_BAR = 4096;
#ifndef PEER_FP4
#define PEER_FP4 1
#endif
constexpr float SCALE_U4 = 90.5f, SCALE_V4 = 5.657f;

constexpr int RING_BYTES = 131072, LDS_BYTES = 163840, TOP_OFF = LDS_BYTES - 1024, MISC_OFF = TOP_OFF + 320;

__constant__ unsigned char kBucket[3 * 129] = {
0,1,2,3,4,5,6,7,8,9,10,11,12,13,14,15,16,16,16,16,16,16,17,17,17,17,17,17,17,17,18,18,18,18,18,18,18,18,18,18,19,19,19,19,19,19,19,19,19,19,19,19,19,19,20,20,20,20,20,20,20,20,20,20,20,20,20,20,20,20,20,20,20,21,21,21,21,21,21,21,21,21,21,21,21,21,21,21,21,21,21,21,21,21,21,21,21,21,21,22,22,22,22,22,22,22,22,22,22,22,22,22,22,22,22,22,22,22,22,22,22,22,22,22,22,22,22,22,22,
0,4,8,12,16,16,17,17,18,18,19,19,19,19,20,20,20,20,20,21,21,21,21,21,21,22,22,22,22,22,22,22,22,22,23,23,23,23,23,23,23,23,23,23,23,23,24,24,24,24,24,24,24,24,24,24,24,24,24,24,24,24,25,25,25,25,25,25,25,25,25,25,25,25,25,25,25,25,25,25,25,25,25,26,26,26,26,26,26,26,26,26,26,26,26,26,26,26,26,26,26,26,26,26,26,26,26,26,26,26,26,26,26,27,27,27,27,27,27,27,27,27,27,27,27,27,27,27,27,
0,16,18,19,20,21,21,22,22,23,23,23,24,24,24,24,25,25,25,25,25,26,26,26,26,26,26,26,26,27,27,27,27,27,27,27,27,27,27,28,28,28,28,28,28,28,28,28,28,28,28,28,29,29,29,29,29,29,29,29,29,29,29,29,29,29,29,29,29,29,30,30,30,30,30,30,30,30,30,30,30,30,30,30,30,30,30,30,30,30,30,30,30,30,30,31,31,31,31,31,31,31,31,31,31,31,31,31,31,31,31,31,31,31,31,31,31,31,31,31,31,31,31,31,31,31,31,31,31};

__device__ __forceinline__ float bflo(unsigned w) { return __uint_as_float(w << 16); }
__device__ __forceinline__ float bfhi(unsigned w) { return __uint_as_float(w & 0xffff0000u); }
__device__ __forceinline__ float bf2f(bf16_t b) { return __uint_as_float(((unsigned)b) << 16); }
__device__ __forceinline__ unsigned f2bf(float f) { unsigned u = __float_as_uint(f); return (u + 0x7fffu + ((u >> 16) & 1u)) >> 16; }
typedef __bf16 bf16x2_t __attribute__((ext_vector_type(2)));
__device__ __forceinline__ unsigned pk2(float lo, float hi) { return __builtin_bit_cast(unsigned, __builtin_convertvector((f32x2){lo, hi}, bf16x2_t)); }
__device__ __forceinline__ unsigned pk2s(float lo, float hi) { return pk2(lo, hi); }
typedef int v2i_t __attribute__((ext_vector_type(2)));
typedef float f32x16 __attribute__((ext_vector_type(16)));
constexpr float Y8S = 8.0f;
__device__ __forceinline__ unsigned pk4_fp8(float a, float b, float c, float d) {
    int pk = 0;
    pk = __builtin_amdgcn_cvt_pk_fp8_f32(__builtin_amdgcn_fmed3f(a, -448.f, 448.f), __builtin_amdgcn_fmed3f(b, -448.f, 448.f), pk, false);
    pk = __builtin_amdgcn_cvt_pk_fp8_f32(__builtin_amdgcn_fmed3f(c, -448.f, 448.f), __builtin_amdgcn_fmed3f(d, -448.f, 448.f), pk, true);
    return (unsigned)pk;
}
__device__ __forceinline__ float wave_sum(float v) {
#pragma unroll
    for (int o = 1; o < 64; o <<= 1) v += __shfl_xor(v, o);
    return v;
}
__device__ __forceinline__ float wave_max(float v) {
#pragma unroll
    for (int o = 1; o < 64; o <<= 1) v = fmaxf(v, __shfl_xor(v, o));
    return v;
}
__device__ __forceinline__ float dot8(const u32x4 a, const u32x4 b) {
    return bflo(a.x) * bflo(b.x) + bfhi(a.x) * bfhi(b.x) + bflo(a.y) * bflo(b.y) + bfhi(a.y) * bfhi(b.y)
         + bflo(a.z) * bflo(b.z) + bfhi(a.z) * bfhi(b.z) + bflo(a.w) * bflo(b.w) + bfhi(a.w) * bfhi(b.w);
}
__device__ __forceinline__ float gelu_erf(float a) { return 0.5f * a * (1.0f + erff(a * 0.70710678118654752f)); }
#define LDS_WAIT() asm volatile("s_waitcnt lgkmcnt(0)" ::: "memory")
#define VM_WAIT() asm volatile("s_waitcnt vmcnt(0)" ::: "memory")

#define XB_TMO      128
#define XB_XCNT(j)  (256  + 64 * (j))
#define XB_XSUB(j)  (1280 + 64 * (j))
#define XB_XGEN(j)  (2304 + 64 * (j))
#define XB_TOP      3328
#define XB_TOPGEN   3392
#define XCD_BAR_WORDS 3456
#define XB_SPIN_CAP (1u << 18)
__device__ __forceinline__ unsigned xb_ld(unsigned* p)              { return __hip_atomic_load(p, __ATOMIC_RELAXED, __HIP_MEMORY_SCOPE_AGENT); }
__device__ __forceinline__ unsigned xb_add(unsigned* p, unsigned v) { return __hip_atomic_fetch_add(p, v, __ATOMIC_RELAXED, __HIP_MEMORY_SCOPE_AGENT); }
__device__ __forceinline__ unsigned xb_xcc_id() { return (unsigned)__builtin_amdgcn_s_getreg((3 << 11) | 20) & 0xFu; }
#define XB_SPIN(cond, bar) do { unsigned _sp = 0; while (cond) { __builtin_amdgcn_s_sleep(1); \
    if ((++_sp & 255u) == 0u) { if (xb_ld(&(bar)[XB_TMO])) break; if (_sp > XB_SPIN_CAP) { atomicAdd(&(bar)[XB_TMO], 1u); break; } } } } while (0)
struct XcdBarrier { unsigned* bar; unsigned x; volatile LAS unsigned* st; };
__device__ __forceinline__ XcdBarrier xcd_barrier_post(unsigned* bar, volatile LAS unsigned* st) {
    XcdBarrier b; b.bar = bar; b.x = xb_xcc_id(); b.st = st;
    if (threadIdx.x == 0) (void)xb_add(&bar[XB_XCNT(b.x)], 1u);
    return b;
}
__device__ __forceinline__ void xcd_barrier_complete(unsigned* bar, unsigned x, unsigned& nloc, unsigned& nx) {
    const unsigned G = gridDim.x * gridDim.y * gridDim.z;
    unsigned sum, cnt, mine, sp = 0u;
    for (;;) {
        sum = 0u; cnt = 0u; mine = 0u;
#pragma unroll
        for (unsigned j = 0; j < 16; ++j) { const unsigned c = xb_ld(&bar[XB_XCNT(j)]); sum += c; cnt += (c > 0u) ? 1u : 0u; mine = (j == x) ? c : mine; }
        if (sum == G) break;
        __builtin_amdgcn_s_sleep(1);
        if ((++sp & 255u) == 0u) { if (xb_ld(&bar[XB_TMO])) break; if (sp > XB_SPIN_CAP) { atomicAdd(&bar[XB_TMO], 1u); break; } }
    }
    nloc = mine > 0u ? mine : 1u; nx = cnt > 0u ? cnt : 1u;
}
__device__ __forceinline__ void xcd_barrier(const XcdBarrier& b) {
    asm volatile("s_waitcnt vmcnt(0)" ::: "memory");
    __syncthreads();
    if (threadIdx.x == 0) {
        unsigned* bar = b.bar;
        __builtin_amdgcn_s_waitcnt(0);
        unsigned nloc = b.st[0], nx = b.st[1];
        if (nloc == 0u) { xcd_barrier_complete(bar, b.x, nloc, nx); b.st[0] = nloc; b.st[1] = nx; }
        const unsigned old = xb_add(&bar[XB_XSUB(b.x)], 1u);
        const unsigned gen = old / nloc;
        if (old + 1u == (gen + 1u) * nloc) {
            __builtin_amdgcn_fence(__ATOMIC_RELEASE, "agent");
            asm volatile("s_waitcnt vmcnt(0)" ::: "memory");
            const unsigned og = xb_add(&bar[XB_TOP], 1u);
            const unsigned tg = og / nx;
            if (og + 1u == (tg + 1u) * nx) xb_add(&bar[XB_TOPGEN], 1u);
            else XB_SPIN(xb_ld(&bar[XB_TOPGEN]) == tg, bar);
            __builtin_amdgcn_fence(__ATOMIC_ACQUIRE, "agent");
            xb_add(&bar[XB_XGEN(b.x)], 1u);
            asm volatile("s_waitcnt vmcnt(0)" ::: "memory");
        } else {
            XB_SPIN(xb_ld(&bar[XB_XGEN(b.x)]) == gen, bar);
            __builtin_amdgcn_fence(__ATOMIC_ACQUIRE, "agent");
            asm volatile("s_waitcnt vmcnt(0)" ::: "memory");
        }
    }
    __syncthreads();
}

#define EPI_STEP(m) (((m) == 3) ? (128 - 48) : 16)
__device__ __forceinline__ unsigned dpp_hi8(unsigned keep, unsigned src) { return (unsigned)__builtin_amdgcn_update_dpp((int)keep, (int)src, 0x128, 0xF, 0xC, false); }
__device__ __forceinline__ unsigned dpp_lo8(unsigned keep, unsigned src) { return (unsigned)__builtin_amdgcn_update_dpp((int)keep, (int)src, 0x128, 0xF, 0x3, false); }
__device__ __forceinline__ void store_rows8(GAS bf16_t* p, size_t ld8, const u32x4 x0, const u32x4 x1) {
    u32x4 s0, s1;
#pragma unroll
    for (int j = 0; j < 4; ++j) { s0[j] = dpp_hi8(x0[j], x1[j]); s1[j] = dpp_lo8(x1[j], x0[j]); }
    *(GAS u32x4*)p = s0; *(GAS u32x4*)(p + ld8) = s1;
}
__device__ __forceinline__ void store_rows8_b8(GAS unsigned char* p, size_t ld8, const u32x2 x0, const u32x2 x1) {
    u32x2 s0, s1;
#pragma unroll
    for (int j = 0; j < 2; ++j) { s0[j] = dpp_hi8(x0[j], x1[j]); s1[j] = dpp_lo8(x1[j], x0[j]); }
    *(GAS u32x2*)p = s0; *(GAS u32x2*)(p + ld8) = s1;
}
struct EpiG1 {
    static constexpr bool PERM = true, AFTER_DRAIN = false, HOOK = false;
    bf16_t *PA, *PB, *PQKV, *PG; const float* rstd; int pn_off; float scale;
    template <int ACT> __device__ __forceinline__ void body(const f32x4 (&acc)[2][2][4][2], bf16_t* base, const int ldc, const int colt, const float sc, const int rowg, int wc, int fr, int fq) const {
        GAS bf16_t* rowp = (GAS bf16_t*)(base + (size_t)(rowg + (fr & 7)) * ldc + colt + wc * 64 + ((fr >> 3) * 4 + fq) * 8);
        GAS unsigned char* rowp8 = (GAS unsigned char*)base + (size_t)(rowg + fr) * ldc + colt + wc * 64 + 8 * fq;
        const GAS float* rp = (const GAS float*)(rstd + rowg + fr);
        float rv[8];
#pragma unroll
        for (int i = 0; i < 8; ++i) rv[i] = rp[(i >> 2) * 128 + (i & 3) * 16] * sc;
#pragma unroll
        for (int ai = 0; ai < 2; ++ai)
#pragma unroll
            for (int m = 0; m < 4; ++m) {
                const float r = rv[ai * 4 + m];
                u32x4 xw[2]; u32x2 xb[2];
#pragma unroll
                for (int bj = 0; bj < 2; ++bj) { f32x4 v0 = acc[ai][bj][m][0] * r, v1 = acc[ai][bj][m][1] * r;
                    if (ACT == 1) { f32x2 a = pg8::gelu_pk((f32x2){v0[0], v0[1]}), b = pg8::gelu_pk((f32x2){v0[2], v0[3]}), c = pg8::gelu_pk((f32x2){v1[0], v1[1]}), d = pg8::gelu_pk((f32x2){v1[2], v1[3]});
                        v0 = (f32x4){a.x, a.y, b.x, b.y}; v1 = (f32x4){c.x, c.y, d.x, d.y}; }
                    if (ACT == 2) {
#pragma unroll
                        for (int j = 0; j < 4; ++j) { v0[j] = __builtin_amdgcn_rcpf(1.0f + __expf(-v0[j])); v1[j] = __builtin_amdgcn_rcpf(1.0f + __expf(-v1[j])); }
                        xb[bj].x = (unsigned)(v0[0] * 255.f + 0.5f) | ((unsigned)(v0[1] * 255.f + 0.5f) << 8) | ((unsigned)(v0[2] * 255.f + 0.5f) << 16) | ((unsigned)(v0[3] * 255.f + 0.5f) << 24);
                        xb[bj].y = (unsigned)(v1[0] * 255.f + 0.5f) | ((unsigned)(v1[1] * 255.f + 0.5f) << 8) | ((unsigned)(v1[2] * 255.f + 0.5f) << 16) | ((unsigned)(v1[3] * 255.f + 0.5f) << 24); }
                    else { xw[bj].x = pk2(v0[0], v0[1]); xw[bj].y = pk2(v0[2], v0[3]); xw[bj].z = pk2(v1[0], v1[1]); xw[bj].w = pk2(v1[2], v1[3]); } }
                if (ACT == 2) { *(GAS u32x2*)rowp8 = xb[0]; *(GAS u32x2*)(rowp8 + 32) = xb[1]; rowp8 += (size_t)EPI_STEP(m) * ldc; asm volatile("" : "+v"(rowp8)); }
                else { store_rows8(rowp, (size_t)8 * ldc, xw[0], xw[1]); rowp += (size_t)EPI_STEP(m) * ldc; asm volatile("" : "+v"(rowp)); }
            }
    }
    __device__ __forceinline__ void operator()(const f32x4 (&acc)[2][2][4][2], const Unit& u, int wr, int wc, int fr, int fq) const {
        const int pn = u.pn + pn_off, rowg = u.pm * 256 + wr * 64;
        if (pn < 8) body<1>(acc, PA, 2048, pn * 256, scale, rowg, wc, fr, fq);
        else if (pn < 12) body<0>(acc, PB, 1024, (pn - 8) * 256, scale, rowg, wc, fr, fq);
        else if (pn < 30) body<0>(acc, PQKV, 4608, (pn - 12) * 256, pn < 18 ? scale * 0.08838834764831845f : scale, rowg, wc, fr, fq);
        else body<2>(acc, PG, 6144, (pn - 30) * 256, scale, rowg, wc, fr, fq);
    }
};
struct EpiG1B {
    static constexpr int PERM = 2; static constexpr bool AFTER_DRAIN = false, HOOK = false;
    unsigned char *PQKV8, *PG; const float* rstd; int pn_off; float scale; bf16_t* PA;
    template <int ACT> __device__ __forceinline__ void body(const f32x4 (&acc)[2][2][4][2], unsigned char* base, const int ldc, const int colt, const int rowg, int wc, int fr, int fq) const {
        GAS unsigned char* rowp = (GAS unsigned char*)base + (size_t)(rowg + fr) * ldc + colt + wc * 64 + 16 * fq;
        const GAS float* rp = (const GAS float*)(rstd + rowg + fr);
        float rv[8];
#pragma unroll
        for (int i = 0; i < 8; ++i) rv[i] = rp[(i >> 2) * 128 + (i & 3) * 16] * scale;
#pragma unroll
        for (int ai = 0; ai < 2; ++ai)
#pragma unroll
            for (int m = 0; m < 4; ++m) {
                const float r = rv[ai * 4 + m];
                u32x4 w;
#pragma unroll
                for (int bj = 0; bj < 2; ++bj)
#pragma unroll
                    for (int n = 0; n < 2; ++n) { f32x4 v = acc[ai][bj][m][n] * r; unsigned pk;
                        if (ACT == 2) {
#pragma unroll
                            for (int j = 0; j < 4; ++j) v[j] = __builtin_amdgcn_rcpf(1.0f + __expf(-v[j]));
                            pk = (unsigned)(v[0] * 255.f + 0.5f) | ((unsigned)(v[1] * 255.f + 0.5f) << 8) | ((unsigned)(v[2] * 255.f + 0.5f) << 16) | ((unsigned)(v[3] * 255.f + 0.5f) << 24); }
                        else pk = pk4_fp8(v[0], v[1], v[2], v[3]);
                        w[bj * 2 + n] = pk; }
                *(GAS u32x4*)rowp = w;
                rowp += (size_t)EPI_STEP(m) * ldc;
                asm volatile("" : "+v"(rowp));
            }
    }
    __device__ __forceinline__ void body_uv(const f32x4 (&acc)[2][2][4][2], const int colt, const int rowg, int wc, int fr, int fq) const {
        GAS bf16_t* rowp = (GAS bf16_t*)PA + (size_t)(rowg + fr) * 2048 + colt + wc * 64 + 16 * fq;
        const GAS float* rp = (const GAS float*)(rstd + rowg + fr);
        float rv[8];
#pragma unroll
        for (int i = 0; i < 8; ++i) rv[i] = rp[(i >> 2) * 128 + (i & 3) * 16] * scale;
#pragma unroll
        for (int ai = 0; ai < 2; ++ai)
#pragma unroll
            for (int m = 0; m < 4; ++m) {
                const float r = rv[ai * 4 + m];
#pragma unroll
                for (int bj = 0; bj < 2; ++bj) { const f32x4 v0 = acc[ai][bj][m][0] * r, v1 = acc[ai][bj][m][1] * r;
                    const f32x2 a = pg8::gelu_pk((f32x2){v0[0], v0[1]}), b = pg8::gelu_pk((f32x2){v0[2], v0[3]}), c = pg8::gelu_pk((f32x2){v1[0], v1[1]}), d = pg8::gelu_pk((f32x2){v1[2], v1[3]});
                    u32x4 w; w.x = pk2(a.x, a.y); w.y = pk2(b.x, b.y); w.z = pk2(c.x, c.y); w.w = pk2(d.x, d.y);
                    *(GAS u32x4*)(rowp + 8 * bj) = w; }
                rowp += (size_t)EPI_STEP(m) * 2048;
                asm volatile("" : "+v"(rowp));
            }
    }
    __device__ __forceinline__ void operator()(const f32x4 (&acc)[2][2][4][2], const Unit& u, int wr, int wc, int fr, int fq) const {
        const int rowg = u.pm * 256 + wr * 64;
        if (A8 && u.pn < 8) { body_uv(acc, u.pn * 256, rowg, wc, fr, fq); return; }
        const int pn = u.pn + pn_off;
        if (pn < 30) body<3>(acc, PQKV8, 4608, (pn - 12) * 256, rowg, wc, fr, fq);
        else body<2>(acc, PG, 6144, (pn - 30) * 256, rowg, wc, fr, fq);
    }
};
template <int FIRST> struct EpiBranch {
    static constexpr bool PERM = true, AFTER_DRAIN = false, HOOK = false;
    bf16_t* MG; const bf16_t* gate;
    __device__ __forceinline__ void operator()(const f32x4 (&acc)[2][2][4][2], const Unit& u, int wr, int wc, int fr, int fq) const {
        const int row0 = u.pm * 256 + wr * 64 + fr, col0 = u.pn * 256 + wc * 32 + 8 * fq;
        const GAS bf16_t* gp = (const GAS bf16_t*)(gate + (size_t)row0 * 6144 + col0); GAS bf16_t* mp = (GAS bf16_t*)(MG + (size_t)row0 * 2048 + col0);
#pragma unroll
        for (int ai = 0; ai < 2; ++ai) {
            u32x4 g[4][2], o[4][2];
#pragma unroll
            for (int m = 0; m < 4; ++m)
#pragma unroll
                for (int bj = 0; bj < 2; ++bj) { g[m][bj] = *(const GAS u32x4*)(gp + (size_t)m * 16 * 6144 + bj * 128); if (!FIRST) o[m][bj] = *(const GAS u32x4*)(mp + (size_t)m * 16 * 2048 + bj * 128); }
#pragma unroll
            for (int m = 0; m < 4; ++m)
#pragma unroll
                for (int bj = 0; bj < 2; ++bj) { const u32x4 gg = g[m][bj];
                    f32x4 v0 = acc[ai][bj][m][0], v1 = acc[ai][bj][m][1];
                    v0[0] *= bflo(gg.x); v0[1] *= bfhi(gg.x); v0[2] *= bflo(gg.y); v0[3] *= bfhi(gg.y);
                    v1[0] *= bflo(gg.z); v1[1] *= bfhi(gg.z); v1[2] *= bflo(gg.w); v1[3] *= bfhi(gg.w);
                    if (!FIRST) { const u32x4 oo = o[m][bj];
                        v0[0] += bflo(oo.x); v0[1] += bfhi(oo.x); v0[2] += bflo(oo.y); v0[3] += bfhi(oo.y);
                        v1[0] += bflo(oo.z); v1[1] += bfhi(oo.z); v1[2] += bflo(oo.w); v1[3] += bfhi(oo.w); }
                    u32x4 w; w.x = pk2(v0[0], v0[1]); w.y = pk2(v0[2], v0[3]); w.z = pk2(v1[0], v1[1]); w.w = pk2(v1[2], v1[3]);
                    *(GAS u32x4*)(mp + (size_t)m * 16 * 2048 + bj * 128) = w; }
            gp += (size_t)128 * 6144; mp += (size_t)128 * 2048;
            asm volatile("" : "+v"(gp), "+v"(mp) :: "memory");
        }
    }
};
template <int F8> struct EpiBranchF {
    static constexpr bool PERM = true, AFTER_DRAIN = false, HOOK = true;
    static constexpr int H0 = F8 ? 8 : 16, H1 = F8 ? 16 : 32;
    static constexpr float OS = F8 ? 1.0f / (Y8S * 1024.0f) : 1.0f;
    bf16_t* MG; const unsigned char* gate;
    static __device__ __forceinline__ float gb(unsigned w, int k) { return fmaxf((float)((w >> (8 * k)) & 0xffu) * (1.0f / 255.0f), 1e-6f); }
    __device__ __forceinline__ void hook(f32x4 (&acc)[2][2][4][2], const Unit& u, int t, int wr, int wc, int fr, int fq) const {
        const int row0 = u.pm * 256 + wr * 64 + fr, col0 = u.pn * 256 + wc * 64 + 8 * fq;
        const GAS unsigned char* gp = (const GAS unsigned char*)(gate + (size_t)row0 * 6144 + col0 + (t == H0 ? 0 : 2048));
#pragma unroll
        for (int ai = 0; ai < 2; ++ai) {
            u32x2 gn[4][2], gd[4][2];
#pragma unroll
            for (int m = 0; m < 4; ++m)
#pragma unroll
                for (int bj = 0; bj < 2; ++bj) { gn[m][bj] = *(const GAS u32x2*)(gp + (size_t)m * 16 * 6144 + bj * 32); gd[m][bj] = *(const GAS u32x2*)(gp + (size_t)m * 16 * 6144 + bj * 32 + 2048); }
#pragma unroll
            for (int m = 0; m < 4; ++m)
#pragma unroll
                for (int bj = 0; bj < 2; ++bj) { const u32x2 a = gn[m][bj], d = gd[m][bj];
#pragma unroll
                    for (int k = 0; k < 4; ++k) { acc[ai][bj][m][0][k] *= gb(a.x, k) * __builtin_amdgcn_rcpf(gb(d.x, k)); acc[ai][bj][m][1][k] *= gb(a.y, k) * __builtin_amdgcn_rcpf(gb(d.y, k)); } }
            gp += (size_t)128 * 6144;
            asm volatile("" : "+v"(gp) :: "memory");
        }
    }
    __device__ __forceinline__ void operator()(const f32x4 (&acc)[2][2][4][2], const Unit& u, int wr, int wc, int fr, int fq) const {
        const int rowg = u.pm * 256 + wr * 64, col0 = u.pn * 256 + wc * 64 + 8 * fq;
        const GAS unsigned char* gp = (const GAS unsigned char*)(gate + (size_t)(rowg + fr) * 6144 + col0 + 4096);
        GAS bf16_t* mp = (GAS bf16_t*)(MG + (size_t)(rowg + (fr & 7)) * 2048 + u.pn * 256 + wc * 64 + ((fr >> 3) * 4 + fq) * 8);
#pragma unroll
        for (int ai = 0; ai < 2; ++ai) {
            u32x2 g[4][2];
#pragma unroll
            for (int m = 0; m < 4; ++m)
#pragma unroll
                for (int bj = 0; bj < 2; ++bj) g[m][bj] = *(const GAS u32x2*)(gp + (size_t)m * 16 * 6144 + bj * 32);
#pragma unroll
            for (int m = 0; m < 4; ++m) { u32x4 w[2];
#pragma unroll
                for (int bj = 0; bj < 2; ++bj) { const u32x2 gg = g[m][bj]; const f32x4 v0 = acc[ai][bj][m][0], v1 = acc[ai][bj][m][1];
                    w[bj].x = pk2(v0[0] * (gb(gg.x, 0) * OS), v0[1] * (gb(gg.x, 1) * OS)); w[bj].y = pk2(v0[2] * (gb(gg.x, 2) * OS), v0[3] * (gb(gg.x, 3) * OS));
                    w[bj].z = pk2(v1[0] * (gb(gg.y, 0) * OS), v1[1] * (gb(gg.y, 1) * OS)); w[bj].w = pk2(v1[2] * (gb(gg.y, 2) * OS), v1[3] * (gb(gg.y, 3) * OS)); }
                store_rows8(mp + (size_t)m * 16 * 2048, (size_t)8 * 2048, w[0], w[1]); }
            gp += (size_t)128 * 6144; mp += (size_t)128 * 2048;
            asm volatile("" : "+v"(gp), "+v"(mp) :: "memory");
        }
    }
};
template <int XIN_BF16> struct EpiWout {
    static constexpr bool PERM = true, AFTER_DRAIN = false, HOOK = false;
    const float* xin; float* xout; bf16_t* XB; unsigned char* XB8;
    __device__ __forceinline__ void operator()(const f32x4 (&acc)[2][2][4][2], const Unit& u, int wr, int wc, int fr, int fq) const {
        const int rowg = u.pm * 256 + wr * 64, colw = u.pn * 256 + wc * 64;
        size_t off = (size_t)(rowg + fr) * 2048 + colw + 8 * fq;
        GAS bf16_t* sp = (GAS bf16_t*)(XB + (size_t)(rowg + (fr & 7)) * 2048 + colw + ((fr >> 3) * 4 + fq) * 8);
#pragma unroll
        for (int ai = 0; ai < 2; ++ai) {
            f32x4 xv[4][2][2];
#pragma unroll
            for (int m = 0; m < 4; ++m)
#pragma unroll
                for (int bj = 0; bj < 2; ++bj) { const size_t o = off + (size_t)m * 16 * 2048 + bj * 32;
                    if (XIN_BF16) { const u32x4 wv = *(const GAS u32x4*)(XB + o); xv[m][bj][0] = (f32x4){bflo(wv.x), bfhi(wv.x), bflo(wv.y), bfhi(wv.y)}; xv[m][bj][1] = (f32x4){bflo(wv.z), bfhi(wv.z), bflo(wv.w), bfhi(wv.w)}; }
                    else { xv[m][bj][0] = *(const GAS f32x4*)(xin + o); xv[m][bj][1] = *(const GAS f32x4*)(xin + o + 4); } }
#pragma unroll
            for (int m = 0; m < 4; ++m) { u32x4 w[2];
#pragma unroll
                for (int bj = 0; bj < 2; ++bj) { const f32x4 v0 = xv[m][bj][0] + acc[ai][bj][m][0], v1 = xv[m][bj][1] + acc[ai][bj][m][1];
                    w[bj].x = pk2(v0[0], v0[1]); w[bj].y = pk2(v0[2], v0[3]); w[bj].z = pk2(v1[0], v1[1]); w[bj].w = pk2(v1[2], v1[3]); }
                store_rows8(sp + (size_t)m * 16 * 2048, (size_t)8 * 2048, w[0], w[1]); }
            off += (size_t)128 * 2048; sp += (size_t)128 * 2048;
            asm volatile("" : "+v"(off), "+v"(sp) :: "memory");
        }
    }
};
struct EpiF32 {
    static constexpr bool PERM = false, AFTER_DRAIN = false, HOOK = false;
    float* C; int ldc;
    __device__ __forceinline__ void operator()(const f32x4 (&acc)[2][2][4][2], const Unit& u, int wr, int wc, int fr, int fq) const {
        const int row0 = u.pm * 256 + wr * 64 + fr, col0 = u.pn * 256 + wc * 32 + 4 * fq;
        GAS float* rowp = (GAS float*)(C + (size_t)row0 * ldc + col0);
#pragma unroll
        for (int ai = 0; ai < 2; ++ai)
#pragma unroll
            for (int m = 0; m < 4; ++m) {
#pragma unroll
                for (int bj = 0; bj < 2; ++bj)
#pragma unroll
                    for (int n = 0; n < 2; ++n) *(GAS f32x4*)(rowp + bj * 128 + n * 16) = acc[ai][bj][m][n];
                rowp += (size_t)EPI_STEP(m) * ldc;
                asm volatile("" : "+v"(rowp) :: "memory"); }
    }
};


struct SplitOrder : pg8::StaticOrder {
    int cut, nA, nB;
    __device__ bool next(int i, Unit& u) const {
        long L;
        if (c < cut) { if (i >= nA) return false; L = (long)i * cut + c; } else { if (i >= nB) return false; L = (long)nA * cut + (long)i * (G - cut) + (c - cut); }
        if (L >= nwg) return false;
        int wgid = (int)L; { const int q = nwg / pg8::NXCD, r = nwg % pg8::NXCD, xcd = wgid % pg8::NXCD, off = wgid / pg8::NXCD; wgid = (xcd < r ? xcd * (q + 1) : r * (q + 1) + (xcd - r) * q) + off; }
        const int nig = pg8::WGM * nN, gid = wgid / nig, fm = gid * pg8::WGM, gsz = (nM - fm) < pg8::WGM ? (nM - fm) : pg8::WGM;
        u.pm = fm + ((wgid % nig) % gsz); u.pn = (wgid % nig) / gsz; return true;
    }
};

struct EpiNull {
    static constexpr bool PERM = true, AFTER_DRAIN = false, HOOK = false;
    __device__ __forceinline__ void operator()(const f32x4 (&acc)[2][2][4][2], const Unit& u, int wr, int wc, int fr, int fq) const {
#pragma unroll
        for (int ai = 0; ai < 2; ++ai)
#pragma unroll
            for (int bj = 0; bj < 2; ++bj)
#pragma unroll
                for (int m = 0; m < 4; ++m) { asm volatile("" :: "v"(acc[ai][bj][m][0]), "v"(acc[ai][bj][m][1])); }
    }
};
struct EpiLocal {
    static constexpr bool PERM = true, AFTER_DRAIN = false, HOOK = false;
    bf16_t* C;
    __device__ __forceinline__ void operator()(const f32x4 (&acc)[2][2][4][2], const Unit& u, int wr, int wc, int fr, int fq) const {
        const int col0 = wc * 32 + 8 * fq;
#pragma unroll
        for (int ai = 0; ai < 2; ++ai)
#pragma unroll
            for (int m = 0; m < 4; ++m) {
                GAS bf16_t* rowp = (GAS bf16_t*)(C + (size_t)(blockIdx.x * 64 + 16 * m + fr) * 2048 + col0);
#pragma unroll
                for (int bj = 0; bj < 2; ++bj) { const f32x4 v0 = acc[ai][bj][m][0], v1 = acc[ai][bj][m][1];
                    u32x4 w; w.x = pk2s(v0[0], v0[1]); w.y = pk2s(v0[2], v0[3]); w.z = pk2s(v1[0], v1[1]); w.w = pk2s(v1[2], v1[3]);
                    *(GAS u32x4*)(rowp + bj * 128) = w; }
            }
    }
};
struct EpiContig {
    static constexpr bool PERM = true, AFTER_DRAIN = false, HOOK = false;
    bf16_t* C;
    __device__ __forceinline__ void operator()(const f32x4 (&acc)[2][2][4][2], const Unit& u, int wr, int wc, int fr, int fq) const {
        GAS unsigned char* tp = (GAS unsigned char*)C + (size_t)(u.pm * 8 + (u.pn & 7)) * 131072 + (wr * 4 + wc) * 16384 + (fq * 16 + fr) * 16;
#pragma unroll
        for (int ai = 0; ai < 2; ++ai)
#pragma unroll
            for (int m = 0; m < 4; ++m) {
#pragma unroll
                for (int bj = 0; bj < 2; ++bj) { const f32x4 v0 = acc[ai][bj][m][0], v1 = acc[ai][bj][m][1];
                    u32x4 w; w.x = pk2s(v0[0], v0[1]); w.y = pk2s(v0[2], v0[3]); w.z = pk2s(v1[0], v1[1]); w.w = pk2s(v1[2], v1[3]);
                    *(GAS u32x4*)(tp + ((ai * 4 + m) * 2 + bj) * 1024) = w; }
            }
    }
};
struct EpiNT {
    static constexpr bool PERM = true, AFTER_DRAIN = false, HOOK = false;
    bf16_t* C;
    __device__ __forceinline__ void operator()(const f32x4 (&acc)[2][2][4][2], const Unit& u, int wr, int wc, int fr, int fq) const {
        const int row0 = u.pm * 256 + wr * 64 + fr, col0 = u.pn * 256 + wc * 32 + 8 * fq;
        GAS bf16_t* rowp = (GAS bf16_t*)(C + (size_t)row0 * 2048 + col0);
#pragma unroll
        for (int ai = 0; ai < 2; ++ai)
#pragma unroll
            for (int m = 0; m < 4; ++m) {
#pragma unroll
                for (int bj = 0; bj < 2; ++bj) { const f32x4 v0 = acc[ai][bj][m][0], v1 = acc[ai][bj][m][1];
                    u32x4 w; w.x = pk2s(v0[0], v0[1]); w.y = pk2s(v0[2], v0[3]); w.z = pk2s(v1[0], v1[1]); w.w = pk2s(v1[2], v1[3]);
                    __builtin_nontemporal_store(w, (GAS u32x4*)(rowp + bj * 128)); }
                rowp += (size_t)EPI_STEP(m) * 2048;
                asm volatile("" : "+v"(rowp));
            }
    }
};
struct EpiRows8 {
    static constexpr bool PERM = true, AFTER_DRAIN = false, HOOK = false;
    bf16_t* C;
    __device__ __forceinline__ void operator()(const f32x4 (&acc)[2][2][4][2], const Unit& u, int wr, int wc, int fr, int fq) const {
        const int lane = fq * 16 + fr, r8 = lane & 7, ch = lane >> 3;
        GAS bf16_t* rowp = (GAS bf16_t*)(C + (size_t)(u.pm * 256 + wr * 64 + r8) * 2048 + u.pn * 256 + wc * 64 + ch * 8);
#pragma unroll
        for (int ai = 0; ai < 2; ++ai)
#pragma unroll
            for (int m = 0; m < 4; ++m) {
#pragma unroll
                for (int bj = 0; bj < 2; ++bj) { const f32x4 v0 = acc[ai][bj][m][0], v1 = acc[ai][bj][m][1];
                    u32x4 w; w.x = pk2s(v0[0], v0[1]); w.y = pk2s(v0[2], v0[3]); w.z = pk2s(v1[0], v1[1]); w.w = pk2s(v1[2], v1[3]);
                    *(GAS u32x4*)(rowp + (size_t)(bj * 8) * 2048) = w; }
                rowp += (size_t)EPI_STEP(m) * 2048;
                asm volatile("" : "+v"(rowp));
            }
    }
};
struct EpiHalf {
    static constexpr bool PERM = true, AFTER_DRAIN = false, HOOK = false;
    bf16_t* C;
    __device__ __forceinline__ void operator()(const f32x4 (&acc)[2][2][4][2], const Unit& u, int wr, int wc, int fr, int fq) const {
        const int row0 = u.pm * 256 + wr * 64 + fr, col0 = u.pn * 256 + wc * 32 + 8 * fq;
        GAS unsigned char* rowp = (GAS unsigned char*)C + (size_t)row0 * 2048 + col0;
#pragma unroll
        for (int ai = 0; ai < 2; ++ai)
#pragma unroll
            for (int m = 0; m < 4; ++m) {
#pragma unroll
                for (int bj = 0; bj < 2; ++bj) { const f32x4 v0 = acc[ai][bj][m][0], v1 = acc[ai][bj][m][1];
                    u32x2 w; w.x = pk4_fp8(v0[0], v0[1], v0[2], v0[3]); w.y = pk4_fp8(v1[0], v1[1], v1[2], v1[3]);
                    *(GAS u32x2*)(rowp + bj * 128) = w; }
                rowp += (size_t)EPI_STEP(m) * 2048;
                asm volatile("" : "+v"(rowp));
            }
    }
};
struct EpiScoreBf16 {
    static constexpr bool PERM = true, AFTER_DRAIN = false, HOOK = false;
    bf16_t* C;
    __device__ __forceinline__ void operator()(const f32x4 (&acc)[2][2][4][2], const Unit& u, int wr, int wc, int fr, int fq) const {
        GAS bf16_t* rowp = (GAS bf16_t*)(C + (size_t)(u.pm * 256 + wr * 64 + (fr & 7)) * 2048 + u.pn * 256 + wc * 64 + ((fr >> 3) * 4 + fq) * 8);
#pragma unroll
        for (int ai = 0; ai < 2; ++ai)
#pragma unroll
            for (int m = 0; m < 4; ++m) { u32x4 w[2];
#pragma unroll
                for (int bj = 0; bj < 2; ++bj) { const f32x4 v0 = acc[ai][bj][m][0], v1 = acc[ai][bj][m][1];
                    w[bj].x = pk2s(v0[0], v0[1]); w[bj].y = pk2s(v0[2], v0[3]); w[bj].z = pk2s(v1[0], v1[1]); w[bj].w = pk2s(v1[2], v1[3]); }
                store_rows8(rowp, (size_t)8 * 2048, w[0], w[1]);
                if (PROBE_DUP == 22) store_rows8(rowp + ((size_t)(WS_PA - WS_PQKV) / 2), (size_t)8 * 2048, w[0], w[1]);
                rowp += (size_t)EPI_STEP(m) * 2048;
                asm volatile("" : "+v"(rowp));
            }
    }
};
struct Ctx {
    LAS unsigned char* lds;
    int tid, lane, wave, G, bx;
    float* out; unsigned char* ws;
};
constexpr int PTR_OFF = TOP_OFF + 512;
__device__ __forceinline__ const float* inptr(const Ctx& C, int i) {
    const LAS unsigned* p = (const LAS unsigned*)(C.lds + PTR_OFF) + 2 * i;
    const unsigned lo = (unsigned)__builtin_amdgcn_readfirstlane((int)p[0]), hi = (unsigned)__builtin_amdgcn_readfirstlane((int)p[1]);
    return (const float*)(const GAS float*)(((unsigned long long)hi << 32) | lo);
}

__device__ __forceinline__ void transpose_item(const float* W, const float* g, int K, int N, bf16_t* WT, LAS float* scr, int item, int lane, int ldw = 0, int koff = 0, int ncols = 0) {
    if (ldw == 0) ldw = K;
    const int nblk = (ncols ? ncols : N) / 32, kb = item / nblk, nb = item % nblk, k0 = 64 * kb, n0 = 32 * nb;
#pragma unroll 8
    for (int i = 0; i < 32; ++i) { const int kk = 2 * i + (lane >> 5); float w = W[(size_t)(k0 + kk) * N + n0 + (lane & 31)]; if (g) w *= g[k0 + kk]; scr[kk * 33 + (lane & 31)] = w; }
    LDS_WAIT();
    const int c = lane & 7;
#pragma unroll
    for (int j = 0; j < 4; ++j) { const int n = (lane >> 3) + 8 * j; const LAS float* s = scr + (8 * c) * 33 + n;
        u32x4 o; o.x = pk2(s[0 * 33], s[1 * 33]); o.y = pk2(s[2 * 33], s[3 * 33]); o.z = pk2(s[4 * 33], s[5 * 33]); o.w = pk2(s[6 * 33], s[7 * 33]);
        *(u32x4*)(WT + (size_t)(n0 + n) * ldw + koff + k0 + 8 * c) = o; }
    LDS_WAIT();
}
__device__ __forceinline__ void transpose_item8(const float* W, const float* g, int K, int N, unsigned char* WT, LAS float* scr, int item, int lane, int ncols, float scale) {
    const int nblk = ncols / 32, kb = item / nblk, nb = item % nblk, k0 = 64 * kb, n0 = 32 * nb;
#pragma unroll 8
    for (int i = 0; i < 32; ++i) { const int kk = 2 * i + (lane >> 5); float w = W[(size_t)(k0 + kk) * N + n0 + (lane & 31)] * scale; if (g) w *= g[k0 + kk]; scr[kk * 33 + (lane & 31)] = fminf(fmaxf(w, -448.f), 448.f); }
    LDS_WAIT();
    const int n = lane >> 1;
#pragma unroll
    for (int j = 0; j < 2; ++j) { const int c = (lane & 1) * 2 + j; const LAS float* s = scr + (16 * c) * 33 + n; u32x4 o;
#pragma unroll
        for (int q = 0; q < 4; ++q) { int pk = 0; pk = __builtin_amdgcn_cvt_pk_fp8_f32(s[(4 * q) * 33], s[(4 * q + 1) * 33], pk, false); pk = __builtin_amdgcn_cvt_pk_fp8_f32(s[(4 * q + 2) * 33], s[(4 * q + 3) * 33], pk, true); o[q] = (unsigned)pk; }
        *(u32x4*)(WT + (size_t)(n0 + n) * K + k0 + 16 * c) = o; }
    LDS_WAIT();
}
__device__ __forceinline__ void cvt_rows(const Ctx& C, const float* src, const float* g, bf16_t* dst, size_t nelem) {
    const size_t n8 = nelem / 8, stride = (size_t)C.G * NTHR;
    for (size_t i = (size_t)C.bx * NTHR + C.tid; i < n8; i += stride) {
        f32x4 a = *(const f32x4*)(src + i * 8), b = *(const f32x4*)(src + i * 8 + 4);
        if (g) { const int d = (int)((i * 8) & 2047); const f32x4 ga = *(const f32x4*)(g + d), gb = *(const f32x4*)(g + d + 4); a = a * ga; b = b * gb; }
        u32x4 w; w.x = pk2(a[0], a[1]); w.y = pk2(a[2], a[3]); w.z = pk2(b[0], b[1]); w.w = pk2(b[2], b[3]);
        *(u32x4*)(dst + i * 8) = w;
    }
}

__device__ __forceinline__ void cvt_rows_fp8(const Ctx& C, const float* src, const float* g, unsigned char* dst, size_t nelem, float scale) {
    const size_t n16 = nelem / 16, stride = (size_t)C.G * NTHR;
    for (size_t i = (size_t)C.bx * NTHR + C.tid; i < n16; i += stride) {
        u32x4 w;
#pragma unroll
        for (int q = 0; q < 4; ++q) {
            f32x4 a = *(const f32x4*)(src + i * 16 + q * 4);
            if (g) { const int d = (int)((i * 16 + q * 4) & 2047); a = a * *(const f32x4*)(g + d); }
            a = a * scale;
#pragma unroll
            for (int j = 0; j < 4; ++j) a[j] = fminf(fmaxf(a[j], -448.f), 448.f);
            int pk = 0; pk = __builtin_amdgcn_cvt_pk_fp8_f32(a[0], a[1], pk, false); pk = __builtin_amdgcn_cvt_pk_fp8_f32(a[2], a[3], pk, true);
            w[q] = (unsigned)pk;
        }
        *(u32x4*)(dst + i * 16) = w;
    }
}

__device__ __forceinline__ void cvt_rows_fp4(const Ctx& C, const float* src, const float* g, unsigned char* dst, size_t nelem, float scale) {
    const size_t n32 = nelem / 32, stride = (size_t)C.G * NTHR;
    size_t i = (size_t)C.bx * NTHR + C.tid;
    f32x4 nx[8];
    if (i < n32) {
#pragma unroll
        for (int q = 0; q < 8; ++q) nx[q] = *(const f32x4*)(src + i * 32 + q * 4); }
    for (; i < n32; i += stride) {
        f32x4 cu[8];
#pragma unroll
        for (int q = 0; q < 8; ++q) cu[q] = nx[q];
        const size_t in = i + stride;
        if (in < n32) {
#pragma unroll
            for (int q = 0; q < 8; ++q) nx[q] = *(const f32x4*)(src + in * 32 + q * 4); }
        u32x4 w;
#pragma unroll
        for (int q = 0; q < 4; ++q) { unsigned pk = 0u;
            f32x4 a = cu[2 * q], b2 = cu[2 * q + 1];
            if (g) { const int d = (int)((i * 32 + q * 8) & 2047); a = a * *(const f32x4*)(g + d); b2 = b2 * *(const f32x4*)(g + d + 4); }
            a = a * scale; b2 = b2 * scale;
            pk = __builtin_amdgcn_cvt_scalef32_pk_fp4_f32(pk, a[0], a[1], 1.0f, 0); pk = __builtin_amdgcn_cvt_scalef32_pk_fp4_f32(pk, a[2], a[3], 1.0f, 1);
            pk = __builtin_amdgcn_cvt_scalef32_pk_fp4_f32(pk, b2[0], b2[1], 1.0f, 2); pk = __builtin_amdgcn_cvt_scalef32_pk_fp4_f32(pk, b2[2], b2[3], 1.0f, 3);
            w[q] = pk; }
        *(u32x4*)(dst + i * 16) = w;
    }
}
__device__ __forceinline__ void cvt_layer_weights(const Ctx& C, int l) {
    LAS float* scr = (LAS float*)(C.lds + C.wave * 16384);
    const int gw = C.bx * NWAVES + C.wave, NGW = C.G * NWAVES;
    const float* w_in = inptr(C, 3) + (size_t)l * D * INW; const float* gmix = inptr(C, 2) + (size_t)l * D;
    const float* wa = inptr(C, 9) + (size_t)l * 1024 * D; const float* wb = inptr(C, 10) + (size_t)l * 1024 * D; const float* wc = inptr(C, 11) + (size_t)l * 512 * D;
    const float* wo = inptr(C, 12) + (size_t)l * D * D;
    bf16_t* WIN = (bf16_t*)(C.ws + WS_WIN); bf16_t* WA = (bf16_t*)(C.ws + WS_WA); bf16_t* WB = (bf16_t*)(C.ws + WS_WB); bf16_t* WC = (bf16_t*)(C.ws + WS_WC);
    bf16_t* WOUT = (bf16_t*)(C.ws + WS_WOUT);
    constexpr int NBF = G1_NBF, NG8 = INW - G1_NBF;
    constexpr int I_IN = (D / 64) * (NBF / 32), I_G8 = (D / 64) * (NG8 / 32), I_A = (1024 / 64) * (D / 32), I_C = (512 / 64) * (D / 32), I_O = (D / 64) * (D / 32);
    constexpr int NITEMS = I_IN + I_G8 + 2 * I_A + I_C + I_O;
    struct TrD { const float* W; const float* g; unsigned char* WT; int N, nblk, ldw, koff, fp8; };
    constexpr int T_IN = A8 ? (D / 64) * (1024 / 256) : (D / 64) * (NBF / 256), T_G8A = A8 ? (D / 64) * (2048 / 256) : 0, T_G8 = (D / 64) * (NG8 / 256), T_A = (1024 / 64) * (D / 256), T_C = (512 / 64) * (D / 256), T_O = (D / 64) * (D / 256);
    constexpr int NTILES = T_IN + T_G8A + T_G8 + 2 * T_A + T_C + T_O;
#define TR_DESC(dd, it_) do { int r_ = (it_); \
        if (r_ < T_IN) { dd = A8 ? TrD{w_in + 2048, gmix, (unsigned char*)WIN, INW, 1024 / 256, D, 0, 0} : TrD{w_in, gmix, (unsigned char*)WIN, INW, NBF / 256, D, 0, 0}; } else { r_ -= T_IN; \
        if (r_ < T_G8A) { dd = TrD{w_in, gmix, C.ws + WS_WIN8, INW, 2048 / 256, D, 0, 1}; } else { r_ -= T_G8A; \
        if (r_ < T_G8) { dd = TrD{w_in + NBF, gmix, C.ws + WS_WIN8 + (A8 ? (size_t)2048 * D : 0), INW, NG8 / 256, D, 0, 1}; } else { r_ -= T_G8; \
        if (r_ < T_A) { dd = TrD{wa, nullptr, (unsigned char*)WA, D, D / 256, 2560, 0, BR8}; } else { r_ -= T_A; \
        if (r_ < T_A) { dd = TrD{wb, nullptr, (unsigned char*)WA, D, D / 256, 2560, 1024, BR8}; } else { r_ -= T_A; \
        if (r_ < T_C) { dd = TrD{wc, nullptr, (unsigned char*)WA, D, D / 256, 2560, 2048, BR8}; } else { r_ -= T_C; \
        dd = TrD{wo, nullptr, (unsigned char*)WOUT, D, D / 256, D, 0, 0}; } } } } } } ritem = r_; } while (0)
#define TR_LOAD(dd, ri, v) do { const int kb_ = (ri) / dd.nblk, nb_ = (ri) - kb_ * dd.nblk, k0_ = 64 * kb_, n0_ = 256 * nb_; \
        _Pragma("unroll") for (int i = 0; i < 8; ++i) { const int kk = (C.tid >> 6) + 8 * i; f32x4 w = *(const f32x4*)(dd.W + (size_t)(k0_ + kk) * dd.N + n0_ + 4 * (C.tid & 63)); if (dd.g) w = w * dd.g[k0_ + kk]; v[i] = w; } } while (0)
    LAS float* tile = (LAS float*)C.lds;
    auto tr_store = [&](const TrD& dd, int ri, const f32x4 (&v)[8]) {
        const int kb = ri / dd.nblk, nb = ri - kb * dd.nblk, k0 = 64 * kb, n0 = 256 * nb;
        __syncthreads();
#pragma unroll
        for (int i = 0; i < 8; ++i) { const int kk = (C.tid >> 6) + 8 * i; LAS float* tp = tile + kk * 257 + 4 * (C.tid & 63);
#pragma unroll
            for (int j = 0; j < 4; ++j) tp[j] = dd.fp8 ? fminf(fmaxf(v[i][j] * 1024.f, -448.f), 448.f) : v[i][j]; }
        __syncthreads();
        if (dd.fp8) { const int c = C.tid & 3;
#pragma unroll
            for (int j = 0; j < 2; ++j) { const int n = (C.tid >> 2) + 128 * j; const LAS float* sq = tile + (16 * c) * 257 + n; u32x4 o;
#pragma unroll
                for (int q = 0; q < 4; ++q) { int pk = 0; pk = __builtin_amdgcn_cvt_pk_fp8_f32(sq[(4 * q) * 257], sq[(4 * q + 1) * 257], pk, false); pk = __builtin_amdgcn_cvt_pk_fp8_f32(sq[(4 * q + 2) * 257], sq[(4 * q + 3) * 257], pk, true); o[q] = (unsigned)pk; }
                *(u32x4*)(dd.WT + (size_t)(n0 + n) * dd.ldw + dd.koff + k0 + 16 * c) = o; } }
        else { const int c = C.tid & 7;
#pragma unroll
            for (int j = 0; j < 4; ++j) { const int n = (C.tid >> 3) + 64 * j; const LAS float* sq = tile + (8 * c) * 257 + n;
                u32x4 o; o.x = pk2(sq[0 * 257], sq[1 * 257]); o.y = pk2(sq[2 * 257], sq[3 * 257]); o.z = pk2(sq[4 * 257], sq[5 * 257]); o.w = pk2(sq[6 * 257], sq[7 * 257]);
                *(u32x4*)((bf16_t*)dd.WT + (size_t)(n0 + n) * dd.ldw + dd.koff + k0 + 8 * c) = o; } }
    };
    {
        f32x4 va[8], vb[8]; TrD da, db; int ritem = 0, ra = 0, rb = 0;
        int it = C.bx;
        if (it < NTILES) { TR_DESC(da, it); ra = ritem; TR_LOAD(da, ra, va); }
        while (it < NTILES) {
            const int it1 = it + C.G;
            if (it1 < NTILES) { TR_DESC(db, it1); rb = ritem; TR_LOAD(db, rb, vb); }
            tr_store(da, ra, va);
            if (it1 >= NTILES) break;
            const int it2 = it1 + C.G;
            if (it2 < NTILES) { TR_DESC(da, it2); ra = ritem; TR_LOAD(da, ra, va); }
            tr_store(db, rb, vb);
            it = it2;
        }
        __syncthreads();
    }
#undef TR_DESC
#undef TR_LOAD
    const size_t gt = (size_t)C.bx * NTHR + C.tid, gs = (size_t)C.G * NTHR;
    {
        const float* wq = inptr(C, 14) + (size_t)l * D * D; const float* k1 = inptr(C, 15) + (size_t)l * 128 * 128; const float* k2 = inptr(C, 16) + (size_t)l * 128 * 128;
        const float* gf = inptr(C, 13) + (size_t)l * D; bf16_t* WSC = (bf16_t*)(C.ws + WS_WSC);
        const int q = C.lane >> 4, r16 = C.lane & 15;
        for (int item = gw; item < 2048; item += NGW) {
            const int nb = item >> 7, mt = (item >> 4) & 7, kc = item & 15;
            const float* kr = ((nb & 1) ? k2 : k1) + (size_t)(mt * 16 + r16) * 128 + 4 * q;
            f32x4 bfr[8];
#pragma unroll
            for (int s = 0; s < 8; ++s) bfr[s] = *(const f32x4*)(kr + 16 * s);
            f32x4 an[8];
            { const float* ar0 = wq + (size_t)((kc * 8) * 16 + r16) * D + nb * 128 + 4 * q;
#pragma unroll
              for (int s = 0; s < 8; ++s) an[s] = *(const f32x4*)(ar0 + 16 * s); }
            for (int t = 0; t < 8; ++t) { const int k0 = (kc * 8 + t) * 16;
                f32x4 av[8];
#pragma unroll
                for (int s = 0; s < 8; ++s) av[s] = an[s];
                if (t < 7) { const float* arn = wq + (size_t)(k0 + 16 + r16) * D + nb * 128 + 4 * q;
#pragma unroll
                    for (int s = 0; s < 8; ++s) an[s] = *(const f32x4*)(arn + 16 * s); }
                f32x4 acc = {0.f, 0.f, 0.f, 0.f};
#pragma unroll
                for (int s = 0; s < 8; ++s) {
#pragma unroll
                    for (int e2 = 0; e2 < 4; ++e2) acc = __builtin_amdgcn_mfma_f32_16x16x4f32(av[s][e2], bfr[s][e2], acc, 0, 0, 0); }
                const f32x4 gv = *(const f32x4*)(gf + k0 + 4 * q);
                u32x2 w; w.x = pk2(acc[0] * gv[0], acc[1] * gv[1]); w.y = pk2(acc[2] * gv[2], acc[3] * gv[3]);
                *(u32x2*)(WSC + (size_t)(nb * 128 + mt * 16 + r16) * D + k0 + 4 * q) = w; }
        }
    }
    {
        const float* ws_ = inptr(C, 5) + (size_t)l * 8 * 128 * 128; bf16_t* WM = (bf16_t*)(C.ws + WS_WM);
        for (size_t i = gt; i < (size_t)8 * 128 * 128; i += gs) { const int s = (int)(i & 127), t = (int)((i >> 7) & 127); WM[i] = (bf16_t)f2bf(s <= t ? ws_[i] : 0.f); }
    }
    {
        const float* wp = inptr(C, 7) + (size_t)l * 4 * 256 * 256; const float* sc = inptr(C, 8) + (size_t)l * 1024; bf16_t* WP = (bf16_t*)(C.ws + WS_WP);
        for (size_t i = gt; i < (size_t)4 * 256 * 256; i += gs) { const int c = (int)(i & 255), e = (int)((i >> 8) & 255), g = (int)(i >> 16); WP[i] = (bf16_t)f2bf(wp[((size_t)g * 256 + c) * 256 + e] * sc[g * 256 + e]); }
    }
}
__device__ __forceinline__ void prologue(const Ctx& C) {
    for (int l = 0; l < (BG_TABLES ? ((BG_TABLES0 && C.G == 256) ? 0 : 1) : DEPTH); ++l) {
#if PEER_FP4
        cvt_rows_fp4(C, inptr(C, 17) + (size_t)l * NEXP * D, inptr(C, 13) + (size_t)l * D, C.ws + WS_U + (size_t)l * NEXP * (D / 2), (size_t)NEXP * D, SCALE_U4);
        cvt_rows_fp4(C, inptr(C, 18) + (size_t)l * NEXP * D, nullptr, C.ws + WS_V + (size_t)l * NEXP * (D / 2), (size_t)NEXP * D, SCALE_V4);
#else
        cvt_rows_fp8(C, inptr(C, 17) + (size_t)l * NEXP * D, inptr(C, 13) + (size_t)l * D, C.ws + WS_U + (size_t)l * NEXP * D, (size_t)NEXP * D, 1024.f);
        cvt_rows_fp8(C, inptr(C, 18) + (size_t)l * NEXP * D, nullptr, C.ws + WS_V + (size_t)l * NEXP * D, (size_t)NEXP * D, 64.f);
#endif
    }
    cvt_layer_weights(C, 0);
    const int gw = C.bx * NWAVES + C.wave, NGW = C.G * NWAVES;
    const float* x = inptr(C, 0); bf16_t* XB = (bf16_t*)(C.ws + WS_XB); float* RS = (float*)(C.ws + WS_RSTD);
    f32x4 nv[8];
    { const f32x4* xr = (const f32x4*)(x + (size_t)min(gw, T - 1) * D) + C.lane;
#pragma unroll
      for (int j = 0; j < 8; ++j) nv[j] = xr[64 * j]; }
    for (int m = gw; m < T; m += NGW) {
        f32x4 v[8]; float s = 0.f;
#pragma unroll
        for (int j = 0; j < 8; ++j) { v[j] = nv[j]; s += (v[j][0] * v[j][0] + v[j][1] * v[j][1]) + (v[j][2] * v[j][2] + v[j][3] * v[j][3]); }
        { const f32x4* xr = (const f32x4*)(x + (size_t)min(m + NGW, T - 1) * D) + C.lane;
#pragma unroll
          for (int j = 0; j < 8; ++j) nv[j] = xr[64 * j]; }
        s = wave_sum(s);
        u32x2* o = (u32x2*)(XB + (size_t)m * D) + C.lane; unsigned* o8 = (unsigned*)(C.ws + WS_XB8 + (size_t)m * D) + C.lane;
#pragma unroll
        for (int j = 0; j < 8; ++j) { u32x2 w; w.x = pk2(v[j][0], v[j][1]); w.y = pk2(v[j][2], v[j][3]); o[64 * j] = w;
            int pk = 0; pk = __builtin_amdgcn_cvt_pk_fp8_f32(fminf(fmaxf(v[j][0], -448.f), 448.f), fminf(fmaxf(v[j][1], -448.f), 448.f), pk, false);
            pk = __builtin_amdgcn_cvt_pk_fp8_f32(fminf(fmaxf(v[j][2], -448.f), 448.f), fminf(fmaxf(v[j][3], -448.f), 448.f), pk, true); o8[64 * j] = (unsigned)pk; }
        if (C.lane == 0) RS[m] = rsqrtf(s * (1.0f / D) + EPS);
    }
}

__device__ __forceinline__ void att_naive(const Ctx& C) {
    const bf16_t* P = (const bf16_t*)(C.ws + WS_PQKV); bf16_t* OG = (bf16_t*)(C.ws + WS_OG); float* LSE = (float*)(C.ws + WS_LSE); const float* rel = inptr(C, 1);
    LAS float* pl = (LAS float*)(C.lds + C.wave * 1024);
    const int gw = C.bx * NWAVES + C.wave, NGW = C.G * NWAVES, lane = C.lane;
    for (int item = gw; item < 12 * T; item += NGW) {
        const int gh = item / T, token = item - gh * T, g = gh >> 2, h = gh & 3;
        const int d = g == 0 ? 1 : (g == 1 ? 4 : 16);
        const int tl = token & (SEQ - 1);
        const int jmax = min(128, tl / d);
        const bf16_t* qrow = P + (size_t)token * 4608 + gh * 128;
        float lg[3]; bool okk[3];
#pragma unroll
        for (int s = 0; s < 3; ++s) {
            const int j = lane + 64 * s; const bool ok = (j <= jmax); const int jj = ok ? j : 0;
            const bf16_t* krow = P + (size_t)(token - jj * d) * 4608 + 1536 + gh * 128;
            float acc = 0.f;
#pragma unroll 4
            for (int c = 0; c < 16; ++c) acc += dot8(*(const u32x4*)(qrow + c * 8), *(const u32x4*)(krow + c * 8));
            const float bias = rel[(int)kBucket[g * 129 + jj] * 12 + gh];
            lg[s] = ok ? acc + bias : -1e30f; okk[s] = ok;
        }
        const float mx = wave_max(fmaxf(lg[0], fmaxf(lg[1], lg[2])));
        const float e0 = okk[0] ? __expf(lg[0] - mx) : 0.f, e1 = okk[1] ? __expf(lg[1] - mx) : 0.f, e2 = okk[2] ? __expf(lg[2] - mx) : 0.f;
        const float ssum = wave_sum(e0 + e1 + e2);
        pl[lane] = e0; pl[lane + 64] = e1; if (lane == 0) pl[128] = e2;
        LDS_WAIT();
        float o0 = 0.f, o1 = 0.f;
        const bf16_t* vb = P + (size_t)token * 4608 + 3072 + gh * 128 + 2 * lane;
        for (int j = 0; j <= jmax; ++j) { const float p = pl[j]; const unsigned vv = *(const unsigned*)(vb - (size_t)j * d * 4608); o0 += p * bflo(vv); o1 += p * bfhi(vv); }
        const float inv = 1.0f / ssum;
        *(unsigned*)(OG + ((size_t)g * T + token) * 512 + h * 128 + 2 * lane) = pk2(o0 * inv, o1 * inv);
        if (lane == 0) LSE[((size_t)g * T + token) * 4 + h] = mx + __logf(ssum);
        LDS_WAIT();
    }
}
__device__ __forceinline__ void vss_rows(const Ctx& C) {
    const GAS bf16_t* PA = (const GAS bf16_t*)(C.ws + WS_PA); GAS float* VS = (GAS float*)(C.ws + WS_RSTD + 131072);
    const int gw = C.bx * NWAVES + C.wave, NGW = C.G * NWAVES;
    u32x4 n0, n1;
    { const GAS u32x4* r = (const GAS u32x4*)(PA + (size_t)min(gw, T - 1) * 2048 + 1024) + C.lane; n0 = r[0]; n1 = r[64]; }
    for (int m = gw; m < T; m += NGW) {
        const u32x4 w0 = n0, w1 = n1;
        { const GAS u32x4* r = (const GAS u32x4*)(PA + (size_t)min(m + NGW, T - 1) * 2048 + 1024) + C.lane; n0 = r[0]; n1 = r[64]; }
        const float s = wave_sum(dot8(w0, w0) + dot8(w1, w1));
        if (C.lane == 0) VS[m] = rsqrtf(s * (1.0f / 1024.0f) + EPS);
    }
}
__device__ __forceinline__ void mixa_naive(const Ctx& C, int l) {
    const bf16_t* PA = (const bf16_t*)(C.ws + WS_PA); const float* VS = (const float*)(C.ws + WS_RSTD + 131072); const bf16_t* WM = (const bf16_t*)(C.ws + WS_WM);
    bf16_t* YA = (bf16_t*)(C.ws + WS_YA); const float* ang = inptr(C, 4) + (size_t)l * 1024; const float* bs = inptr(C, 6) + (size_t)l * 1024;
    const int gw = C.bx * NWAVES + C.wave, NGW = C.G * NWAVES, lane = C.lane;
    for (int item = gw; item < 8 * T; item += NGW) {
        const int h = item / T, token = item - h * T, t = token & 127, c0 = token - t;
        float s0 = 0.f, s1 = 0.f;
        const bf16_t* wrow = WM + ((size_t)h * 128 + t) * 128;
        for (int s = 0; s <= t; ++s) { const float w = bf2f(wrow[s]) * VS[c0 + s]; const unsigned vv = *(const unsigned*)(PA + (size_t)(c0 + s) * 2048 + 1024 + h * 128 + 2 * lane); s0 += w * bflo(vv); s1 += w * bfhi(vv); }
        const float b = bs[h * 128 + t];
        const float S0 = s0 * ang[h * 128 + 2 * lane] + b, S1 = s1 * ang[h * 128 + 2 * lane + 1] + b;
        const unsigned uu = *(const unsigned*)(PA + (size_t)token * 2048 + h * 128 + 2 * lane);
        *(unsigned*)(YA + (size_t)token * 2560 + h * 128 + 2 * lane) = pk2(bflo(uu) * S0, bfhi(uu) * S1);
    }
}
__device__ __forceinline__ void mixb_naive(const Ctx& C) {
    const bf16_t* PB = (const bf16_t*)(C.ws + WS_PB); const bf16_t* WP = (const bf16_t*)(C.ws + WS_WP); bf16_t* YB = (bf16_t*)(C.ws + WS_YA);
    const int half = C.tid >> 8, c = C.tid & 255; LAS float* dsh = (LAS float*)(C.lds + half * 1024);
    for (int base = C.bx * 2; base < 4 * T; base += C.G * 2) {
        const int it = base + half, gb = it & 3, token = it >> 2, tl = token & (SEQ - 1);
        const int w = 2 << gb, cnt = min(w, tl + 1), col = gb * 256 + c;
        float sum = 0.f;
        for (int j = 0; j < cnt; ++j) sum += bf2f(PB[(size_t)(token - j) * 1024 + col]);
        dsh[c] = sum / (float)cnt - bf2f(PB[(size_t)token * 1024 + col]);
        __syncthreads();
        const bf16_t* wr = WP + ((size_t)gb * 256 + c) * 256; float y = 0.f;
#pragma unroll 4
        for (int k = 0; k < 256; k += 8) { const u32x4 wv = *(const u32x4*)(wr + k);
            y += dsh[k] * bflo(wv.x) + dsh[k + 1] * bfhi(wv.x) + dsh[k + 2] * bflo(wv.y) + dsh[k + 3] * bfhi(wv.y) + dsh[k + 4] * bflo(wv.z) + dsh[k + 5] * bfhi(wv.z) + dsh[k + 6] * bflo(wv.w) + dsh[k + 7] * bfhi(wv.w); }
        YB[(size_t)token * 2560 + 1024 + col] = (bf16_t)f2bf(y);
        __syncthreads();
    }
}
struct BgRow { f32x4 x[8]; };
__device__ __forceinline__ void bg_load(BgRow& r, const GAS float* row, int lane) {
    asm volatile("" : "+v"(lane));
#pragma unroll
    for (int q = 0; q < 8; ++q) r.x[q] = *(const GAS f32x4*)(row + 32 * lane + 4 * q); }
template <bool GAIN> __device__ __forceinline__ void bg_store(const BgRow& r, const GAS float* gain, GAS unsigned char* dst, int lane) {
    asm volatile("" : "+v"(lane));
    u32x4 w;
#pragma unroll
    for (int q = 0; q < 4; ++q) { unsigned pk = 0u; f32x4 a = r.x[2 * q], b2 = r.x[2 * q + 1];
        if (GAIN) { a = a * *(const GAS f32x4*)(gain + 32 * lane + 8 * q) * SCALE_U4; b2 = b2 * *(const GAS f32x4*)(gain + 32 * lane + 8 * q + 4) * SCALE_U4; } else { a = a * SCALE_V4; b2 = b2 * SCALE_V4; }
        pk = __builtin_amdgcn_cvt_scalef32_pk_fp4_f32(pk, a[0], a[1], 1.0f, 0); pk = __builtin_amdgcn_cvt_scalef32_pk_fp4_f32(pk, a[2], a[3], 1.0f, 1);
        pk = __builtin_amdgcn_cvt_scalef32_pk_fp4_f32(pk, b2[0], b2[1], 1.0f, 2); pk = __builtin_amdgcn_cvt_scalef32_pk_fp4_f32(pk, b2[2], b2[3], 1.0f, 3); w[q] = pk; }
    *(GAS u32x4*)(dst + 16 * lane) = w; }
__device__ __forceinline__ void combine_groups(const Ctx& C, bool bg = false) {
    const GAS float* bgsrc = (const GAS float*)inptr(C, 17); const GAS float* bggain = (const GAS float*)inptr(C, 13); GAS unsigned char* bgdst = (GAS unsigned char*)(C.ws + WS_U); BgRow bgr; int bgj = 0;
    const GAS bf16_t* OG = (const GAS bf16_t*)(C.ws + WS_OG); const GAS float* LSE = (const GAS float*)(C.ws + WS_LSE); GAS bf16_t* YC = (GAS bf16_t*)(C.ws + WS_YA);
    const int gw = C.bx * NWAVES + C.wave, NGW = C.G * NWAVES, lane = C.lane, h = lane >> 4;
    float nl0 = 0.f, nl1 = 0.f, nl2 = 0.f; u32x4 na = {0u, 0u, 0u, 0u}, nb = na, nc = na;
#define CMB_LOAD(m_) do { const int mm_ = min((m_), T - 1); nl0 = LSE[((size_t)0 * T + mm_) * 4 + h]; nl1 = LSE[((size_t)1 * T + mm_) * 4 + h]; nl2 = LSE[((size_t)2 * T + mm_) * 4 + h]; \
        na = *((const GAS u32x4*)(OG + ((size_t)0 * T + mm_) * 512) + lane); nb = *((const GAS u32x4*)(OG + ((size_t)1 * T + mm_) * 512) + lane); nc = *((const GAS u32x4*)(OG + ((size_t)2 * T + mm_) * 512) + lane); } while (0)
    CMB_LOAD(gw);
    for (int m = gw; m < T; m += NGW) {
        const float l0 = nl0, l1 = nl1, l2 = nl2; const u32x4 a = na, b = nb, c = nc;
        CMB_LOAD(m + NGW);
        const int bgrow = 8192 + bgj * NGW + gw; const bool bgon = bg && bgj < 4; ++bgj;
        if (bgon) bg_load(bgr, bgsrc + (size_t)bgrow * D, lane);
        const float mx = fmaxf(l0, fmaxf(l1, l2)); float w0 = __expf(l0 - mx), w1 = __expf(l1 - mx), w2 = __expf(l2 - mx); const float inv = 1.0f / (w0 + w1 + w2); w0 *= inv; w1 *= inv; w2 *= inv;
        if (BR8) { w0 *= Y8S; w1 *= Y8S; w2 *= Y8S; u32x2 o;
            o.x = pk4_fp8(w0 * bflo(a.x) + w1 * bflo(b.x) + w2 * bflo(c.x), w0 * bfhi(a.x) + w1 * bfhi(b.x) + w2 * bfhi(c.x), w0 * bflo(a.y) + w1 * bflo(b.y) + w2 * bflo(c.y), w0 * bfhi(a.y) + w1 * bfhi(b.y) + w2 * bfhi(c.y));
            o.y = pk4_fp8(w0 * bflo(a.z) + w1 * bflo(b.z) + w2 * bflo(c.z), w0 * bfhi(a.z) + w1 * bfhi(b.z) + w2 * bfhi(c.z), w0 * bflo(a.w) + w1 * bflo(b.w) + w2 * bflo(c.w), w0 * bfhi(a.w) + w1 * bfhi(b.w) + w2 * bfhi(c.w));
            *((GAS u32x2*)((GAS unsigned char*)YC + (size_t)m * 2560 + 2048) + lane) = o; }
        else { u32x4 o;
        o.x = pk2(w0 * bflo(a.x) + w1 * bflo(b.x) + w2 * bflo(c.x), w0 * bfhi(a.x) + w1 * bfhi(b.x) + w2 * bfhi(c.x));
        o.y = pk2(w0 * bflo(a.y) + w1 * bflo(b.y) + w2 * bflo(c.y), w0 * bfhi(a.y) + w1 * bfhi(b.y) + w2 * bfhi(c.y));
        o.z = pk2(w0 * bflo(a.z) + w1 * bflo(b.z) + w2 * bflo(c.z), w0 * bfhi(a.z) + w1 * bfhi(b.z) + w2 * bfhi(c.z));
        o.w = pk2(w0 * bflo(a.w) + w1 * bflo(b.w) + w2 * bflo(c.w), w0 * bfhi(a.w) + w1 * bfhi(b.w) + w2 * bfhi(c.w));
        *((GAS u32x4*)(YC + (size_t)m * 2560 + 2048) + lane) = o; }
        if (bgon) bg_store<true>(bgr, bggain, bgdst + (size_t)bgrow * (D / 2), lane);
    }
#undef CMB_LOAD
}
__device__ __forceinline__ void peer_naive(const Ctx& C, int l, bool last) {
    LAS float* xs = (LAS float*)(C.lds); LAS float* sc = (LAS float*)(C.lds + 8192);
    LAS float* v1s = (LAS float*)(C.lds + 16384); LAS int* i1s = (LAS int*)(C.lds + 16896); LAS float* v2s = (LAS float*)(C.lds + 17408); LAS int* i2s = (LAS int*)(C.lds + 17920);
    LAS int* ex = (LAS int*)(C.lds + 18432); LAS float* gt = (LAS float*)(C.lds + 18944); LAS float* hs = (LAS float*)(C.lds + 19456); LAS float* red = (LAS float*)(C.lds + 19968);
    LAS float* selv = (LAS float*)(C.lds + 20480); LAS int* sele = (LAS int*)(C.lds + 20992);
    const float* SC = (const float*)(C.ws + WS_PQKV); const bf16_t* U = (const bf16_t*)(C.ws + WS_U) + (size_t)l * NEXP * D; const bf16_t* V = (const bf16_t*)(C.ws + WS_V) + (size_t)l * NEXP * D;
    bf16_t* XB = (bf16_t*)(C.ws + WS_XB); float* RS = (float*)(C.ws + WS_RSTD); const float* fg = inptr(C, 19);
    const int tid = C.tid, lane = C.lane, wave = C.wave, h = wave;
    for (int token = C.bx; token < T; token += C.G) {
        const f32x4 xv = *((const f32x4*)(C.out + (size_t)token * D) + tid);
        *((LAS f32x4*)xs + tid) = xv; *((LAS f32x4*)sc + tid) = *((const f32x4*)(SC + (size_t)token * D) + tid);
        float ss = wave_sum((xv[0] * xv[0] + xv[1] * xv[1]) + (xv[2] * xv[2] + xv[3] * xv[3]));
        if (lane == 0) red[wave] = ss;
        __syncthreads();
        ss = 0.f;
#pragma unroll
        for (int i = 0; i < 8; ++i) ss += red[i];
        const float rstd = rsqrtf(ss * (1.0f / D) + EPS);
#pragma unroll
        for (int half = 0; half < 2; ++half) { const LAS float* src = sc + h * 256 + half * 128; LAS float* vd = half ? v2s : v1s; LAS int* id = half ? i2s : i1s;
#pragma unroll
            for (int q = 0; q < 2; ++q) { const int j = lane + 64 * q; const float v = src[j]; int rank = 0;
                for (int i = 0; i < 128; ++i) { const float u = src[i]; rank += (u > v || (u == v && i < j)) ? 1 : 0; }
                if (rank < 16) { vd[h * 16 + rank] = v; id[h * 16 + rank] = j; } } }
        __syncthreads();
#pragma unroll
        for (int q = 0; q < 4; ++q) { const int pos = lane + 64 * q; const float cv = v1s[h * 16 + (pos >> 4)] + v2s[h * 16 + (pos & 15)]; int rank = 0;
            for (int i = 0; i < 256; ++i) { const float u = v1s[h * 16 + (i >> 4)] + v2s[h * 16 + (i & 15)]; rank += (u > cv || (u == cv && i < pos)) ? 1 : 0; }
            if (rank < 16) { selv[h * 16 + rank] = cv; sele[h * 16 + rank] = i1s[h * 16 + (pos >> 4)] * 128 + i2s[h * 16 + (pos & 15)]; } }
        __syncthreads();
        { const float v = selv[h * 16 + (lane & 15)] * rstd; float mx = v;
#pragma unroll
          for (int o = 1; o < 16; o <<= 1) mx = fmaxf(mx, __shfl_xor(mx, o));
          const float e = __expf(v - mx); float sm = e;
#pragma unroll
          for (int o = 1; o < 16; o <<= 1) sm += __shfl_xor(sm, o);
          if (lane < 16) { gt[h * 16 + lane] = e / sm; ex[h * 16 + lane] = sele[h * 16 + lane]; } }
        __syncthreads();
        { float xr[32];
#pragma unroll
          for (int i = 0; i < 4; ++i) { const f32x4 a = *(const LAS f32x4*)(xs + i * 512 + lane * 8), b = *(const LAS f32x4*)(xs + i * 512 + lane * 8 + 4);
              xr[i * 8 + 0] = a[0]; xr[i * 8 + 1] = a[1]; xr[i * 8 + 2] = a[2]; xr[i * 8 + 3] = a[3]; xr[i * 8 + 4] = b[0]; xr[i * 8 + 5] = b[1]; xr[i * 8 + 6] = b[2]; xr[i * 8 + 7] = b[3]; }
          for (int kk = 0; kk < 16; ++kk) { const int k = wave * 16 + kk; const bf16_t* urow = U + (size_t)ex[k] * D; float acc = 0.f;
#pragma unroll
              for (int i = 0; i < 4; ++i) { const u32x4 uv = *(const u32x4*)(urow + i * 512 + lane * 8);
                  acc += xr[i * 8 + 0] * bflo(uv.x) + xr[i * 8 + 1] * bfhi(uv.x) + xr[i * 8 + 2] * bflo(uv.y) + xr[i * 8 + 3] * bfhi(uv.y)
                       + xr[i * 8 + 4] * bflo(uv.z) + xr[i * 8 + 5] * bfhi(uv.z) + xr[i * 8 + 6] * bflo(uv.w) + xr[i * 8 + 7] * bfhi(uv.w); }
              acc = wave_sum(acc);
              if (lane == 0) hs[k] = gelu_erf(acc * rstd) * gt[k]; } }
        __syncthreads();
        float y0 = 0.f, y1 = 0.f, y2 = 0.f, y3 = 0.f;
#pragma unroll 8
        for (int k = 0; k < 128; ++k) { const float hk = hs[k]; const u32x2 vv = *(const u32x2*)(V + (size_t)ex[k] * D + tid * 4);
            y0 += hk * bflo(vv.x); y1 += hk * bfhi(vv.x); y2 += hk * bflo(vv.y); y3 += hk * bfhi(vv.y); }
        f32x4 xn; xn[0] = xv[0] + y0; xn[1] = xv[1] + y1; xn[2] = xv[2] + y2; xn[3] = xv[3] + y3;
        float s2 = wave_sum((xn[0] * xn[0] + xn[1] * xn[1]) + (xn[2] * xn[2] + xn[3] * xn[3]));
        if (lane == 0) red[8 + wave] = s2;
        __syncthreads();
        s2 = 0.f;
#pragma unroll
        for (int i = 0; i < 8; ++i) s2 += red[8 + i];
        const float rstd2 = rsqrtf(s2 * (1.0f / D) + EPS);
        if (last) { const f32x4 g = *((const f32x4*)fg + tid); f32x4 o; o[0] = xn[0] * rstd2 * g[0]; o[1] = xn[1] * rstd2 * g[1]; o[2] = xn[2] * rstd2 * g[2]; o[3] = xn[3] * rstd2 * g[3];
            *((f32x4*)(C.out + (size_t)token * D) + tid) = o; }
        else { *((f32x4*)(C.out + (size_t)token * D) + tid) = xn; u32x2 w; w.x = pk2(xn[0], xn[1]); w.y = pk2(xn[2], xn[3]); *((u32x2*)(XB + (size_t)token * D) + tid) = w;
            if (tid == 0) RS[token] = rstd2; }
        __syncthreads();
    }
}


typedef short s16x4 __attribute__((ext_vector_type(4)));
using pg8::bf16x8;
__device__ __forceinline__ s16x4 tr_read(const LAS unsigned char* p) { return __builtin_bit_cast(s16x4, __builtin_amdgcn_ds_read_tr16_b64_v4i16((LAS s16x4*)p)); }
__device__ __forceinline__ bf16x8 cat8(const s16x4 lo, const s16x4 hi) { return __builtin_shufflevector(lo, hi, 0, 1, 2, 3, 4, 5, 6, 7); }
#define MFMA16(a, b, c) __builtin_amdgcn_mfma_f32_16x16x32_bf16((a), (b), (c), 0, 0, 0)
constexpr int VSTR = 288;
constexpr int DSTR = 528;

struct AttUnit { int g, h, d, n, gh, spk0; size_t tok0; };
__device__ __forceinline__ AttUnit att_unit(int u) {
    AttUnit a; a.g = u >> 9; const int rem = u & 511; a.h = rem & 3; const int idx = rem >> 2;
    const int dsh = 2 * a.g, nbs = 4 - dsh; a.d = 1 << dsh;
    const int sb = idx >> nbs; a.n = idx & ((1 << nbs) - 1);
    const int bb = sb >> dsh, r = sb & (a.d - 1); a.gh = a.g * 4 + a.h;
    a.tok0 = (size_t)bb * SEQ + r;
    a.spk0 = (a.n - 1) * 128;
    return a;
}
__device__ __forceinline__ void att_mfma(const Ctx& C, bool bg = false) {
    const GAS float* bgsrc = (const GAS float*)inptr(C, 18); GAS unsigned char* bgdst = (GAS unsigned char*)(C.ws + WS_V); BgRow bgr;
    const GAS unsigned char* P = (const GAS unsigned char*)(C.ws + WS_PQKV); GAS bf16_t* OG = (GAS bf16_t*)(C.ws + WS_OG); GAS float* LSE = (GAS float*)(C.ws + WS_LSE); const GAS float* rel = (const GAS float*)inptr(C, 1);
    LAS unsigned char* vt = C.lds; LAS float* bias = (LAS float*)(C.lds + 256 * VSTR);
    constexpr int KOFF = 74752;
    const int lane = C.lane, wave = C.wave, g4 = lane >> 4, r16 = lane & 15;
    const int chunk = C.tid & 15, row0 = C.tid >> 4;
#define ATT_KDMA(A) do { _Pragma("unroll") for (int j = 0; j < 4; ++j) { const int row = 32 * wave + 8 * j + (lane >> 3), ksp = max((A).spk0 + row, 0), cc = (lane & 7) ^ ((row >> 1) & 7); \
        __builtin_amdgcn_global_load_lds((const GAS unsigned*)(P + ((A).tok0 + (size_t)ksp * (A).d) * 4608 + 1536 + (A).gh * 128 + cc * 16), (LAS unsigned*)(C.lds + KOFF + (32 * wave + 8 * j) * 128), 16, 0, 0); } } while (0)
    u32x2 vv[8]; float bv = 0.f; long qn[4];
#define ATT_PREFETCH(A) do { \
        _Pragma("unroll") for (int i = 0; i < 8; ++i) { const int ksp = (A).spk0 + row0 + 32 * i; vv[i] = *(const GAS u32x2*)(P + ((A).tok0 + (size_t)max(ksp, 0) * (A).d) * 4608 + 3072 + (A).gh * 128 + chunk * 8); } \
        bv = (C.tid < 129) ? rel[(int)kBucket[(A).g * 129 + C.tid] * 12 + (A).gh] : 0.f; \
        { const size_t tq_ = (A).tok0 + (size_t)((A).n * 128 + 16 * wave + r16) * (A).d; \
          _Pragma("unroll") for (int ks = 0; ks < 4; ++ks) qn[ks] = *(const GAS long*)(P + tq_ * 4608 + (A).gh * 128 + 32 * ks + 8 * g4); } } while (0)
    int u = C.bx;
    AttUnit cur = att_unit(u < 1536 ? u : 0);
    if (u < 1536) { __syncthreads(); ATT_KDMA(cur); ATT_PREFETCH(cur); }
    for (; u < 1536; u += C.G) {
        int lane_o = C.lane; asm volatile("" : "+v"(lane_o));
        const int lane = lane_o, g4 = lane >> 4, r16 = lane & 15;
        const int g = cur.g, h = cur.h, d = cur.d, n = cur.n, gh = cur.gh, spk0 = cur.spk0; const size_t tok0 = cur.tok0;
        VM_WAIT();
        __syncthreads();
#pragma unroll
        for (int i = 0; i < 8; ++i) { const int ki = row0 + 32 * i; u32x2 v8 = vv[i]; if (spk0 + ki < 0) v8 = (u32x2){0u, 0u};
            const f32x2 a = __builtin_amdgcn_cvt_pk_f32_fp8((int)v8.x, false), b2 = __builtin_amdgcn_cvt_pk_f32_fp8((int)v8.x, true), c2 = __builtin_amdgcn_cvt_pk_f32_fp8((int)v8.y, false), d2 = __builtin_amdgcn_cvt_pk_f32_fp8((int)v8.y, true);
            u32x4 v; v.x = pk2(a.x, a.y); v.y = pk2(b2.x, b2.y); v.z = pk2(c2.x, c2.y); v.w = pk2(d2.x, d2.y);
            *(LAS u32x4*)(vt + ki * VSTR + chunk * 16) = v; }
        if (C.tid < 129) bias[C.tid] = bv * 1.4426950408889634f;
        long qf[4];
#pragma unroll
        for (int ks = 0; ks < 4; ++ks) qf[ks] = qn[ks];
        const int un = u + C.G;
        if (un < 1536) { cur = att_unit(un); ATT_PREFETCH(cur); }
        __syncthreads();
        const int bgrow = (u / C.G) * (C.G * NWAVES) + C.bx * NWAVES + wave;
        __builtin_amdgcn_sched_barrier(0);
        const int qi = 16 * wave + r16; const size_t tq = tok0 + (size_t)(n * 128 + qi) * d;
        const int ki0 = min(16 * wave, 96);
        f32x4 st[10];
        {
            const LAS unsigned char* kb = C.lds + KOFF + (ki0 + r16) * 128 + (g4 & 1) * 8; const int sw = (r16 >> 1) & 7;
#pragma unroll
            for (int kt = 0; kt < 10; ++kt) { f32x4 acc = {0.f, 0.f, 0.f, 0.f};
#pragma unroll
                for (int ks = 0; ks < 4; ++ks) acc = __builtin_amdgcn_mfma_f32_16x16x32_fp8_fp8(*(const LAS long*)(kb + kt * 2048 + (((2 * ks + (g4 >> 1)) ^ sw) * 16)), qf[ks], acc, 0, 0, 0);
                st[kt] = acc; }
        }
        __syncthreads();
        if (un < 1536) ATT_KDMA(cur);
        if (bg) bg_load(bgr, bgsrc + (size_t)bgrow * D, lane);
        __builtin_amdgcn_sched_barrier(0);
        float mx = -1e30f;
        {
            const int lim = min(128, 128 + qi + spk0), boff = 128 + qi - ki0 - 4 * g4;
            const LAS float* blo = bias + (boff - 147);
#pragma unroll
            for (int kt = 0; kt < 10; ++kt)
#pragma unroll
                for (int i = 0; i < 4; ++i) { const int off = boff - 16 * kt - i; const bool ok = (unsigned)off <= (unsigned)lim;
                    float v = __builtin_fmaf(st[kt][i], 0.08838834764831845f * 1.4426950408889634f, blo[147 - 16 * kt - i]); v = ok ? v : -1e30f; st[kt][i] = v; mx = fmaxf(mx, v); } }
        mx = fmaxf(mx, __shfl_xor(mx, 16)); mx = fmaxf(mx, __shfl_xor(mx, 32));
        float sum = 0.f;
#pragma unroll
        for (int kt = 0; kt < 10; ++kt)
#pragma unroll
            for (int i = 0; i < 4; ++i) { const float ee = __builtin_amdgcn_exp2f(st[kt][i] - mx); st[kt][i] = ee; sum += ee; }
        sum += __shfl_xor(sum, 16); sum += __shfl_xor(sum, 32);
        f32x4 o[8];
#pragma unroll
        for (int mt = 0; mt < 8; ++mt) o[mt] = (f32x4){0.f, 0.f, 0.f, 0.f};
#pragma unroll
        for (int s = 0; s < 5; ++s) {
            u32x4 pw; pw.x = pk2(st[2 * s][0], st[2 * s][1]); pw.y = pk2(st[2 * s][2], st[2 * s][3]); pw.z = pk2(st[2 * s + 1][0], st[2 * s + 1][1]); pw.w = pk2(st[2 * s + 1][2], st[2 * s + 1][3]);
            const bf16x8 pf = __builtin_bit_cast(bf16x8, pw);
            const LAS unsigned char* a0 = vt + (ki0 + 32 * s + 4 * g4 + (r16 >> 2)) * VSTR + (4 * (r16 & 3)) * 2;
#pragma unroll
            for (int mt = 0; mt < 8; ++mt) { const s16x4 lo = tr_read(a0 + 32 * mt), hi = tr_read(a0 + 32 * mt + 16 * VSTR); o[mt] = MFMA16(cat8(lo, hi), pf, o[mt]); }
        }
        const float inv = 1.0f / sum;
        {   LAS unsigned char* os = C.lds + 107520 + wave * 4608;
#pragma unroll
            for (int mt = 0; mt < 8; ++mt) { u32x2 w; w.x = pk2(o[mt][0] * inv, o[mt][1] * inv); w.y = pk2(o[mt][2] * inv, o[mt][3] * inv); *(LAS u32x2*)(os + r16 * 288 + 32 * mt + 8 * g4) = w; }
            LDS_WAIT();
#pragma unroll
            for (int j = 0; j < 4; ++j) { const int row = g4 + 4 * j; const u32x4 v = *(const LAS u32x4*)(os + row * 288 + r16 * 16);
                const size_t tqr = tok0 + (size_t)(n * 128 + 16 * wave + row) * d;
                *(GAS u32x4*)(OG + ((size_t)g * T + tqr) * 512 + h * 128 + r16 * 8) = v; } }
        if (g4 == 0) LSE[((size_t)g * T + tq) * 4 + h] = mx * 0.6931471805599453f + __logf(sum);
        if (bg) bg_store<false>(bgr, nullptr, bgdst + (size_t)bgrow * (D / 2), lane);
    }
#undef ATT_PREFETCH
#undef ATT_KDMA
}
__device__ __forceinline__ void mixa_mfma(const Ctx& C, int l, bool bg = false) {
    const GAS float* bgsrc = (const GAS float*)inptr(C, 17); const GAS float* bggain = (const GAS float*)inptr(C, 13); GAS unsigned char* bgdst = (GAS unsigned char*)(C.ws + WS_U); BgRow bgr;
    const GAS bf16_t* PA = (const GAS bf16_t*)(C.ws + WS_PA); const GAS float* VS = (const GAS float*)(C.ws + WS_RSTD + 131072); const GAS bf16_t* WM = (const GAS bf16_t*)(C.ws + WS_WM);
    GAS bf16_t* YA = (GAS bf16_t*)(C.ws + WS_YA); const GAS float* ang = (const GAS float*)(inptr(C, 4) + (size_t)l * 1024); const GAS float* bs = (const GAS float*)(inptr(C, 6) + (size_t)l * 1024);
    LAS unsigned char* vt = C.lds;
    const int lane = C.lane, wave = C.wave, g4 = lane >> 4, r16 = lane & 15;
    const int chunk = C.tid & 15, row0 = C.tid >> 4, t = 16 * wave + r16;
    u32x4 nv[4]; float nrs[4]; f32x4 nga, ngb; bf16x8 nwf[4]; u32x2 nuu[8]; float nbsv;
#define MIXA_PREFETCH(U) do { const int h_ = (U) & 7; const size_t c0_ = (size_t)((U) >> 3) * 128; \
        nga = *(const GAS f32x4*)(ang + h_ * 128 + chunk * 8); ngb = *(const GAS f32x4*)(ang + h_ * 128 + chunk * 8 + 4); \
        _Pragma("unroll") for (int i = 0; i < 4; ++i) { const int row = row0 + 32 * i; nv[i] = *(const GAS u32x4*)(PA + (c0_ + row) * 2048 + 1024 + h_ * 128 + chunk * 8); nrs[i] = VS[c0_ + row]; } \
        _Pragma("unroll") for (int ks = 0; ks < 4; ++ks) nwf[ks] = *(const GAS bf16x8*)(WM + ((size_t)h_ * 128 + t) * 128 + 32 * ks + 8 * g4); \
        _Pragma("unroll") for (int mt = 0; mt < 8; ++mt) nuu[mt] = *(const GAS u32x2*)(PA + (c0_ + t) * 2048 + h_ * 128 + 16 * mt + 4 * g4); \
        nbsv = bs[h_ * 128 + t]; } while (0)
    int u = C.bx;
    if (u < 1024) MIXA_PREFETCH(u);
    for (; u < 1024; u += C.G) {
        const int h = u & 7; const size_t c0 = (size_t)(u >> 3) * 128;
        __syncthreads();
#pragma unroll
        for (int i = 0; i < 4; ++i) { const int row = row0 + 32 * i; const u32x4 v = nv[i]; const float rs = nrs[i];
            u32x4 w; w.x = pk2(bflo(v.x) * rs * nga[0], bfhi(v.x) * rs * nga[1]); w.y = pk2(bflo(v.y) * rs * nga[2], bfhi(v.y) * rs * nga[3]);
            w.z = pk2(bflo(v.z) * rs * ngb[0], bfhi(v.z) * rs * ngb[1]); w.w = pk2(bflo(v.w) * rs * ngb[2], bfhi(v.w) * rs * ngb[3]);
            *(LAS u32x4*)(vt + row * VSTR + chunk * 16) = w; }
        bf16x8 wf[4]; u32x2 uu[8];
#pragma unroll
        for (int ks = 0; ks < 4; ++ks) wf[ks] = nwf[ks];
#pragma unroll
        for (int mt = 0; mt < 8; ++mt) uu[mt] = nuu[mt];
        const float bsv = nbsv;
        __syncthreads();
        if (u + C.G < 1024) MIXA_PREFETCH(u + C.G);
        const int bgrow = (u / C.G) * (C.G * NWAVES) + C.bx * NWAVES + wave;
        if (bg) bg_load(bgr, bgsrc + (size_t)bgrow * D, lane);
        __builtin_amdgcn_sched_barrier(0);
        f32x4 acc[8];
#pragma unroll
        for (int mt = 0; mt < 8; ++mt) acc[mt] = (f32x4){0.f, 0.f, 0.f, 0.f};
        const int nks = (wave >> 1) + 1;
        const size_t token = c0 + t;
#pragma unroll
        for (int ks = 0; ks < 4; ++ks) if (ks < nks) {
            const LAS unsigned char* a0 = vt + (32 * ks + 8 * g4 + (r16 >> 2)) * VSTR + (4 * (r16 & 3)) * 2;
#pragma unroll
            for (int mt = 0; mt < 8; ++mt) { const s16x4 lo = tr_read(a0 + 32 * mt), hi = tr_read(a0 + 32 * mt + 4 * VSTR); acc[mt] = MFMA16(cat8(lo, hi), wf[ks], acc[mt]); }
        }
#pragma unroll
        for (int mt = 0; mt < 8; ++mt) { const int dd = 16 * mt + 4 * g4;
            if (BR8) *(GAS unsigned*)((GAS unsigned char*)YA + token * 2560 + h * 128 + dd) = pk4_fp8(Y8S * bflo(uu[mt].x) * (acc[mt][0] + bsv), Y8S * bfhi(uu[mt].x) * (acc[mt][1] + bsv), Y8S * bflo(uu[mt].y) * (acc[mt][2] + bsv), Y8S * bfhi(uu[mt].y) * (acc[mt][3] + bsv));
            else { u32x2 w; w.x = pk2(bflo(uu[mt].x) * (acc[mt][0] + bsv), bfhi(uu[mt].x) * (acc[mt][1] + bsv)); w.y = pk2(bflo(uu[mt].y) * (acc[mt][2] + bsv), bfhi(uu[mt].y) * (acc[mt][3] + bsv));
            *(LAS u32x2*)(C.lds + 40960 + wave * 4608 + r16 * 288 + dd * 2) = w; } }
        if (!BR8) { LDS_WAIT();
#pragma unroll
            for (int j = 0; j < 4; ++j) { const int row = g4 + 4 * j; const u32x4 v = *(const LAS u32x4*)(C.lds + 40960 + wave * 4608 + row * 288 + r16 * 16);
                *(GAS u32x4*)(YA + (c0 + 16 * wave + row) * 2560 + h * 128 + r16 * 8) = v; } }
        if (bg) bg_store<true>(bgr, bggain, bgdst + (size_t)bgrow * (D / 2), lane);
    }
#undef MIXA_PREFETCH
}
__device__ __forceinline__ void mixb_mfma(const Ctx& C, bool bg = false) {
    const GAS float* bgsrc = (const GAS float*)inptr(C, 18); GAS unsigned char* bgdst = (GAS unsigned char*)(C.ws + WS_V); BgRow bgr;
    const GAS bf16_t* PB = (const GAS bf16_t*)(C.ws + WS_PB); const GAS bf16_t* WP = (const GAS bf16_t*)(C.ws + WS_WP); GAS bf16_t* YB = (GAS bf16_t*)(C.ws + WS_YA);
    LAS unsigned char* dt = C.lds;
    const int lane = C.lane, wave = C.wave, g4 = lane >> 4, r16 = lane & 15;
    for (int u = C.bx; u < 512; u += C.G) {
        const int gb = u & 3, t0 = (u >> 2) * 128, w = 2 << gb;
        __syncthreads();
        {
            const int cp = C.tid & 127, seg = C.tid >> 7, rbeg = 32 * seg, tl0 = (t0 & (SEQ - 1)) + rbeg;
            const GAS bf16_t* pc = PB + (size_t)(t0 + rbeg) * 1024 + gb * 256 + 2 * cp;
            unsigned pv[48];
#pragma unroll
            for (int j = 1; j <= 16; ++j) pv[16 - j] = (tl0 - j >= 0) ? *(const GAS unsigned*)(pc - (size_t)j * 1024) : 0u;
#pragma unroll
            for (int rr = 0; rr < 32; ++rr) pv[16 + rr] = *(const GAS unsigned*)(pc + (size_t)rr * 1024);
            __builtin_amdgcn_sched_barrier(0);
#define MIXB_WINDOW(W) do { float s0 = 0.f, s1 = 0.f; \
                _Pragma("unroll") for (int j = 1; j <= (W); ++j) { s0 += bflo(pv[16 - j]); s1 += bfhi(pv[16 - j]); } \
                _Pragma("unroll") for (int rr = 0; rr < 32; ++rr) { const int tl = tl0 + rr; const unsigned cur = pv[16 + rr], old = pv[16 + rr - (W)]; \
                    s0 += bflo(cur) - bflo(old); s1 += bfhi(cur) - bfhi(old); \
                    const float inv = 1.0f / (float)min((W), tl + 1); \
                    *(LAS unsigned*)(dt + (rbeg + rr) * DSTR + cp * 4) = pk2(s0 * inv - bflo(cur), s1 * inv - bfhi(cur)); } } while (0)
            if (gb == 0) MIXB_WINDOW(2); else if (gb == 1) MIXB_WINDOW(4); else if (gb == 2) MIXB_WINDOW(8); else MIXB_WINDOW(16);
#undef MIXB_WINDOW
        }
        __syncthreads();
        const int bgrow = 12288 + (u / C.G) * (C.G * NWAVES) + C.bx * NWAVES + wave;
        if (bg) bg_load(bgr, bgsrc + (size_t)bgrow * D, lane);
        f32x4 acc[2][8];
#pragma unroll
        for (int mt = 0; mt < 2; ++mt)
#pragma unroll
            for (int nt = 0; nt < 8; ++nt) acc[mt][nt] = (f32x4){0.f, 0.f, 0.f, 0.f};
        bf16x8 af[8][2];
#pragma unroll
        for (int ks = 0; ks < 8; ++ks) { af[ks][0] = *(const GAS bf16x8*)(WP + ((size_t)gb * 256 + 32 * wave + r16) * 256 + 32 * ks + 8 * g4); af[ks][1] = *(const GAS bf16x8*)(WP + ((size_t)gb * 256 + 32 * wave + 16 + r16) * 256 + 32 * ks + 8 * g4); }
        __builtin_amdgcn_sched_barrier(0);
#pragma unroll
        for (int ks = 0; ks < 8; ++ks) {
#pragma unroll
            for (int nt = 0; nt < 8; ++nt) { const bf16x8 bfr = *(const LAS bf16x8*)(dt + (16 * nt + r16) * DSTR + (32 * ks + 8 * g4) * 2); acc[0][nt] = MFMA16(af[ks][0], bfr, acc[0][nt]); acc[1][nt] = MFMA16(af[ks][1], bfr, acc[1][nt]); }
        }
        {
            LAS unsigned char* og = C.lds + 69632;
#pragma unroll
            for (int mt = 0; mt < 2; ++mt)
#pragma unroll
                for (int nt = 0; nt < 8; ++nt) { u32x2 wv; wv.x = pk2s(acc[mt][nt][0], acc[mt][nt][1]); wv.y = pk2s(acc[mt][nt][2], acc[mt][nt][3]);
                    *(LAS u32x2*)(og + (16 * nt + r16) * DSTR + (32 * wave + 16 * mt + 4 * g4) * 2) = wv; }
            __syncthreads();
#pragma unroll
            for (int j = 0; j < 8; ++j) { const int row = 16 * wave + 2 * j + (lane >> 5); const u32x4 v = *(const LAS u32x4*)(og + row * DSTR + (lane & 31) * 16);
                *(GAS u32x4*)(YB + (size_t)(t0 + row) * 2560 + 1024 + gb * 256 + (lane & 31) * 8) = v; } }
        if (bg) bg_store<false>(bgr, nullptr, bgdst + (size_t)bgrow * (D / 2), lane);
    }
}

template <int CTRL> __device__ __forceinline__ unsigned dpp_u(unsigned v) { return (unsigned)__builtin_amdgcn_update_dpp(0, (int)v, CTRL, 0xF, 0xF, false); }
template <int CTRL> __device__ __forceinline__ float dpp_f(float v) { return __int_as_float(__builtin_amdgcn_update_dpp(0, __float_as_int(v), CTRL, 0xF, 0xF, false)); }
__device__ __forceinline__ unsigned row_max_u32(unsigned v) { v = max(v, dpp_u<0xB1>(v)); v = max(v, dpp_u<0x4E>(v)); v = max(v, dpp_u<0x141>(v)); v = max(v, dpp_u<0x140>(v)); return v; }
__device__ __forceinline__ float row_max_f32(float v) { v = fmaxf(v, dpp_f<0xB1>(v)); v = fmaxf(v, dpp_f<0x4E>(v)); v = fmaxf(v, dpp_f<0x141>(v)); v = fmaxf(v, dpp_f<0x140>(v)); return v; }
__device__ __forceinline__ float row_sum_f32(float v) { v += dpp_f<0xB1>(v); v += dpp_f<0x4E>(v); v += dpp_f<0x141>(v); v += dpp_f<0x140>(v); return v; }
__device__ __forceinline__ unsigned mono_key(float v) { const unsigned u = __float_as_uint(v); return u ^ ((unsigned)((int)u >> 31) | 0x80000000u); }
__device__ __forceinline__ unsigned row_top16(unsigned (&k)[8], int r) {
#define CE_(i, j) do { const unsigned hi_ = max(k[i], k[j]), lo_ = min(k[i], k[j]); k[i] = hi_; k[j] = lo_; } while (0)
    CE_(0, 1); CE_(2, 3); CE_(4, 5); CE_(6, 7);
    CE_(0, 2); CE_(1, 3); CE_(4, 6); CE_(5, 7);
    CE_(1, 2); CE_(5, 6);
    CE_(0, 4); CE_(1, 5); CE_(2, 6); CE_(3, 7);
    CE_(2, 4); CE_(3, 5);
    CE_(1, 2); CE_(3, 4); CE_(5, 6);
#undef CE_
    unsigned sel = 0u;
#pragma unroll
    for (int t = 0; t < 16; ++t) {
        const unsigned m = row_max_u32(k[0]);
        const bool win = (k[0] == m);
#pragma unroll
        for (int i = 0; i < 7; ++i) k[i] = win ? k[i + 1] : k[i];
        k[7] = win ? 0u : k[7];
        sel = (r == t) ? m : sel;
    }
    return sel;
}
__device__ __forceinline__ float unmono_key(unsigned k) { return __uint_as_float((k & 0x80000000u) ? (k ^ 0x80000000u) : ~k); }
__device__ __forceinline__ void peer_topk_dpp(const Ctx& C, int lbg = -1) {
    const GAS bf16_t* SC = (const GAS bf16_t*)(C.ws + WS_PQKV); GAS int* EXG = (GAS int*)(C.ws + WS_EXG); GAS float* CVG = (GAS float*)(C.ws + WS_CVG);
    const int lane = C.lane, r = lane & 15, rho = lane >> 4;
    const bool bg = BG_TABLES && lbg >= 0;
    const GAS float* tu = nullptr; const GAS float* tv = nullptr; GAS unsigned char* du = nullptr; GAS unsigned char* dv = nullptr; f32x4 gq[8], bx_[8]; int R = C.bx * NWAVES + C.wave;
    if (bg) { tu = (const GAS float*)(inptr(C, 17) + (size_t)lbg * NEXP * D); tv = (const GAS float*)(inptr(C, 18) + (size_t)lbg * NEXP * D);
        du = (GAS unsigned char*)(C.ws + WS_U + (size_t)lbg * NEXP * (D / 2)); dv = (GAS unsigned char*)(C.ws + WS_V + (size_t)lbg * NEXP * (D / 2));
        const GAS float* gf = (const GAS float*)(inptr(C, 13) + (size_t)lbg * D) + 32 * lane;
#pragma unroll
        for (int q = 0; q < 8; ++q) gq[q] = *(const GAS f32x4*)(gf + 4 * q) * SCALE_U4; }
#define BG_LOAD() do { if (bg && R < 2 * NEXP) { const GAS float* s_ = (R < NEXP ? tu + (size_t)R * D : tv + (size_t)(R - NEXP) * D) + 32 * lane; \
        _Pragma("unroll") for (int q = 0; q < 8; ++q) bx_[q] = *(const GAS f32x4*)(s_ + 4 * q); } } while (0)
#define BG_STORE() do { if (bg && R < 2 * NEXP) { const bool isu_ = R < NEXP; u32x4 w_; \
        _Pragma("unroll") for (int q = 0; q < 4; ++q) { unsigned pk = 0u; f32x4 a = bx_[2 * q], b2 = bx_[2 * q + 1]; \
            if (isu_) { a = a * gq[2 * q]; b2 = b2 * gq[2 * q + 1]; } else { a = a * SCALE_V4; b2 = b2 * SCALE_V4; } \
            pk = __builtin_amdgcn_cvt_scalef32_pk_fp4_f32(pk, a[0], a[1], 1.0f, 0); pk = __builtin_amdgcn_cvt_scalef32_pk_fp4_f32(pk, a[2], a[3], 1.0f, 1); \
            pk = __builtin_amdgcn_cvt_scalef32_pk_fp4_f32(pk, b2[0], b2[1], 1.0f, 2); pk = __builtin_amdgcn_cvt_scalef32_pk_fp4_f32(pk, b2[2], b2[3], 1.0f, 3); w_[q] = pk; } \
        *(GAS u32x4*)((isu_ ? du + (size_t)R * (D / 2) : dv + (size_t)(R - NEXP) * (D / 2)) + 16 * lane) = w_; } R += C.G * NWAVES; } while (0)
    LAS float* selv = (LAS float*)(C.lds + C.wave * 512); LAS int* sele = (LAS int*)(C.lds + C.wave * 512 + 256);
    const int cnt = (r == 0) ? 16 : (r == 1) ? 8 : (r == 2) ? 5 : (r == 3) ? 4 : (r == 4) ? 3 : (r < 8) ? 2 : 1;
    const int NGW = C.G * NWAVES;
    u32x4 nw1, nw2;
    { const int tl = C.wave >> 1, token = C.bx * NWAVES + (tl & 7) + (tl >> 3) * NGW, head = (C.wave & 1) * 4 + rho; const GAS bf16_t* sp = SC + (size_t)min(token, T - 1) * D + head * 256;
#pragma unroll
      for (int i = 0; i < 1; ++i) { nw1 = *(const GAS u32x4*)(sp + 8 * r); nw2 = *(const GAS u32x4*)(sp + 128 + 8 * r); } }
    for (int q = C.wave; ; q += NWAVES) {
        const int tl = q >> 1, token = C.bx * NWAVES + (tl & 7) + (tl >> 3) * NGW;
        if (token >= T) break;
        BG_LOAD();
        const int head = (q & 1) * 4 + rho;
        unsigned k1[8], k2[8];
#pragma unroll
        for (int i = 0; i < 8; ++i) { const float x1 = (i & 1) ? bfhi(nw1[i >> 1]) : bflo(nw1[i >> 1]), x2 = (i & 1) ? bfhi(nw2[i >> 1]) : bflo(nw2[i >> 1]);
            k1[i] = (mono_key(x1) & ~127u) | (unsigned)(127 - (8 * r + i)); k2[i] = (mono_key(x2) & ~127u) | (unsigned)(127 - (8 * r + i)); }
        { const int qn = q + NWAVES, tln = qn >> 1, tokn = C.bx * NWAVES + (tln & 7) + (tln >> 3) * NGW, headn = (qn & 1) * 4 + rho; const GAS bf16_t* spn = SC + (size_t)min(tokn, T - 1) * D + headn * 256;
#pragma unroll
          for (int i = 0; i < 1; ++i) { nw1 = *(const GAS u32x4*)(spn + 8 * r); nw2 = *(const GAS u32x4*)(spn + 128 + 8 * r); } }
        const unsigned s1 = row_top16(k1, r), s2 = row_top16(k2, r);
        const int idx1 = 127 - (int)(s1 & 127u), idx2 = 127 - (int)(s2 & 127u);
        const float v1 = unmono_key(s1 & ~127u), v2 = unmono_key(s2 & ~127u);
        unsigned ck[4];
        {   const float a0 = dpp_f<0x150>(v1), a1 = dpp_f<0x151>(v1), a2 = dpp_f<0x152>(v1), a3 = dpp_f<0x153>(v1), a4 = dpp_f<0x154>(v1);
            const float b0 = dpp_f<0x150>(v2), b1 = dpp_f<0x151>(v2), b2 = dpp_f<0x152>(v2);
            const float v1s6 = dpp_f<0x116>(v1), v2s3 = dpp_f<0x113>(v2);
            const float c0 = v1 + b0; const int t0 = 16 * r;
            const float c1 = a0 + v2; const int t1 = r; const bool ok1 = r >= 1;
            const bool lo2 = r <= 7; const float c2 = lo2 ? a1 + v2 : v1s6 + b1; const int t2 = lo2 ? 16 + r : 16 * (r - 6) + 1; const bool ok2 = r >= 1 && r <= 13;
            const bool m3a = r <= 4, m3b = r <= 6; const float c3 = m3a ? a2 + v2 : m3b ? a3 + v2s3 : a4 + b2; const int t3 = m3a ? 32 + r : m3b ? 48 + (r - 3) : 64 + 2; const bool ok3 = r >= 2 && r <= 7;
            ck[0] = (mono_key(c0) & ~255u) | (unsigned)(255 - t0);
            ck[1] = ok1 ? (mono_key(c1) & ~255u) | (unsigned)(255 - t1) : 0u;
            ck[2] = ok2 ? (mono_key(c2) & ~255u) | (unsigned)(255 - t2) : 0u;
            ck[3] = ok3 ? (mono_key(c3) & ~255u) | (unsigned)(255 - t3) : 0u; }
#define CE4_(i, j) do { const unsigned hi_ = max(ck[i], ck[j]), lo_ = min(ck[i], ck[j]); ck[i] = hi_; ck[j] = lo_; } while (0)
        CE4_(0, 1); CE4_(2, 3); CE4_(0, 2); CE4_(1, 3); CE4_(1, 2);
#undef CE4_
        unsigned selk = 0u;
#pragma unroll
        for (int t = 0; t < 16; ++t) {
            const unsigned m = row_max_u32(ck[0]);
            const bool win = (ck[0] == m);
            ck[0] = win ? ck[1] : ck[0]; ck[1] = win ? ck[2] : ck[1]; ck[2] = win ? ck[3] : ck[2]; ck[3] = win ? 0u : ck[3];
            selk = (r == t) ? m : selk;
        }
        {   const int flat = 255 - (int)(selk & 255u), si = flat >> 4, sj = flat & 15, rb = (lane & 48) * 4;
            const int e1 = __builtin_amdgcn_ds_bpermute(rb + si * 4, idx1), e2 = __builtin_amdgcn_ds_bpermute(rb + sj * 4, idx2);
            const float w1 = __int_as_float(__builtin_amdgcn_ds_bpermute(rb + si * 4, __float_as_int(v1))), w2 = __int_as_float(__builtin_amdgcn_ds_bpermute(rb + sj * 4, __float_as_int(v2)));
            EXG[(size_t)token * 128 + head * 16 + r] = e1 * 128 + e2; CVG[(size_t)token * 128 + head * 16 + r] = w1 + w2; }
        BG_STORE();
    }
    while (bg && R < 2 * NEXP) { BG_LOAD(); BG_STORE(); }
#undef BG_LOAD
#undef BG_STORE
}
__device__ __forceinline__ float transpose_reduce16(const float (&s)[16], int lane) {
    const bool b3 = lane & 8, b2 = lane & 4, b1 = lane & 2, b0 = lane & 1;
    float a[8], b[4], c[2];
#pragma unroll
    for (int q = 0; q < 8; ++q) { const float keep = b3 ? s[q + 8] : s[q], send = b3 ? s[q] : s[q + 8]; a[q] = keep + dpp_f<0x128>(send); }
#pragma unroll
    for (int q = 0; q < 4; ++q) { const float keep = b2 ? a[q + 4] : a[q], send = b2 ? a[q] : a[q + 4]; b[q] = keep + dpp_f<0x141>(send); }
#pragma unroll
    for (int q = 0; q < 2; ++q) { const float keep = b1 ? b[q + 2] : b[q], send = b1 ? b[q] : b[q + 2]; c[q] = keep + dpp_f<0x4E>(send); }
    const float keep = b0 ? c[1] : c[0], send = b0 ? c[0] : c[1];
    float rsum = keep + dpp_f<0xB1>(send);
    rsum += __shfl_xor(rsum, 16); rsum += __shfl_xor(rsum, 32);
    return rsum;
}
__device__ __forceinline__ void peer_gather(const Ctx& C, int l, bool last, bool dry = false) {
    const unsigned char* U8 = C.ws + WS_U + (size_t)l * NEXP * D; const unsigned char* V8 = C.ws + WS_V + (size_t)l * NEXP * D;
    const int* EXG = (const int*)(C.ws + WS_EXG); const float* CVG = (const float*)(C.ws + WS_CVG);
    bf16_t* XB = (bf16_t*)(C.ws + WS_XB); float* RS = (float*)(C.ws + WS_RSTD);
    const int lane = C.lane;
    LAS float* hl = (LAS float*)(C.lds + 8192 + C.wave * 1024); LAS int* el = (LAS int*)(C.lds + 8192 + C.wave * 1024 + 512);
    const int gw = C.bx * NWAVES + C.wave, NGW = C.G * NWAVES;
    for (int token = gw; token < T; token += NGW) {
        f32x4 xq[8]; float ss = 0.f;
        const float* xrow = C.out + (size_t)token * D;
#pragma unroll
        for (int i = 0; i < 2; ++i)
#pragma unroll
            for (int q = 0; q < 4; ++q) { const f32x4 v = *(const f32x4*)(xrow + i * 1024 + lane * 16 + q * 4); xq[i * 4 + q] = v; ss += (v[0] * v[0] + v[1] * v[1]) + (v[2] * v[2] + v[3] * v[3]); }
        const float rstd = rsqrtf(wave_sum(ss) * (1.0f / D) + EPS);
        {
            const int e0 = EXG[(size_t)token * 128 + lane], e1 = EXG[(size_t)token * 128 + 64 + lane];
            const float z0 = CVG[(size_t)token * 128 + lane] * rstd, z1 = CVG[(size_t)token * 128 + 64 + lane] * rstd;
            const float p0 = __expf(z0 - row_max_f32(z0)), p1 = __expf(z1 - row_max_f32(z1));
            const float g0 = p0 / row_sum_f32(p0), g1 = p1 / row_sum_f32(p1);
            el[lane] = e0; el[64 + lane] = e1; hl[lane] = g0; hl[64 + lane] = g1;
        }
        LDS_WAIT();
        for (int b = 0; b < 8; ++b) {
            float s[16];
#pragma unroll
            for (int sb = 0; sb < 2; ++sb) {
                u32x4 ld[16];
#pragma unroll
                for (int j = 0; j < 8; ++j) { const int e = __builtin_amdgcn_readfirstlane(el[b * 16 + sb * 8 + j]); const unsigned char* rowp = U8 + (size_t)e * D + lane * 16;
                    ld[j * 2] = *(const u32x4*)rowp; ld[j * 2 + 1] = *(const u32x4*)(rowp + 1024); }
#pragma unroll
                for (int j = 0; j < 8; ++j) { f32x2 acc = {0.f, 0.f};
#pragma unroll
                    for (int i = 0; i < 2; ++i)
#pragma unroll
                        for (int q = 0; q < 4; ++q) { const int w = (int)ld[j * 2 + i][q]; const f32x4 xv = xq[i * 4 + q];
                            acc = __builtin_amdgcn_cvt_pk_f32_fp8(w, false) * (f32x2){xv[0], xv[1]} + acc; acc = __builtin_amdgcn_cvt_pk_f32_fp8(w, true) * (f32x2){xv[2], xv[3]} + acc; }
                    s[sb * 8 + j] = acc.x + acc.y; }
            }
            const float tot = transpose_reduce16(s, lane);
            const float a = tot * rstd * (1.0f / 1024.0f);
            const float h = gelu_erf(a) * hl[b * 16 + (lane & 15)] * (1.0f / 64.0f);
            LDS_WAIT();
            if (lane < 16) hl[b * 16 + lane] = h;
        }
        LDS_WAIT();
        f32x2 ya[16];
#pragma unroll
        for (int i = 0; i < 16; ++i) ya[i] = (f32x2){0.f, 0.f};
        for (int kb = 0; kb < 16; ++kb) {
            u32x4 ld[16];
#pragma unroll
            for (int j = 0; j < 8; ++j) { const int e = __builtin_amdgcn_readfirstlane(el[kb * 8 + j]); const unsigned char* rowp = V8 + (size_t)e * D + lane * 16;
                ld[j * 2] = *(const u32x4*)rowp; ld[j * 2 + 1] = *(const u32x4*)(rowp + 1024); }
#pragma unroll
            for (int j = 0; j < 8; ++j) { const float hk = hl[kb * 8 + j]; const f32x2 hh = {hk, hk};
#pragma unroll
                for (int i = 0; i < 2; ++i)
#pragma unroll
                    for (int q = 0; q < 4; ++q) { const int w = (int)ld[j * 2 + i][q];
                        ya[(i * 4 + q) * 2] = __builtin_amdgcn_cvt_pk_f32_fp8(w, false) * hh + ya[(i * 4 + q) * 2]; ya[(i * 4 + q) * 2 + 1] = __builtin_amdgcn_cvt_pk_f32_fp8(w, true) * hh + ya[(i * 4 + q) * 2 + 1]; } }
        }
        float s2 = 0.f;
#pragma unroll
        for (int i = 0; i < 8; ++i) { xq[i][0] += ya[i * 2].x; xq[i][1] += ya[i * 2].y; xq[i][2] += ya[i * 2 + 1].x; xq[i][3] += ya[i * 2 + 1].y;
            s2 += (xq[i][0] * xq[i][0] + xq[i][1] * xq[i][1]) + (xq[i][2] * xq[i][2] + xq[i][3] * xq[i][3]); }
        const float rstd2 = rsqrtf(wave_sum(s2) * (1.0f / D) + EPS);
        float* orow = C.out + (size_t)token * D;
        if (dry) { if (rstd2 == 12345.678f) RS[token] = rstd2; }
        else if (last) { const float* fg = inptr(C, 19);
#pragma unroll
            for (int i = 0; i < 2; ++i)
#pragma unroll
                for (int q = 0; q < 4; ++q) { const int d = i * 1024 + lane * 16 + q * 4; const f32x4 g = *(const f32x4*)(fg + d); f32x4 o = xq[i * 4 + q] * rstd2; o = o * g; *(f32x4*)(orow + d) = o; } }
        else {
#pragma unroll
            for (int i = 0; i < 2; ++i)
#pragma unroll
                for (int q = 0; q < 4; ++q) { const int d = i * 1024 + lane * 16 + q * 4; const f32x4 v = xq[i * 4 + q]; *(f32x4*)(orow + d) = v;
                    u32x2 w; w.x = pk2(v[0], v[1]); w.y = pk2(v[2], v[3]); *(u32x2*)(XB + (size_t)token * D + d) = w; }
            if (lane == 0) RS[token] = rstd2; }
        LDS_WAIT();
    }
}


template <int CTRL> __device__ __forceinline__ float xsel_add(bool sel, float lo, float hi) { const float keep = sel ? hi : lo, send = sel ? lo : hi; return keep + dpp_f<CTRL>(send); }
__device__ __forceinline__ float treduce8(const float (&v)[8], int lane) {
    const bool b2 = lane & 4, b1 = lane & 2, b0 = lane & 1;
    float a[4], c[2];
#pragma unroll
    for (int q = 0; q < 4; ++q) a[q] = xsel_add<0x141>(b2, v[q], v[q + 4]);
#pragma unroll
    for (int q = 0; q < 2; ++q) c[q] = xsel_add<0x4E>(b1, a[q], a[q + 2]);
    return xsel_add<0xB1>(b0, c[0], c[1]);
}
__device__ __forceinline__ float xsel_add_shfl(bool sel, float lo, float hi, int m) { const float keep = sel ? hi : lo, send = sel ? lo : hi; return keep + __shfl_xor(send, m); }
__device__ __forceinline__ void peer_sweep(const Ctx& C, int l, bool last, bool dry = false) {
    #if PEER_FP4
    const GAS unsigned char* U8 = (const GAS unsigned char*)(C.ws + WS_U + (size_t)l * NEXP * (D / 2)); const GAS unsigned char* V8 = (const GAS unsigned char*)(C.ws + WS_V + (size_t)l * NEXP * (D / 2));
    typedef u32x2 ldv_t; constexpr int PIECE = 64, ROWSH = 10; constexpr float INV_SU = 1.0f / SCALE_U4, INV_SV = 1.0f / SCALE_V4;
#define PEER_CVT(w, k) __builtin_amdgcn_cvt_scalef32_pk_f32_fp4((w), 1.0f, (k))
#define PEER_DOT(LDV, XV, a2) do { \
        a2 = PEER_CVT(LDV.x, 0) * (f32x2){XV[0][0], XV[0][1]} + a2; a2 = PEER_CVT(LDV.x, 1) * (f32x2){XV[0][2], XV[0][3]} + a2; a2 = PEER_CVT(LDV.x, 2) * (f32x2){XV[1][0], XV[1][1]} + a2; a2 = PEER_CVT(LDV.x, 3) * (f32x2){XV[1][2], XV[1][3]} + a2; \
        a2 = PEER_CVT(LDV.y, 0) * (f32x2){XV[2][0], XV[2][1]} + a2; a2 = PEER_CVT(LDV.y, 1) * (f32x2){XV[2][2], XV[2][3]} + a2; a2 = PEER_CVT(LDV.y, 2) * (f32x2){XV[3][0], XV[3][1]} + a2; a2 = PEER_CVT(LDV.y, 3) * (f32x2){XV[3][2], XV[3][3]} + a2; } while (0)
#define PEER_AXPY(LDV, hh, ya) do { \
        ya[0] = PEER_CVT(LDV.x, 0) * hh + ya[0]; ya[1] = PEER_CVT(LDV.x, 1) * hh + ya[1]; ya[2] = PEER_CVT(LDV.x, 2) * hh + ya[2]; ya[3] = PEER_CVT(LDV.x, 3) * hh + ya[3]; \
        ya[4] = PEER_CVT(LDV.y, 0) * hh + ya[4]; ya[5] = PEER_CVT(LDV.y, 1) * hh + ya[5]; ya[6] = PEER_CVT(LDV.y, 2) * hh + ya[6]; ya[7] = PEER_CVT(LDV.y, 3) * hh + ya[7]; } while (0)
#else
    const GAS unsigned char* U8 = (const GAS unsigned char*)(C.ws + WS_U + (size_t)l * NEXP * D); const GAS unsigned char* V8 = (const GAS unsigned char*)(C.ws + WS_V + (size_t)l * NEXP * D);
    typedef u32x4 ldv_t; constexpr int PIECE = 128, ROWSH = 11; constexpr float INV_SU = 1.0f / 1024.0f, INV_SV = 1.0f / 64.0f;
#define PEER_DOT(LDV, XV, a2) do { \
        a2 = __builtin_amdgcn_cvt_pk_f32_fp8((int)LDV.x, false) * (f32x2){XV[0][0], XV[0][1]} + a2; a2 = __builtin_amdgcn_cvt_pk_f32_fp8((int)LDV.x, true) * (f32x2){XV[0][2], XV[0][3]} + a2; \
        a2 = __builtin_amdgcn_cvt_pk_f32_fp8((int)LDV.y, false) * (f32x2){XV[1][0], XV[1][1]} + a2; a2 = __builtin_amdgcn_cvt_pk_f32_fp8((int)LDV.y, true) * (f32x2){XV[1][2], XV[1][3]} + a2; \
        a2 = __builtin_amdgcn_cvt_pk_f32_fp8((int)LDV.z, false) * (f32x2){XV[2][0], XV[2][1]} + a2; a2 = __builtin_amdgcn_cvt_pk_f32_fp8((int)LDV.z, true) * (f32x2){XV[2][2], XV[2][3]} + a2; \
        a2 = __builtin_amdgcn_cvt_pk_f32_fp8((int)LDV.w, false) * (f32x2){XV[3][0], XV[3][1]} + a2; a2 = __builtin_amdgcn_cvt_pk_f32_fp8((int)LDV.w, true) * (f32x2){XV[3][2], XV[3][3]} + a2; } while (0)
#define PEER_AXPY(LDV, hh, ya) do { \
        ya[0] = __builtin_amdgcn_cvt_pk_f32_fp8((int)LDV.x, false) * hh + ya[0]; ya[1] = __builtin_amdgcn_cvt_pk_f32_fp8((int)LDV.x, true) * hh + ya[1]; \
        ya[2] = __builtin_amdgcn_cvt_pk_f32_fp8((int)LDV.y, false) * hh + ya[2]; ya[3] = __builtin_amdgcn_cvt_pk_f32_fp8((int)LDV.y, true) * hh + ya[3]; \
        ya[4] = __builtin_amdgcn_cvt_pk_f32_fp8((int)LDV.z, false) * hh + ya[4]; ya[5] = __builtin_amdgcn_cvt_pk_f32_fp8((int)LDV.z, true) * hh + ya[5]; \
        ya[6] = __builtin_amdgcn_cvt_pk_f32_fp8((int)LDV.w, false) * hh + ya[6]; ya[7] = __builtin_amdgcn_cvt_pk_f32_fp8((int)LDV.w, true) * hh + ya[7]; } while (0)
#endif
    const GAS int* EXG = (const GAS int*)(C.ws + WS_EXG); const GAS float* CVG = (const GAS float*)(C.ws + WS_CVG);
    GAS bf16_t* XB = (GAS bf16_t*)(C.ws + WS_XB); GAS unsigned char* XB8 = (GAS unsigned char*)(C.ws + WS_XB8); GAS float* RS = (GAS float*)(C.ws + WS_RSTD); GAS float* OUT = (GAS float*)C.out;
    const int lane = C.lane, j8 = lane & 7, gidx = lane >> 3;
    LAS unsigned char* wl = C.lds + C.wave * 14464;
    LAS float* acc = (LAS float*)wl;
    LAS int* el = (LAS int*)(wl + 4096);
    LAS float* gl = (LAS float*)(wl + 8192);
    LAS float* ssl = (LAS float*)(wl + 12288);
    LAS float* rsl = (LAS float*)(wl + 14336);
    const int gw = C.bx * NWAVES + C.wave, NGW = C.G * NWAVES;
    for (int tbase = gw; tbase < T; tbase += 8 * NGW) {
        const int ntk = min(8, (T - tbase + NGW - 1) / NGW);
        for (int tk = 0; tk < ntk; ++tk) { const int token = tbase + tk * NGW; const GAS float* xrow = OUT + (size_t)token * D; float ss = 0.f;
#pragma unroll
            for (int q = 0; q < 8; ++q) { const f32x4 v = *(const GAS f32x4*)(xrow + q * 256 + lane * 4); ss += (v[0] * v[0] + v[1] * v[1]) + (v[2] * v[2] + v[3] * v[3]); }
            const float rstd = rsqrtf(wave_sum(ss) * (1.0f / D) + EPS);
            const int e0 = EXG[(size_t)token * 128 + lane], e1 = EXG[(size_t)token * 128 + 64 + lane];
            const float z0 = CVG[(size_t)token * 128 + lane] * rstd, z1 = CVG[(size_t)token * 128 + 64 + lane] * rstd;
            const float p0 = __expf(z0 - row_max_f32(z0)), p1 = __expf(z1 - row_max_f32(z1));
            el[tk * 128 + lane] = e0; el[tk * 128 + 64 + lane] = e1; gl[tk * 128 + lane] = p0 / row_sum_f32(p0); gl[tk * 128 + 64 + lane] = p1 / row_sum_f32(p1);
            acc[tk * 128 + lane] = 0.f; acc[tk * 128 + 64 + lane] = 0.f; ssl[tk * 64 + lane] = 0.f; if (lane == 0) rsl[tk] = rstd; }
        LDS_WAIT();
        {
            const int nit = 16 * ntk;
#define A_ISSUE(LD, XV, it) do { const int s_ = is_, tk_ = itk_; if ((it) < nit - 1) { if (++itk_ == ntk) { itk_ = 0; ++is_; } } \
                const GAS unsigned char* ub_ = U8 + s_ * PIECE + j8 * (PIECE / 8); const GAS float* xr_ = OUT + (size_t)(tbase + tk_ * NGW) * D + s_ * 128 + j8 * 16; \
                _Pragma("unroll") for (int i = 0; i < 16; ++i) { const unsigned e_ = (unsigned)el[tk_ * 128 + 8 * i + gidx]; LD[i] = *(const GAS ldv_t*)(ub_ + ((size_t)e_ << ROWSH)); } \
                XV[0] = *(const GAS f32x4*)xr_; XV[1] = *(const GAS f32x4*)(xr_ + 4); XV[2] = *(const GAS f32x4*)(xr_ + 8); XV[3] = *(const GAS f32x4*)(xr_ + 12); } while (0)
#define A_COMPUTE(LD, XV, it) do { if ((it) < nit) { const int tk_ = ctk_; if (++ctk_ == ntk) { ctk_ = 0; ++cs_; } float pa[8], pb[8]; \
                _Pragma("unroll") for (int i = 0; i < 16; ++i) { f32x2 a2 = {0.f, 0.f}; \
                    PEER_DOT(LD[i], XV, a2); \
                    if (i < 8) pa[i] = a2.x + a2.y; else pb[i - 8] = a2.x + a2.y; } \
                const float r0_ = treduce8(pa, lane), r1_ = treduce8(pb, lane); \
                LAS float* ap_ = acc + tk_ * 128 + 8 * j8 + gidx; ap_[0] += r0_; ap_[64] += r1_; } } while (0)
            ldv_t ldA[16], ldB[16]; f32x4 xA[4], xB[4]; int is_ = 0, itk_ = 0, cs_ = 0, ctk_ = 0;
            A_ISSUE(ldA, xA, 0);
            for (int it = 0; it < nit; it += 2) {
                A_ISSUE(ldB, xB, it + 1); A_COMPUTE(ldA, xA, it);
                A_ISSUE(ldA, xA, it + 2); A_COMPUTE(ldB, xB, it + 1);
            }
#undef A_ISSUE
#undef A_COMPUTE
        }
        LDS_WAIT();
        for (int tk = 0; tk < ntk; ++tk) { const float rstd = rsl[tk];
#pragma unroll
            for (int m = 0; m < 2; ++m) { const int k = tk * 128 + m * 64 + lane; acc[k] = gelu_erf(acc[k] * rstd * INV_SU) * gl[k] * INV_SV; } }
        LDS_WAIT();
        {
            const int nit = 16 * ntk;
#define Y_ISSUE(LD, XV, it) do { const int s_ = is_, tk_ = itk_; if ((it) < nit - 1) { if (++itk_ == ntk) { itk_ = 0; ++is_; } } \
                const GAS unsigned char* vb_ = V8 + s_ * PIECE + j8 * (PIECE / 8); \
                _Pragma("unroll") for (int i = 0; i < 16; ++i) { const unsigned e_ = (unsigned)el[tk_ * 128 + 8 * i + gidx]; LD[i] = *(const GAS ldv_t*)(vb_ + ((size_t)e_ << ROWSH)); } \
                XV = *(const GAS f32x2*)(OUT + (size_t)(tbase + tk_ * NGW) * D + s_ * 128 + j8 * 16 + 2 * gidx); } while (0)
#define Y_COMPUTE(LD, XV, it) do { if ((it) < nit) { const int s_ = cs_, tk_ = ctk_; if (++ctk_ == ntk) { ctk_ = 0; ++cs_; } const size_t xo_ = (size_t)(tbase + tk_ * NGW) * D + s_ * 128 + j8 * 16 + 2 * gidx; \
                f32x2 ya[8]; _Pragma("unroll") for (int q = 0; q < 8; ++q) ya[q] = (f32x2){0.f, 0.f}; \
                _Pragma("unroll") for (int i = 0; i < 16; ++i) { const float hk = acc[tk_ * 128 + 8 * i + gidx]; const f32x2 hh = {hk, hk}; \
                    PEER_AXPY(LD[i], hh, ya); } \
                const bool b5 = lane & 32, b4 = lane & 16, b3 = lane & 8; float y8[8], y4[4], y2[2]; \
                _Pragma("unroll") for (int q = 0; q < 4; ++q) { y8[2 * q] = xsel_add_shfl(b5, ya[q].x, ya[q + 4].x, 32); y8[2 * q + 1] = xsel_add_shfl(b5, ya[q].y, ya[q + 4].y, 32); } \
                _Pragma("unroll") for (int q = 0; q < 4; ++q) y4[q] = xsel_add_shfl(b4, y8[q], y8[q + 4], 16); \
                _Pragma("unroll") for (int q = 0; q < 2; ++q) y2[q] = xsel_add<0x128>(b3, y4[q], y4[q + 2]); \
                f32x2 xn; xn.x = XV.x + y2[0]; xn.y = XV.y + y2[1]; \
                if (!dry) { *(GAS f32x2*)(OUT + xo_) = xn; if (!last) { *(GAS unsigned*)(XB + xo_) = pk2(xn.x, xn.y); *(GAS unsigned short*)(XB8 + xo_) = (unsigned short)__builtin_amdgcn_cvt_pk_fp8_f32(fminf(fmaxf(xn.x, -448.f), 448.f), fminf(fmaxf(xn.y, -448.f), 448.f), 0, false); } } \
                ssl[tk_ * 64 + lane] += xn.x * xn.x + xn.y * xn.y; } } while (0)
            ldv_t ldA[16], ldB[16]; f32x2 xA, xB; int is_ = 0, itk_ = 0, cs_ = 0, ctk_ = 0;
            Y_ISSUE(ldA, xA, 0);
            for (int it = 0; it < nit; it += 2) {
                Y_ISSUE(ldB, xB, it + 1); Y_COMPUTE(ldA, xA, it);
                Y_ISSUE(ldA, xA, it + 2); Y_COMPUTE(ldB, xB, it + 1);
            }
#undef Y_ISSUE
#undef Y_COMPUTE
        }
        LDS_WAIT();
        for (int tk = 0; tk < ntk; ++tk) { const int token = tbase + tk * NGW;
            const float rstd2 = rsqrtf(wave_sum(ssl[tk * 64 + lane]) * (1.0f / D) + EPS);
            if (dry) { if (rstd2 == 12345.678f) RS[token] = rstd2; }
            else if (!last) { if (lane == 0) RS[token] = rstd2; }
            else { VM_WAIT(); const GAS float* fg = (const GAS float*)inptr(C, 19); GAS float* orow = OUT + (size_t)token * D;
#pragma unroll
                for (int q = 0; q < 8; ++q) { const f32x4 v = *(const GAS f32x4*)(orow + q * 256 + lane * 4), g = *(const GAS f32x4*)(fg + q * 256 + lane * 4); f32x4 o = v * rstd2; o = o * g; *(GAS f32x4*)(orow + q * 256 + lane * 4) = o; } } }
        LDS_WAIT();
    }
}

#undef PEER_DOT
#undef PEER_AXPY

#define F4CVT(w, k) __builtin_amdgcn_cvt_scalef32_pk_f32_fp4((w), 1.0f, (k))
__device__ __forceinline__ void peer_sweep4(const Ctx& C, int l, bool last, bool dry = false) {
    const GAS unsigned char* U4 = (const GAS unsigned char*)(C.ws + WS_U + (size_t)l * NEXP * (D / 2)); const GAS unsigned char* V4 = (const GAS unsigned char*)(C.ws + WS_V + (size_t)l * NEXP * (D / 2));
    const GAS int* EXG = (const GAS int*)(C.ws + WS_EXG); const GAS float* CVG = (const GAS float*)(C.ws + WS_CVG);
    GAS bf16_t* XB = (GAS bf16_t*)(C.ws + WS_XB); GAS unsigned char* XB8 = (GAS unsigned char*)(C.ws + WS_XB8); GAS float* RS = (GAS float*)(C.ws + WS_RSTD); GAS float* OUT = (GAS float*)C.out;
    const int lane = C.lane, j8 = lane & 7, gidx = lane >> 3;
    LAS unsigned char* wl = C.lds + C.wave * 19584;
    LAS float* acc = (LAS float*)wl; LAS int* el = (LAS int*)(wl + 4096); LAS float* gl = (LAS float*)(wl + 8192); LAS unsigned char* vtile = wl + 8192; LAS float* ssl = (LAS float*)(wl + 16384); LAS float* rsl = (LAS float*)(wl + 18432);
    LAS unsigned char* hp = wl + 18496; LAS float* hsc = (LAS float*)(wl + 19520);
    const int gw = C.bx * NWAVES + C.wave, NGW = C.G * NWAVES;
    constexpr float INV_SU = 1.0f / SCALE_U4, INV_SV = 1.0f / SCALE_V4;
    for (int tbase = gw; tbase < T; tbase += 8 * NGW) {
        const int ntk = min(8, (T - tbase + NGW - 1) / NGW);
        {
            u32x2 nxw[8]; int ne0, ne1; float nc0, nc1;
#define SETUP_LOAD(tk_) do { const int tkn_ = min((tk_), ntk - 1); const int tokn_ = tbase + tkn_ * NGW; \
                _Pragma("unroll") for (int q = 0; q < 8; ++q) nxw[q] = *(const GAS u32x2*)(XB + (size_t)tokn_ * D + q * 256 + lane * 4); \
                ne0 = EXG[(size_t)tokn_ * 128 + lane]; ne1 = EXG[(size_t)tokn_ * 128 + 64 + lane]; nc0 = CVG[(size_t)tokn_ * 128 + lane]; nc1 = CVG[(size_t)tokn_ * 128 + 64 + lane]; } while (0)
            SETUP_LOAD(0);
            for (int tk = 0; tk < ntk; ++tk) { const int token = tbase + tk * NGW; float ss = 0.f; f32x4 xr8[8];
#pragma unroll
                for (int q = 0; q < 8; ++q) { const u32x2 wv = nxw[q]; const f32x4 v = {bflo(wv.x), bfhi(wv.x), bflo(wv.y), bfhi(wv.y)}; xr8[q] = v; ss += (v[0] * v[0] + v[1] * v[1]) + (v[2] * v[2] + v[3] * v[3]); }
                const int e0 = ne0, e1 = ne1; const float c0 = nc0, c1 = nc1;
                SETUP_LOAD(tk + 1);
                const float rstd = rsqrtf(wave_sum(ss) * (1.0f / D) + EPS);
                {
                    const float st = 2.0f * rstd; GAS unsigned short* xh = (GAS unsigned short*)(C.ws + WS_XH4 + (size_t)token * (D / 2)) + lane; GAS unsigned short* xl = (GAS unsigned short*)(C.ws + WS_XL4 + (size_t)token * (D / 2)) + lane;
#pragma unroll
                    for (int q = 0; q < 8; ++q) { const f32x4 xs = xr8[q] * st; unsigned ph = 0u, pl = 0u;
                        ph = __builtin_amdgcn_cvt_scalef32_pk_fp4_f32(ph, xs[0], xs[1], 1.0f, 0); ph = __builtin_amdgcn_cvt_scalef32_pk_fp4_f32(ph, xs[2], xs[3], 1.0f, 1);
                        const f32x2 d0 = __builtin_amdgcn_cvt_scalef32_pk_f32_fp4(ph, 1.0f, 0), d1 = __builtin_amdgcn_cvt_scalef32_pk_f32_fp4(ph, 1.0f, 1);
                        pl = __builtin_amdgcn_cvt_scalef32_pk_fp4_f32(pl, 8.f * (xs[0] - d0.x), 8.f * (xs[1] - d0.y), 1.0f, 0); pl = __builtin_amdgcn_cvt_scalef32_pk_fp4_f32(pl, 8.f * (xs[2] - d1.x), 8.f * (xs[3] - d1.y), 1.0f, 1);
                        xh[q * 64] = (unsigned short)ph; xl[q * 64] = (unsigned short)pl; } }
                const float z0 = c0 * rstd, z1 = c1 * rstd;
                const float p0 = __expf(z0 - row_max_f32(z0)), p1 = __expf(z1 - row_max_f32(z1));
                el[tk * 128 + lane] = e0; el[tk * 128 + 64 + lane] = e1; gl[tk * 128 + lane] = p0 / row_sum_f32(p0); gl[tk * 128 + 64 + lane] = p1 / row_sum_f32(p1);
                acc[tk * 128 + lane] = 0.f; acc[tk * 128 + 64 + lane] = 0.f; ssl[tk * 64 + lane] = 0.f; if (lane == 0) rsl[tk] = rstd; }
#undef SETUP_LOAD
        }
        LDS_WAIT(); VM_WAIT();
        {
            const int nit = 8 * ntk, m16 = lane & 15, kc = lane >> 4;
            int is_ = 0, itk_ = 0, ctk_ = 0;
            const GAS unsigned char* XB8r = (const GAS unsigned char*)(C.ws + WS_XB8);
#define A4_ISSUE(LD, H, XV, WITHX) do { const GAS unsigned char* ub_ = U4 + is_ * 128 + (m16 & 1) * 64 + kc * 16; \
                _Pragma("unroll") for (int i = 0; i < 8; ++i) { const unsigned e_ = (unsigned)el[itk_ * 128 + 8 * (8 * (H) + i) + (m16 >> 1)]; LD[i] = *(const GAS u32x4*)(ub_ + ((size_t)e_ << 10)); } \
                if (WITHX) { const size_t xo_ = (size_t)(tbase + itk_ * NGW) * (D / 2) + is_ * 128 + (m16 & 1) * 64 + kc * 16; XV[0] = *(const GAS u32x4*)(XB8r + (WS_XH4 - WS_XB8) + xo_); XV[1] = *(const GAS u32x4*)(XB8r + (WS_XL4 - WS_XB8) + xo_); } } while (0)
#define A4_ADVANCE(it) do { if ((it) < nit - 1) { if (++itk_ == ntk) { itk_ = 0; ++is_; } } } while (0)
#define A4_COMPUTE(LD, XV, H) do { const pg8::pg8_v4i h4_ = __builtin_bit_cast(pg8::pg8_v4i, XV[0]), q4_ = __builtin_bit_cast(pg8::pg8_v4i, XV[1]); \
                const pg8::pg8_v8i xh_ = __builtin_shufflevector(h4_, h4_, 0, 1, 2, 3, 4, 5, 6, 7), xl_ = __builtin_shufflevector(q4_, q4_, 0, 1, 2, 3, 4, 5, 6, 7); \
                _Pragma("unroll") for (int i = 0; i < 8; ++i) { const pg8::pg8_v4i l4_ = __builtin_bit_cast(pg8::pg8_v4i, LD[i]); const pg8::pg8_v8i ua_ = __builtin_shufflevector(l4_, l4_, 0, 1, 2, 3, 4, 5, 6, 7); \
                    f32x4 r_ = __builtin_amdgcn_mfma_scale_f32_16x16x128_f8f6f4(ua_, xl_, (f32x4){0.f, 0.f, 0.f, 0.f}, 4, 4, 0, 0, 0, 0); r_ = r_ * 0.125f; \
                    r_ = __builtin_amdgcn_mfma_scale_f32_16x16x128_f8f6f4(ua_, xh_, r_, 4, 4, 0, 0, 0, 0); \
                    const float t1_ = dpp_f<0xB1>(r_[1]), t3_ = dpp_f<0xB1>(r_[3]); \
                    if (m16 == 0) { LAS f32x2* ap_ = (LAS f32x2*)(acc + ctk_ * 128 + 8 * (8 * (H) + i) + 2 * kc); f32x2 o_ = *ap_; o_.x += r_[0] + t1_; o_.y += r_[2] + t3_; *ap_ = o_; } } } while (0)
#define A4_FINISH() do { if (++ctk_ == ntk) ctk_ = 0; } while (0)
            u32x4 lda[8], ldb[8], x0[2], x1[2];
            A4_ISSUE(lda, 0, x0, true);
            for (int it = 0; it < nit; it += 2) {
                A4_ISSUE(ldb, 1, x0, false); A4_ADVANCE(it);      A4_COMPUTE(lda, x0, 0);
                A4_ISSUE(lda, 0, x1, true);                        A4_COMPUTE(ldb, x0, 1); A4_FINISH();
                A4_ISSUE(ldb, 1, x1, false); A4_ADVANCE(it + 1);  A4_COMPUTE(lda, x1, 0);
                A4_ISSUE(lda, 0, x0, true);                        A4_COMPUTE(ldb, x1, 1); A4_FINISH();
            }
#undef A4_ISSUE
#undef A4_ADVANCE
#undef A4_COMPUTE
#undef A4_FINISH
        }
        LDS_WAIT();
        for (int tk = 0; tk < ntk; ++tk) {
            const int k = tk * 128 + 2 * lane; const f32x2 av = *(LAS f32x2*)(acc + k), gv = *(LAS f32x2*)(gl + k);
            const float h0 = gelu_erf(av.x * (0.5f * INV_SU)) * gv.x * INV_SV, h1 = gelu_erf(av.y * (0.5f * INV_SU)) * gv.y * INV_SV;
            const float mx = wave_max(fmaxf(fabsf(h0), fabsf(h1))), s = mx > 0.f ? 6.0f / mx : 0.f, a0 = h0 * s, a1 = h1 * s;
            const unsigned ph = __builtin_amdgcn_cvt_scalef32_pk_fp4_f32(0u, a0, a1, 1.0f, 0); const f32x2 dh = __builtin_amdgcn_cvt_scalef32_pk_f32_fp4(ph, 1.0f, 0);
            const unsigned pl = __builtin_amdgcn_cvt_scalef32_pk_fp4_f32(0u, 8.f * (a0 - dh.x), 8.f * (a1 - dh.y), 1.0f, 0);
            hp[tk * 128 + lane] = (unsigned char)ph; hp[tk * 128 + 64 + lane] = (unsigned char)pl; if (lane == 0) hsc[tk] = mx * (1.0f / 6.0f); }
        LDS_WAIT();
        {
            const int nit = 8 * ntk;
            int is_ = 0, itk_ = 0, cs_ = 0, ctk_ = 0;
#define Y4_ISSUE(LD, H, XV, WITHX) do { const GAS unsigned char* vb_ = V4 + is_ * 128 + j8 * 16; \
                _Pragma("unroll") for (int i = 0; i < 8; ++i) { const unsigned e_ = (unsigned)el[itk_ * 128 + 8 * (8 * (H) + i) + gidx]; LD[i] = *(const GAS u32x4*)(vb_ + ((size_t)e_ << 10)); } \
                if (WITHX) { const GAS bf16_t* xp_ = XB + (size_t)(tbase + itk_ * NGW) * D + is_ * 256 + lane; \
                    _Pragma("unroll") for (int p = 0; p < 4; ++p) XV[p] = bf2f(xp_[64 * p]); } } while (0)
#define Y4_ADVANCE(it) do { if ((it) < nit - 1) { if (++itk_ == ntk) { itk_ = 0; ++is_; } } } while (0)
#define Y4_COMPUTE(LD, H) do { \
                _Pragma("unroll") for (int i = 0; i < 8; ++i) *(LAS u32x4*)(vtile + (8 * i + gidx) * 128 + ((j8 ^ ((4 * (i & 1) + (gidx >> 1)) & 7)) * 16)) = LD[i]; \
                const int m32_ = lane & 31, kg_ = lane >> 5, li_ = lane & 15, grp_ = (lane >> 4) & 1; \
                pg8::pg8_v4i ha_ = {0, 0, 0, 0}; if (m32_ < 2) ha_ = *(const LAS pg8::pg8_v4i*)(hp + ctk_ * 128 + m32_ * 64 + 32 * (H) + 16 * kg_); \
                const pg8::pg8_v8i ha8_ = __builtin_shufflevector(ha_, ha_, 0, 1, 2, 3, 4, 5, 6, 7); \
                LDS_WAIT(); \
                const LAS unsigned char* tb_ = vtile + (32 * kg_ + li_) * 128 + grp_ * 8; const int sw_ = li_ >> 1; \
                _Pragma("unroll") for (int bk = 0; bk < 8; ++bk) { \
                    const v2i_t t0_ = __builtin_amdgcn_ds_read_tr4_b64_v2i32((LAS v2i_t*)(tb_ + ((bk ^ sw_) * 16))), t1_ = __builtin_amdgcn_ds_read_tr4_b64_v2i32((LAS v2i_t*)(tb_ + 16 * 128 + ((bk ^ sw_) * 16))); \
                    const pg8::pg8_v8i vb8_ = {t0_.x, t0_.y, t1_.x, t1_.y, 0, 0, 0, 0}; \
                    const f32x16 d_ = __builtin_amdgcn_mfma_scale_f32_32x32x64_f8f6f4(ha8_, vb8_, (f32x16){0.f, 0.f, 0.f, 0.f, 0.f, 0.f, 0.f, 0.f, 0.f, 0.f, 0.f, 0.f, 0.f, 0.f, 0.f, 0.f}, 4, 4, 0, 0, 0, 0); \
                    yb[bk] += d_[0] + d_[1] * 0.125f; } \
                LDS_WAIT(); } while (0)
#define Y4_FINISH(XV, it) do { if ((it) < nit) { const size_t xo_ = (size_t)(tbase + ctk_ * NGW) * D + cs_ * 256 + lane; const float hs_ = hsc[ctk_]; float sq_ = 0.f; \
                _Pragma("unroll") for (int p = 0; p < 4; ++p) { const float up_ = __shfl(yb[2 * p + 1], lane & 31); const float xn = XV[p] + (lane < 32 ? yb[2 * p] : up_) * hs_; \
                    if (!dry) { XB[xo_ + 64 * p] = (bf16_t)pk2(xn, 0.f);     \
                        if (!last) { const int pk = __builtin_amdgcn_cvt_pk_fp8_f32(fminf(fmaxf(xn, -448.f), 448.f), 0.f, 0, false); XB8[xo_ + 64 * p] = (unsigned char)pk; } } \
                    sq_ += xn * xn; } \
                ssl[ctk_ * 64 + lane] += sq_; } \
                _Pragma("unroll") for (int q = 0; q < 8; ++q) yb[q] = 0.f; \
                if (++ctk_ == ntk) { ctk_ = 0; ++cs_; } } while (0)
            u32x4 lda[8], ldb[8]; f32x4 x0, x1; float yb[8];
#pragma unroll
            for (int q = 0; q < 8; ++q) yb[q] = 0.f;
            Y4_ISSUE(lda, 0, x0, true);
            for (int it = 0; it < nit; it += 2) {
                Y4_ISSUE(ldb, 1, x0, false); Y4_ADVANCE(it);      Y4_COMPUTE(lda, 0);
                Y4_ISSUE(lda, 0, x1, true);                        Y4_COMPUTE(ldb, 1); Y4_FINISH(x0, it);
                Y4_ISSUE(ldb, 1, x1, false); Y4_ADVANCE(it + 1);  Y4_COMPUTE(lda, 0);
                Y4_ISSUE(lda, 0, x0, true);                        Y4_COMPUTE(ldb, 1); Y4_FINISH(x1, it + 1);
            }
#undef Y4_ISSUE
#undef Y4_ADVANCE
#undef Y4_COMPUTE
#undef Y4_FINISH
        }
        LDS_WAIT();
        if (!last || dry) {
            for (int tk = 0; tk < ntk; ++tk) { const float rstd2 = rsqrtf(wave_sum(ssl[tk * 64 + lane]) * (1.0f / D) + EPS);
                if (dry) { if (rstd2 == 12345.678f) RS[tbase + tk * NGW] = rstd2; } else if (lane == 0) RS[tbase + tk * NGW] = rstd2; } }
        else {
            VM_WAIT(); const GAS float* fg = (const GAS float*)inptr(C, 19);
            f32x4 gq[8]; u32x2 nr[8];
#pragma unroll
            for (int q = 0; q < 8; ++q) { gq[q] = *(const GAS f32x4*)(fg + q * 256 + lane * 4); nr[q] = *(const GAS u32x2*)(XB + (size_t)tbase * D + q * 256 + lane * 4); }
            for (int tk = 0; tk < ntk; ++tk) { GAS float* orow = OUT + (size_t)(tbase + tk * NGW) * D; f32x4 cr[8];
#pragma unroll
                for (int q = 0; q < 8; ++q) cr[q] = (f32x4){bflo(nr[q].x), bfhi(nr[q].x), bflo(nr[q].y), bfhi(nr[q].y)};
                { const GAS bf16_t* nrow = XB + (size_t)(tbase + min(tk + 1, ntk - 1) * NGW) * D;
#pragma unroll
                  for (int q = 0; q < 8; ++q) nr[q] = *(const GAS u32x2*)(nrow + q * 256 + lane * 4); }
                const float rstd2 = rsqrtf(wave_sum(ssl[tk * 64 + lane]) * (1.0f / D) + EPS);
#pragma unroll
                for (int q = 0; q < 8; ++q) { f32x4 o = cr[q] * rstd2; o = o * gq[q]; *(GAS f32x4*)(orow + q * 256 + lane * 4) = o; } } }
        LDS_WAIT();
    }
}
#undef F4CVT

constexpr int NPHASE = 1 + 8 * DEPTH - 1;
struct Args { const float* in[20]; float* out; unsigned char* ws; int ph_lo, ph_hi; };

__global__ void __launch_bounds__(NTHR, 2) fwd(Args args) {
    extern __shared__ __attribute__((aligned(16))) unsigned char lds_raw[];
    Ctx C;
    C.lds = (LAS unsigned char*)lds_raw; C.tid = threadIdx.x; C.lane = C.tid & 63; C.wave = __builtin_amdgcn_readfirstlane(C.tid >> 6); C.G = gridDim.x; C.bx = blockIdx.x;
    C.out = args.out; C.ws = args.ws;
    PG8_LAS unsigned char* lds = (PG8_LAS unsigned char*)lds_raw;
    volatile LAS unsigned* MISC = (volatile LAS unsigned*)(lds + MISC_OFF);
    for (int u = C.tid; u < (LDS_BYTES - TOP_OFF) / 4; u += NTHR) ((LAS unsigned*)(lds + TOP_OFF))[u] = 0u;
    __syncthreads();
    if (C.tid < 20) { const unsigned long long pv = (unsigned long long)args.in[C.tid]; LAS unsigned* p = (LAS unsigned*)(lds + PTR_OFF) + 2 * C.tid; p[0] = (unsigned)pv; p[1] = (unsigned)(pv >> 32); }
    __syncthreads();
    const int lo = args.ph_lo, hi = args.ph_hi;
    unsigned* barw = (unsigned*)(C.ws + WS_CTL) + CW_BAR;
    XcdBarrier bar; bar.bar = barw; bar.x = 0; bar.st = nullptr;
    if (hi - lo > 1) bar = xcd_barrier_post(barw, MISC + 8);
#ifndef PH_MASK
#define PH_MASK 0xFF
#endif
#define PHEN(i) (((PH_MASK) >> (i)) & 1)
#define IN(k) (lo <= (k) && (k) < hi)
#define SEAM(k) do { if (IN(k) && IN((k) + 1)) { xcd_barrier(bar); if (PROBE_DUP == 12) xcd_barrier(bar); } } while (0)

#define PHASE_CTX() Ctx P; P.lds = C.lds; P.out = C.out; P.ws = C.ws; P.G = C.G; P.bx = C.bx; P.tid = C.tid; \
    asm volatile("" : "+s"(P.out), "+s"(P.ws), "+s"(P.G), "+s"(P.bx), "+v"(P.tid)); \
    P.out = (float*)(GAS float*)P.out; P.ws = (unsigned char*)(GAS unsigned char*)P.ws; P.lane = P.tid & 63; P.wave = __builtin_amdgcn_readfirstlane(P.tid >> 6)
    if (PHEN(0) && IN(0)) { { PHASE_CTX(); prologue(P); } if (PROBE_DUP == 3) { __syncthreads(); PHASE_CTX(); prologue(P); } SEAM(0); }
    for (int l = 0; l < DEPTH; ++l) {
        const int base = 1 + 8 * l;
        if (PHEN(1) && IN(base + 0)) {
            { PHASE_CTX();
              constexpr int NG8 = INW - G1_NBF + (A8 ? 2048 : 0), U8 = (T / 256) * (NG8 / 256);
              pg8::Gemm g{(const bf16_t*)(P.ws + WS_XB8), (const bf16_t*)(P.ws + WS_WIN8), T, NG8, D / 2}; SplitOrder S; S.init(T, NG8, P.G, P.bx);
              { const int rem = 1920 % P.G;
                if (G1_NBF == 7680 && P.G == 256 && rem == 128) { S.cut = 128; S.nA = 5; S.nB = 7; }
                else if (A8 && P.G == 256) { S.cut = 128; S.nA = 14; S.nB = 11; }
                else if (G1_NBF == 3072 && P.G == 256) { S.cut = 128; S.nA = 9; S.nB = 12; }
                else { S.cut = 0; S.nA = 0; S.nB = (U8 + P.G - 1) / P.G; } }
              static_assert(G1_NBF == 3072, "EpiG1B: the fp8 call holds exactly the q/k/v and gate columns");
              EpiG1B E{P.ws + WS_PQKV, P.ws + WS_PG, (const float*)(P.ws + WS_RSTD), A8 ? 4 : G1_NBF / 256, 1.0f / 1024.0f, (bf16_t*)(P.ws + WS_PA)};
              pg8::gemm_phase<EpiG1B, SplitOrder, false, true>(lds, g, S, E, nullptr);
              if (PROBE_DUP == 2 || PROBE_DUP == 13) { __syncthreads(); pg8::gemm_phase<EpiG1B, SplitOrder, false, true>(lds, g, S, E, nullptr); } }
            __syncthreads();
            if (G1_NBF > 0) { PHASE_CTX();
              constexpr int NB16 = A8 ? 1024 : G1_NBF;
              pg8::Gemm g{(const bf16_t*)(P.ws + WS_XB), (const bf16_t*)(P.ws + WS_WIN), T, NB16, D}; SplitOrder S; S.init(T, NB16, P.G, P.bx);
              if (!A8 && G1_NBF == 3072 && P.G == 256) { S.cut = 128; S.nA = 4; S.nB = 2; } else if (A8 && P.G == 256) { S.cut = 128; S.nA = 0; S.nB = 2; } else { S.cut = 0; S.nA = 0; S.nB = ((T / 256) * (NB16 / 256) + P.G - 1) / P.G; }
              EpiG1 E{(bf16_t*)(P.ws + WS_PA), (bf16_t*)(P.ws + WS_PB), (bf16_t*)(P.ws + WS_PQKV), (bf16_t*)(P.ws + WS_PG), (const float*)(P.ws + WS_RSTD), A8 ? 8 : 0, 1.0f};
              pg8::gemm_phase<EpiG1, SplitOrder, false>(lds, g, S, E, nullptr);
              if (PROBE_DUP == 2) { __syncthreads(); pg8::gemm_phase<EpiG1, SplitOrder, false>(lds, g, S, E, nullptr); } }
            SEAM(base + 0);
        }
        if (PHEN(2) && IN(base + 1)) {
#ifdef ATT_NAIVE
            PHASE_CTX(); att_naive(P); vss_rows(P);
#else
            { PHASE_CTX(); att_mfma(P, BG_TABLES && BG_TABLES0 && l == 0 && P.G == 256); } { PHASE_CTX(); vss_rows(P); }
            if (PROBE_DUP == 5) { { PHASE_CTX(); att_mfma(P); } { PHASE_CTX(); vss_rows(P); } }
#endif
            SEAM(base + 1); }
        if (PHEN(3) && IN(base + 2)) {
#ifdef MIXA_NAIVE
            { PHASE_CTX(); mixa_naive(P, l); }
#else
            { PHASE_CTX(); mixa_mfma(P, l, BG_TABLES && BG_TABLES0 && l == 0 && P.G == 256); }
#endif
#ifdef MIXB_NAIVE
            { PHASE_CTX(); mixb_naive(P); }
#else
            { PHASE_CTX(); mixb_mfma(P, BG_TABLES && BG_TABLES0 && l == 0 && P.G == 256); }
#endif
            { PHASE_CTX(); combine_groups(P, BG_TABLES && BG_TABLES0 && l == 0 && P.G == 256); }
            if (PROBE_DUP == 6) { { PHASE_CTX(); mixa_mfma(P, l); } { PHASE_CTX(); mixb_mfma(P); } { PHASE_CTX(); combine_groups(P); } }
            SEAM(base + 2); }
        if (PHEN(4) && IN(base + 3)) {
            PHASE_CTX();
            pg8::Gemm g{(const bf16_t*)(P.ws + WS_YA), (const bf16_t*)(P.ws + WS_WA), T, D, BR8 ? 1280 : 2560}; pg8::StaticOrder S; S.init(T, D, P.G, P.bx);
            EpiBranchF<BR8> E{(bf16_t*)(P.ws + WS_PA), (const unsigned char*)(P.ws + WS_PG)};
            pg8::gemm_phase<EpiBranchF<BR8>, pg8::StaticOrder, false, BR8 != 0>(lds, g, S, E, nullptr);
            if (PROBE_DUP == 7) { __syncthreads(); pg8::gemm_phase<EpiBranchF<BR8>, pg8::StaticOrder, false, BR8 != 0>(lds, g, S, E, nullptr); }
            SEAM(base + 3);
        }
        if (PHEN(5) && IN(base + 4)) {
            PHASE_CTX();
            pg8::Gemm g{(const bf16_t*)(P.ws + WS_PA), (const bf16_t*)(P.ws + WS_WOUT), T, D, D}; pg8::StaticOrder S; S.init(T, D, P.G, P.bx);
            const float* xin0 = inptr(P, 0);
            if (false) { EpiWout<0> E{xin0, P.out, (bf16_t*)(P.ws + WS_XB), P.ws + WS_XB8};
                if (PROBE_DUP == 10) { __syncthreads(); pg8::gemm_phase<EpiWout<0>, pg8::StaticOrder, false>(lds, g, S, E, nullptr); } }
            else { EpiWout<1> E{xin0, P.out, (bf16_t*)(P.ws + WS_XB), P.ws + WS_XB8}; pg8::gemm_phase<EpiWout<1>, pg8::StaticOrder, false>(lds, g, S, E, nullptr); }
            SEAM(base + 4);
        }
        if (PHEN(6) && IN(base + 5)) {
            PHASE_CTX();
            pg8::Gemm g{(const bf16_t*)(P.ws + WS_XB), (const bf16_t*)(P.ws + WS_WSC), T, D, D}; pg8::StaticOrder S; S.init(T, D, P.G, P.bx);
            EpiScoreBf16 E{(bf16_t*)(P.ws + WS_PQKV)};
            pg8::gemm_phase<EpiScoreBf16, pg8::StaticOrder, false>(lds, g, S, E, nullptr);
            if (PROBE_DUP == 8) { __syncthreads(); pg8::gemm_phase<EpiScoreBf16, pg8::StaticOrder, false>(lds, g, S, E, nullptr); }
            if (PROBE_DUP == 15) { __syncthreads(); pg8::Gemm g2{(const bf16_t*)(P.ws + WS_XB), (const bf16_t*)(P.ws + WS_WSC), T, 2 * D, D / 2}; pg8::StaticOrder S2; S2.init(T, 2 * D, P.G, P.bx); EpiScoreBf16 E2{(bf16_t*)(P.ws + WS_PA)}; pg8::gemm_phase<EpiScoreBf16, pg8::StaticOrder, false>(lds, g2, S2, E2, nullptr); }
            if (PROBE_DUP == 16) { __syncthreads(); pg8::Gemm g2{(const bf16_t*)(P.ws + WS_XB), (const bf16_t*)(P.ws + WS_WSC), T, 2 * D, D / 2}; pg8::StaticOrder S2; S2.init(T, 2 * D, P.G, P.bx); EpiNull E2; pg8::gemm_phase<EpiNull, pg8::StaticOrder, false>(lds, g2, S2, E2, nullptr); }
            if (PROBE_DUP == 17) { __syncthreads(); pg8::Gemm g2{(const bf16_t*)(P.ws + WS_XB), (const bf16_t*)(P.ws + WS_WSC), T, 2 * D, D / 2}; pg8::StaticOrder S2; S2.init(T, 2 * D, P.G, P.bx); EpiHalf E2{(bf16_t*)(P.ws + WS_PA)}; pg8::gemm_phase<EpiHalf, pg8::StaticOrder, false>(lds, g2, S2, E2, nullptr); }
            if (PROBE_DUP == 18) { __syncthreads(); pg8::Gemm g2{(const bf16_t*)(P.ws + WS_XB), (const bf16_t*)(P.ws + WS_WSC), T, 2 * D, D / 2}; pg8::StaticOrder S2; S2.init(T, 2 * D, P.G, P.bx); EpiLocal E2{(bf16_t*)(P.ws + WS_PA)}; pg8::gemm_phase<EpiLocal, pg8::StaticOrder, false>(lds, g2, S2, E2, nullptr); }
            if (PROBE_DUP == 19) { __syncthreads(); pg8::Gemm g2{(const bf16_t*)(P.ws + WS_XB), (const bf16_t*)(P.ws + WS_WSC), T, 2 * D, D / 2}; pg8::StaticOrder S2; S2.init(T, 2 * D, P.G, P.bx); EpiContig E2{(bf16_t*)(P.ws + WS_PA)}; pg8::gemm_phase<EpiContig, pg8::StaticOrder, false>(lds, g2, S2, E2, nullptr); }
            if (PROBE_DUP == 20) { __syncthreads(); pg8::Gemm g2{(const bf16_t*)(P.ws + WS_XB), (const bf16_t*)(P.ws + WS_WSC), T, 2 * D, D / 2}; pg8::StaticOrder S2; S2.init(T, 2 * D, P.G, P.bx); EpiNT E2{(bf16_t*)(P.ws + WS_PA)}; pg8::gemm_phase<EpiNT, pg8::StaticOrder, false>(lds, g2, S2, E2, nullptr); }
            if (PROBE_DUP == 21) { __syncthreads(); pg8::Gemm g2{(const bf16_t*)(P.ws + WS_XB), (const bf16_t*)(P.ws + WS_WSC), T, 2 * D, D / 2}; pg8::StaticOrder S2; S2.init(T, 2 * D, P.G, P.bx); EpiRows8 E2{(bf16_t*)(P.ws + WS_PA)}; pg8::gemm_phase<EpiRows8, pg8::StaticOrder, false>(lds, g2, S2, E2, nullptr); }
            if (PROBE_DUP == 14) { __syncthreads(); pg8::Gemm g2{(const bf16_t*)(P.ws + WS_XB), (const bf16_t*)(P.ws + WS_WSC), T, D, D / 2}; EpiScoreBf16 E2{(bf16_t*)(P.ws + WS_PA)}; pg8::gemm_phase<EpiScoreBf16, pg8::StaticOrder, false>(lds, g2, S, E2, nullptr); }
            SEAM(base + 5);
        }
        if (PHEN(7) && IN(base + 6)) { { PHASE_CTX(); peer_topk_dpp(P, l + 1 < DEPTH ? l + 1 : -1); } if (PROBE_DUP == 4) { PHASE_CTX(); peer_topk_dpp(P); } VM_WAIT(); __syncthreads(); if (PROBE_DUP == 1) { PHASE_CTX(); peer_gather(P, l, l == DEPTH - 1, true); }
#ifdef PEER_ROWS
            { PHASE_CTX(); peer_gather(P, l, l == DEPTH - 1); }
#else
            if (PROBE_DUP == 11) { PHASE_CTX(); peer_sweep(P, l, l == DEPTH - 1, true); }
#if PEER_FP4
            if (PROBE_DUP == 11) { PHASE_CTX(); peer_sweep4(P, l, l == DEPTH - 1, true); }
            { PHASE_CTX(); peer_sweep4(P, l, l == DEPTH - 1); }
#else
            { PHASE_CTX(); peer_sweep(P, l, l == DEPTH - 1); }
#endif
#endif
            if (l + 1 < DEPTH) { if (IN(base + 7)) __syncthreads(); else SEAM(base + 6); } }
        if (PHEN(0) && l + 1 < DEPTH && IN(base + 7)) { { PHASE_CTX(); cvt_layer_weights(P, l + 1); } if (PROBE_DUP == 9) { __syncthreads(); PHASE_CTX(); cvt_layer_weights(P, l + 1); } SEAM(base + 7); }
    }
#undef IN
#undef SEAM
}
}

#ifndef MK_ONE_LAUNCH
#define MK_ONE_LAUNCH 1
#endif
extern "C" void kernel_launch(void* const* d_in, const int* in_sizes, int n_in, void* d_out, int out_size, void* d_ws, size_t ws_size, hipStream_t stream) {
    using namespace mk;
    static int grid = 0;
    if (grid == 0) {
        if (n_in != 20 || in_sizes[0] != T * D || out_size != T * D || ws_size < WS_END) { fprintf(stderr, "kernel_launch: unexpected shapes (n_in %d, in0 %d, out %d, ws %zu < %zu); nothing launched\n", n_in, n_in > 0 ? in_sizes[0] : -1, out_size, ws_size, (size_t)WS_END); grid = -1; return; }
        int dev = 0, cus = 0, per_cu = 0;
        if (hipGetDevice(&dev) != hipSuccess || hipDeviceGetAttribute(&cus, hipDeviceAttributeMultiprocessorCount, dev) != hipSuccess) { fprintf(stderr, "kernel_launch: device query failed\n"); grid = -1; return; }
        if (hipFuncSetAttribute((const void*)fwd, hipFuncAttributeMaxDynamicSharedMemorySize, LDS_BYTES) != hipSuccess) { fprintf(stderr, "kernel_launch: hipFuncSetAttribute failed\n"); grid = -1; return; }
        if (hipOccupancyMaxActiveBlocksPerMultiprocessor(&per_cu, (const void*)fwd, NTHR, LDS_BYTES) != hipSuccess || per_cu < 1) fprintf(stderr, "kernel_launch: note: occupancy query reports %d workgroups per CU\n", per_cu);
        (void)hipGetLastError();
        grid = cus;
    }
    if (grid < 0) return;
    if (hipMemsetAsync((char*)d_ws + WS_CTL, 0, CTL_ZERO_BYTES, stream) != hipSuccess) { fprintf(stderr, "kernel_launch: memset failed\n"); return; }
    Args a{};
    for (int i = 0; i < 20; ++i) a.in[i] = (const float*)d_in[i];
    a.out = (float*)d_out; a.ws = (unsigned char*)d_ws;
#if MK_ONE_LAUNCH
    a.ph_lo = 0; a.ph_hi = NPHASE;
    hipLaunchKernelGGL(fwd, dim3(grid), dim3(NTHR), LDS_BYTES, stream, a);
#else
    for (int p = 0; p < NPHASE; ++p) { a.ph_lo = p; a.ph_hi = p + 1; hipLaunchKernelGGL(fwd, dim3(grid), dim3(NTHR), LDS_BYTES, stream, a); }
#endif
    const hipError_t le = hipPeekAtLastError();
    if (le != hipSuccess) fprintf(stderr, "kernel_launch: launch failed: %s\n", hipGetErrorName(le));
}
```
